# Optimizing an MI355X kernel written in HIP

```python
import math
import jax, jax.numpy as jnp
from jax import lax
import numpy as np

D_MODEL = 1024
BATCH = 8
SEQ = 4096
DEPTH = 1

CHUNK = 64
D_MIX = D_MODEL
HG_WIDTH = D_MIX // 2
DA_WIDTH = D_MIX - HG_WIDTH
HG_HEADS = 4
HG_DK = HG_WIDTH // HG_HEADS
HG_DV = HG_DK
DA_HEADS = 4
DA_DV = DA_WIDTH // DA_HEADS
DA_DH = DA_DV // 2
Q_BLOCK = 128
HG_Q_COLS = HG_HEADS * HG_DK
HG_F_COLS = HG_HEADS * HG_DK
HG_I_COLS = HG_HEADS * HG_DV
HG_G_COLS = HG_HEADS * HG_DV
DA_Q_COLS = DA_HEADS * 2 * DA_DH
DA_K_COLS = DA_HEADS * 2 * DA_DH
DA_V_COLS = DA_HEADS * DA_DV
D_IN = HG_Q_COLS + HG_F_COLS + HG_I_COLS + HG_G_COLS + DA_Q_COLS + DA_K_COLS + DA_V_COLS
D_CAT = HG_HEADS * HG_DV + DA_HEADS * DA_DV
PEER_HEADS = 8
PEER_N_KEYS = 128
PEER_N_EXPERTS = PEER_N_KEYS * PEER_N_KEYS
PEER_D_KEY = 256
PEER_HALF = PEER_D_KEY // 2
PEER_TOPK = 16
TOKEN_BLOCK = 128
RMS_EPS = 1e-6

kernel_name = "hymba_hgrn2_diffattn_peer_block"


def rmsnorm(x, w):
    xf = x.astype(jnp.float32)
    y = xf * lax.rsqrt(jnp.mean(xf * xf, axis=-1, keepdims=True) + RMS_EPS)
    return (y * w.astype(jnp.float32)).astype(x.dtype)


def rmsnorm_f32(x, w):
    y = x * lax.rsqrt(jnp.mean(x * x, axis=-1, keepdims=True) + RMS_EPS)
    return y * w.astype(jnp.float32)


def lambda_init(layer_idx):
    return 0.8 - 0.6 * math.exp(-0.3 * layer_idx)


def hgrn2_group(q, f_logit, inp, gate, lb, norm_w):
    B, S = q.shape[0], q.shape[1]
    n_chunks = S // CHUNK
    lbf = lb.astype(jnp.float32)
    f = lbf + (1.0 - lbf) * jax.nn.sigmoid(f_logit.astype(jnp.float32))
    k = 1.0 - f
    log_f = jnp.log(f)
    qf = q.astype(jnp.float32) * (HG_DK ** -0.5)
    vf = inp.astype(jnp.float32)

    def to_chunks(t, d):
        return t.reshape(B, n_chunks, CHUNK, HG_HEADS, d).transpose(1, 0, 3, 2, 4)

    qc, kc, ac = to_chunks(qf, HG_DK), to_chunks(k, HG_DK), to_chunks(log_f, HG_DK)
    vc = to_chunks(vf, HG_DV)
    tri = jnp.tril(jnp.ones((CHUNK, CHUNK), dtype=bool))

    def step(state, xs):
        qb, kb, vb, ab = xs
        b = jnp.cumsum(ab, axis=2)
        diff = b[:, :, :, None, :] - b[:, :, None, :, :]
        decay = jnp.exp(jnp.where(tri[:, :, None], diff, -jnp.inf))
        scores = jnp.einsum('bhtd,bhsd,bhtsd->bhts', qb, kb, decay)
        o = jnp.einsum('bhts,bhse->bhte', scores, vb) \
            + jnp.einsum('bhtd,bhde->bhte', qb * jnp.exp(b), state)
        b_last = b[:, :, -1]
        state = jnp.exp(b_last)[..., None] * state \
            + jnp.einsum('bhsd,bhse->bhde', kb * jnp.exp(b_last[:, :, None, :] - b), vb)
        return state, o

    s0 = jnp.zeros((B, HG_HEADS, HG_DK, HG_DV), jnp.float32)
    _, oc = lax.scan(step, s0, (qc, kc, vc, ac))
    o = oc.transpose(1, 0, 3, 2, 4).reshape(B, S, HG_HEADS, HG_DV)
    g = gate.astype(jnp.float32).reshape(B, S, HG_HEADS, HG_DV)
    o = rmsnorm_f32(o, norm_w) * jax.nn.silu(g)
    return o.reshape(B, S, HG_HEADS * HG_DV)


def diff_attention_group(q, k, v, lam_params, norm_w, layer_idx):
    B, S = q.shape[0], q.shape[1]
    n_blocks = S // Q_BLOCK
    lam_init = lambda_init(layer_idx)
    lp = lam_params.astype(jnp.float32)
    lam = jnp.exp(jnp.sum(lp[0] * lp[1])) - jnp.exp(jnp.sum(lp[2] * lp[3])) + lam_init
    scale = DA_DH ** -0.5
    qf = q.astype(jnp.float32).reshape(B, n_blocks, Q_BLOCK, DA_HEADS, 2, DA_DH).transpose(1, 0, 2, 3, 4, 5)
    kf = k.astype(jnp.float32).reshape(B, S, DA_HEADS, 2, DA_DH)
    vf = v.astype(jnp.float32).reshape(B, S, DA_HEADS, DA_DV)
    key_chunk = jnp.arange(S) // CHUNK

    def one_block(args):
        qb, blk = args
        s = jnp.einsum('bqhcd,bkhcd->bhcqk', qb, kf) * scale
        q_chunk = (blk * Q_BLOCK + jnp.arange(Q_BLOCK)) // CHUNK
        mask = key_chunk[None, :] <= q_chunk[:, None]
        p = jax.nn.softmax(jnp.where(mask, s, -jnp.inf), axis=-1)
        a = p[:, :, 0] - lam * p[:, :, 1]
        return jnp.einsum('bhqk,bkhe->bqhe', a, vf)

    o = lax.map(one_block, (qf, jnp.arange(n_blocks)))
    o = o.transpose(1, 0, 2, 3, 4).reshape(B, S, DA_HEADS, DA_DV)
    o = rmsnorm_f32(o, norm_w) * (1.0 - lam_init)
    return o.reshape(B, S, DA_HEADS * DA_DV)


def peer_ffn(x, w_query, sub_keys, u, v):
    B, S, D = x.shape
    xt = x.reshape((B * S) // TOKEN_BLOCK, TOKEN_BLOCK, D)
    wq = w_query.reshape(D, PEER_HEADS, PEER_D_KEY)

    def one_block(xb):
        qh = jnp.einsum('td,dhk->thk', xb, wq)
        s1 = jnp.einsum('thk,hnk->thn', qh[..., :PEER_HALF], sub_keys[:, 0])
        s2 = jnp.einsum('thk,hnk->thn', qh[..., PEER_HALF:], sub_keys[:, 1])
        v1, i1 = lax.top_k(s1, PEER_TOPK)
        v2, i2 = lax.top_k(s2, PEER_TOPK)
        T = xb.shape[0]
        cand = (v1[..., :, None] + v2[..., None, :]).reshape(T, PEER_HEADS, PEER_TOPK * PEER_TOPK)
        cand_idx = (i1[..., :, None] * PEER_N_KEYS + i2[..., None, :]).reshape(T, PEER_HEADS, PEER_TOPK * PEER_TOPK)
        top_s, pos = lax.top_k(cand, PEER_TOPK)
        idx = jnp.take_along_axis(cand_idx, pos, axis=-1)
        g = jax.nn.softmax(top_s.astype(jnp.float32), axis=-1).astype(xb.dtype)
        ue = u[idx]
        act = jax.nn.gelu(jnp.einsum('thkd,td->thk', ue, xb))
        ve = v[idx]
        return jnp.einsum('thk,thkd->td', g * act, ve)

    out = lax.map(one_block, xt)
    return out.reshape(B, S, D)


def setup_inputs(seed: int = 0) -> dict:
    key = jax.random.key(seed)
    ks = jax.random.split(key, 16)
    f32 = jnp.float32
    nrm = lambda k, shape, s: jax.random.normal(k, shape, f32) * s
    gain = lambda k, shape: 1.0 + 0.02 * jax.random.normal(k, shape, f32)
    return {
        "x": nrm(ks[0], (BATCH, SEQ, D_MODEL), 1.0),
        "norm_mix_w": gain(ks[1], (DEPTH, D_MODEL)),
        "w_in": nrm(ks[2], (DEPTH, D_MODEL, D_IN), D_MODEL ** -0.5),
        "hgrn_lb_param": nrm(ks[3], (DEPTH + 1, HG_HEADS * HG_DK), 0.5),
        "hgrn_norm_w": gain(ks[4], (DEPTH, HG_DV)),
        "diff_lambda": nrm(ks[5], (DEPTH, 4, DA_DH), 0.1),
        "diff_norm_w": gain(ks[6], (DEPTH, DA_DV)),
        "w_out": nrm(ks[7], (DEPTH, D_CAT, D_MODEL), D_CAT ** -0.5),
        "norm_ffn_w": gain(ks[8], (DEPTH, D_MODEL)),
        "peer_w_query": nrm(ks[9], (DEPTH, D_MODEL, PEER_HEADS * PEER_D_KEY), D_MODEL ** -0.5),
        "peer_sub_keys": nrm(ks[10], (DEPTH, PEER_HEADS, 2, PEER_N_KEYS, PEER_HALF), PEER_HALF ** -0.5),
        "peer_u": nrm(ks[11], (DEPTH, PEER_N_EXPERTS, D_MODEL), D_MODEL ** -0.5),
        "peer_v": nrm(ks[12], (DEPTH, PEER_N_EXPERTS, D_MODEL), 0.5),
        "norm_final_w": gain(ks[13], (D_MODEL,)),
    }


def reference(x, norm_mix_w, w_in, hgrn_lb_param, hgrn_norm_w, diff_lambda, diff_norm_w,
              w_out, norm_ffn_w, peer_w_query, peer_sub_keys, peer_u, peer_v, norm_final_w):
    lower_bounds = jnp.cumsum(jax.nn.softmax(hgrn_lb_param.astype(jnp.float32), axis=0), axis=0)
    c1 = HG_Q_COLS
    c2 = c1 + HG_F_COLS
    c3 = c2 + HG_I_COLS
    c4 = c3 + HG_G_COLS
    c5 = c4 + DA_Q_COLS
    c6 = c5 + DA_K_COLS
    h = x
    for l in range(DEPTH):
        n1 = rmsnorm(h, norm_mix_w[l])
        proj = jnp.einsum('bsd,de->bse', n1, w_in[l])
        hg_out = hgrn2_group(proj[..., :c1], proj[..., c1:c2], proj[..., c2:c3], proj[..., c3:c4],
                             lower_bounds[l], hgrn_norm_w[l])
        da_out = diff_attention_group(proj[..., c4:c5], proj[..., c5:c6], proj[..., c6:],
                                      diff_lambda[l], diff_norm_w[l], l)
        mixed = jnp.concatenate([hg_out, da_out], axis=-1).astype(h.dtype)
        h = h + jnp.einsum('bse,ed->bsd', mixed, w_out[l])
        n2 = rmsnorm(h, norm_ffn_w[l])
        h = h + peer_ffn(n2, peer_w_query[l], peer_sub_keys[l], peer_u[l], peer_v[l]).astype(h.dtype)
    return rmsnorm(h, norm_final_w)
```

```cpp
#include <hip/hip_runtime.h>
#include <cstdio>
#include <cstdint>

constexpr int BATCH = 8, SEQ = 4096, T = BATCH * SEQ, D = 1024, DIN = 3584;
constexpr int NEXP = 16384;
constexpr float RMS_EPS = 1e-6f;
constexpr int NWAVES = 8, NTHREADS = NWAVES * 64;

constexpr int C_HQ = 0, C_HF = 512, C_HI = 1024, C_HG = 1536, C_AQ = 2048, C_AK = 2560, C_AV = 3072;

constexpr size_t MiB = 1u << 20;
constexpr size_t WS_CTL = 0;
constexpr size_t WS_WIN = 2 * MiB;
constexpr size_t WS_WO = 9 * MiB;
constexpr size_t WS_WQ = 11 * MiB;
constexpr size_t WS_SK = 15 * MiB;
constexpr size_t WS_UB = 16 * MiB;
constexpr size_t WS_VB = 48 * MiB;
constexpr size_t WS_XN = 80 * MiB;
constexpr size_t WS_MIX = 80 * MiB;
constexpr size_t WS_PROJ = 144 * MiB;
constexpr size_t WS_HA = 368 * MiB;
constexpr size_t WS_HO = 432 * MiB;
constexpr size_t WS_TMPO = 368 * MiB;
constexpr size_t WS_PSQ = 496 * MiB;
constexpr size_t WS_HB = 144 * MiB;
constexpr size_t WS_QH = 208 * MiB;
constexpr size_t WS_IDX = 336 * MiB;
constexpr size_t WS_G = 352 * MiB;
constexpr size_t WS_END = 498 * MiB;

constexpr int LDS_BYTES = 147456;

typedef unsigned short bf16;
#define LAS __attribute__((address_space(3)))

__device__ __forceinline__ unsigned f2bf(float f) { unsigned u = __builtin_bit_cast(unsigned, f); return (u + 0x7fffu + ((u >> 16) & 1u)) >> 16; }
__device__ __forceinline__ unsigned pk2(float lo, float hi) { return f2bf(lo) | (f2bf(hi) << 16); }
__device__ __forceinline__ float bf2f(unsigned b) { return __builtin_bit_cast(float, b << 16); }
__device__ __forceinline__ float bflo(unsigned w) { return __builtin_bit_cast(float, w << 16); }
__device__ __forceinline__ float bfhi(unsigned w) { return __builtin_bit_cast(float, w & 0xffff0000u); }
__device__ __forceinline__ float wave_sum(float v) {
#pragma unroll
    for (int o = 1; o < 64; o <<= 1) v += __shfl_xor(v, o);
    return v;
}

struct Args { const float* in[14]; float* out; unsigned char* ws; int ph_lo, ph_hi; };

struct Frame {
    unsigned char* lds;
    int tid, lane, wave, G, bid;
    const float *x, *nmw, *w_in, *lbp, *hnw, *dlam, *dnw, *w_out, *nfw, *wq, *sk, *u, *v, *nfin;
    float* out;
    bf16 *WinT, *WoT, *WqT, *SKb, *Ub, *Vb, *XN, *MIX, *PROJ, *HB, *QH;
    float *HA, *HO, *TMPO, *PSQ, *GW;
    int* IDX;
};

__device__ __forceinline__ void transpose_item(const float* W, const float* scale, int K, int N, bf16* WT, float* scr, int item, int lane) {
    const int nblk = N / 32, kb = item / nblk, nb = item % nblk, k0 = 64 * kb, n0 = 32 * nb;
#pragma unroll 8
    for (int i = 0; i < 32; ++i) { const int kk = 2 * i + (lane >> 5); float s = scale ? scale[k0 + kk] : 1.0f; scr[kk * 33 + (lane & 31)] = W[(size_t)(k0 + kk) * N + n0 + (lane & 31)] * s; }
    __builtin_amdgcn_s_waitcnt(0xc07f); asm volatile("" ::: "memory");
    const int c = lane & 7;
#pragma unroll
    for (int j = 0; j < 4; ++j) { const int n = (lane >> 3) + 8 * j; const float* s = scr + (8 * c) * 33 + n;
        uint4 o; o.x = pk2(s[0 * 33], s[1 * 33]); o.y = pk2(s[2 * 33], s[3 * 33]); o.z = pk2(s[4 * 33], s[5 * 33]); o.w = pk2(s[6 * 33], s[7 * 33]);
        *(uint4*)(WT + (size_t)(n0 + n) * K + k0 + 8 * c) = o; }
    __builtin_amdgcn_s_waitcnt(0xc07f); asm volatile("" ::: "memory");
}

__device__ __forceinline__ void stage_prep(Frame& F) {
    float* scr = (float*)(F.lds + F.wave * 16384);
    const int gw = F.bid * NWAVES + F.wave, NGW = F.G * NWAVES;
    constexpr int I_IN = (D / 64) * (DIN / 32), I_O = (D / 64) * (D / 32), I_Q = (D / 64) * (2048 / 32);
    for (int it = gw; it < I_IN + I_O + I_Q; it += NGW) {
        int r = it;
        if (r < I_IN) { transpose_item(F.w_in, nullptr, D, DIN, F.WinT, scr, r, F.lane); continue; } r -= I_IN;
        if (r < I_O) { transpose_item(F.w_out, nullptr, D, D, F.WoT, scr, r, F.lane); continue; } r -= I_O;
        transpose_item(F.wq, F.nfw, D, 2048, F.WqT, scr, r, F.lane);
    }
    const size_t gt = (size_t)F.bid * NTHREADS + F.tid, NGT = (size_t)F.G * NTHREADS;
    for (size_t i = gt; i < (size_t)NEXP * D / 8; i += NGT) {
        const int k = (int)((i * 8) & (D - 1));
        const float4 a = *(const float4*)(F.u + i * 8), b = *(const float4*)(F.u + i * 8 + 4);
        const float4 s0 = *(const float4*)(F.nfw + k), s1 = *(const float4*)(F.nfw + k + 4);
        uint4 o; o.x = pk2(a.x * s0.x, a.y * s0.y); o.y = pk2(a.z * s0.z, a.w * s0.w); o.z = pk2(b.x * s1.x, b.y * s1.y); o.w = pk2(b.z * s1.z, b.w * s1.w);
        *(uint4*)(F.Ub + i * 8) = o;
        const float4 c = *(const float4*)(F.v + i * 8), d = *(const float4*)(F.v + i * 8 + 4);
        uint4 p; p.x = pk2(c.x, c.y); p.y = pk2(c.z, c.w); p.z = pk2(d.x, d.y); p.w = pk2(d.z, d.w);
        *(uint4*)(F.Vb + i * 8) = p;
    }
    for (size_t i = gt; i < (size_t)8 * 2 * 128 * 128 / 8; i += NGT) {
        const float4 c = *(const float4*)(F.sk + i * 8), d = *(const float4*)(F.sk + i * 8 + 4);
        uint4 p; p.x = pk2(c.x, c.y); p.y = pk2(c.z, c.w); p.z = pk2(d.x, d.y); p.w = pk2(d.z, d.w);
        *(uint4*)(F.SKb + i * 8) = p;
    }
    for (int m = gw; m < T; m += NGW) {
        const float4* xr = (const float4*)(F.x + (size_t)m * D) + F.lane;
        float4 v[4]; float s = 0.f;
#pragma unroll
        for (int j = 0; j < 4; ++j) { v[j] = xr[64 * j]; s += (v[j].x * v[j].x + v[j].y * v[j].y) + (v[j].z * v[j].z + v[j].w * v[j].w); }
        const float rstd = 1.0f / sqrtf(wave_sum(s) * (1.f / D) + RMS_EPS);
        unsigned long long* o8 = (unsigned long long*)(F.XN + (size_t)m * D) + F.lane;
#pragma unroll
        for (int j = 0; j < 4; ++j) { const float4 w = ((const float4*)F.nmw)[F.lane + 64 * j];
            o8[64 * j] = (unsigned long long)pk2(v[j].x * rstd * w.x, v[j].y * rstd * w.y) | ((unsigned long long)pk2(v[j].z * rstd * w.z, v[j].w * rstd * w.w) << 32); }
    }
}

template <class Epi>
__device__ __forceinline__ void gemm_naive(Frame& F, const bf16* A, const bf16* Bt, int M, int N, int K, const Epi& epi) {
    float* As = (float*)F.lds;
    float* Bs = As + 32 * 68;
    const int tid = F.tid, ty = tid >> 5, tx = tid & 31;
    const int ntm = M / 64, ntn = N / 128;
    for (int tile = F.bid; tile < ntm * ntn; tile += F.G) {
        const int tm = tile / ntn, tn = tile % ntn;
        float acc[4][4];
#pragma unroll
        for (int i = 0; i < 4; ++i)
#pragma unroll
            for (int j = 0; j < 4; ++j) acc[i][j] = 0.f;
        for (int k0 = 0; k0 < K; k0 += 32) {
            { const int idx = tid * 4, r = idx >> 5, kk = idx & 31;
              const uint2 v = *(const uint2*)(A + (size_t)(tm * 64 + r) * K + k0 + kk);
              As[(kk + 0) * 68 + r] = bflo(v.x); As[(kk + 1) * 68 + r] = bfhi(v.x); As[(kk + 2) * 68 + r] = bflo(v.y); As[(kk + 3) * 68 + r] = bfhi(v.y); }
            { const int idx = tid * 8, r = idx >> 5, kk = idx & 31;
              const uint4 v = *(const uint4*)(Bt + (size_t)(tn * 128 + r) * K + k0 + kk);
              Bs[(kk + 0) * 132 + r] = bflo(v.x); Bs[(kk + 1) * 132 + r] = bfhi(v.x); Bs[(kk + 2) * 132 + r] = bflo(v.y); Bs[(kk + 3) * 132 + r] = bfhi(v.y);
              Bs[(kk + 4) * 132 + r] = bflo(v.z); Bs[(kk + 5) * 132 + r] = bfhi(v.z); Bs[(kk + 6) * 132 + r] = bflo(v.w); Bs[(kk + 7) * 132 + r] = bfhi(v.w); }
            __syncthreads();
#pragma unroll 8
            for (int kk = 0; kk < 32; ++kk) {
                const float4 a = *(const float4*)&As[kk * 68 + ty * 4], b = *(const float4*)&Bs[kk * 132 + tx * 4];
                acc[0][0] += a.x * b.x; acc[0][1] += a.x * b.y; acc[0][2] += a.x * b.z; acc[0][3] += a.x * b.w;
                acc[1][0] += a.y * b.x; acc[1][1] += a.y * b.y; acc[1][2] += a.y * b.z; acc[1][3] += a.y * b.w;
                acc[2][0] += a.z * b.x; acc[2][1] += a.z * b.y; acc[2][2] += a.z * b.z; acc[2][3] += a.z * b.w;
                acc[3][0] += a.w * b.x; acc[3][1] += a.w * b.y; acc[3][2] += a.w * b.z; acc[3][3] += a.w * b.w;
            }
            __syncthreads();
        }
#pragma unroll
        for (int i = 0; i < 4; ++i)
#pragma unroll
            for (int j = 0; j < 4; ++j) epi(tm * 64 + ty * 4 + i, tn * 128 + tx * 4 + j, acc[i][j]);
    }
}

struct Epi1 {
    bf16* PROJ; float* HA; const float* lbp;
    __device__ __forceinline__ void operator()(int r, int c, float v) const {
        float o;
        if (c < C_HF) o = v * 0.08838834764831845f;
        else if (c < C_HI) { const int j = c - C_HF; const float lb = 1.0f / (1.0f + __expf(lbp[512 + j] - lbp[j]));
            const float sig = 1.0f / (1.0f + __expf(-v)), omsig = 1.0f / (1.0f + __expf(v));
            const float f = lb + (1.0f - lb) * sig; HA[(size_t)r * 512 + j] = __logf(f); o = (1.0f - lb) * omsig; }
        else if (c < C_HG) o = v;
        else if (c < C_AQ) o = v / (1.0f + __expf(-v));
        else if (c < C_AK) o = v * 0.125f;
        else o = v;
        PROJ[(size_t)r * DIN + c] = (bf16)f2bf(o);
    }
};
struct Epi3 {
    const float* x; float* out; bf16* HB;
    __device__ __forceinline__ void operator()(int r, int c, float v) const {
        const float h = x[(size_t)r * D + c] + v; out[(size_t)r * D + c] = h; HB[(size_t)r * D + c] = (bf16)f2bf(h);
    }
};
struct Epi4 {
    bf16* QH;
    __device__ __forceinline__ void operator()(int r, int c, float v) const { QH[(size_t)r * 2048 + c] = (bf16)f2bf(v); }
};

__device__ __forceinline__ void stage_hgrn_naive(Frame& F) {
    float* sf = (float*)F.lds;
    float* skk = sf + 1024;
    float* sq = skk + 1024;
    float* si = sq + 1024;
    float* red = si + 1024;
    const int tid = F.tid, e = tid & 127, dq = tid >> 7;
    for (int unit = F.bid; unit < 32; unit += F.G) {
        const int b = unit >> 2, h = unit & 3;
        float S[32];
#pragma unroll
        for (int i = 0; i < 32; ++i) S[i] = 0.f;
        for (int t0 = 0; t0 < SEQ; t0 += 8) {
#pragma unroll
            for (int i = 0; i < 8; ++i) {
                const int idx = tid + 512 * i, rem = idx & 1023, tt = rem >> 7, d = rem & 127;
                const size_t row = (size_t)b * SEQ + t0 + tt;
                if ((i >> 1) == 0) sf[rem] = __expf(F.HA[row * 512 + h * 128 + d]);
                else if ((i >> 1) == 1) skk[rem] = bf2f(F.PROJ[row * DIN + C_HF + h * 128 + d]);
                else if ((i >> 1) == 2) sq[rem] = bf2f(F.PROJ[row * DIN + C_HQ + h * 128 + d]);
                else si[rem] = bf2f(F.PROJ[row * DIN + C_HI + h * 128 + d]);
            }
            __syncthreads();
            float po[8];
#pragma unroll
            for (int tt = 0; tt < 8; ++tt) {
                const float iv = si[tt * 128 + e]; float acc = 0.f;
#pragma unroll
                for (int dd = 0; dd < 32; ++dd) { const int d = dq * 32 + dd; S[dd] = sf[tt * 128 + d] * S[dd] + skk[tt * 128 + d] * iv; acc += S[dd] * sq[tt * 128 + d]; }
                po[tt] = acc;
            }
#pragma unroll
            for (int tt = 0; tt < 8; ++tt) red[(dq * 8 + tt) * 128 + e] = po[tt];
            __syncthreads();
#pragma unroll
            for (int i = 0; i < 2; ++i) { const int idx = tid + 512 * i, tt = idx >> 7, ee = idx & 127;
                const float o = (red[(0 * 8 + tt) * 128 + ee] + red[(1 * 8 + tt) * 128 + ee]) + (red[(2 * 8 + tt) * 128 + ee] + red[(3 * 8 + tt) * 128 + ee]);
                F.HO[((size_t)b * SEQ + t0 + tt) * 512 + h * 128 + ee] = o; }
        }
        __syncthreads();
    }
}
__device__ __forceinline__ void stage_hgrn_fin(Frame& F) {
    const int gw = F.bid * NWAVES + F.wave, NGW = F.G * NWAVES;
    for (int it = gw; it < T * 4; it += NGW) {
        const int row = it >> 2, h = it & 3;
        const float o0 = F.HO[(size_t)row * 512 + h * 128 + F.lane], o1 = F.HO[(size_t)row * 512 + h * 128 + 64 + F.lane];
        const float r = 1.0f / sqrtf(wave_sum(o0 * o0 + o1 * o1) * (1.f / 128.f) + RMS_EPS);
        const float g0 = bf2f(F.PROJ[(size_t)row * DIN + C_HG + h * 128 + F.lane]), g1 = bf2f(F.PROJ[(size_t)row * DIN + C_HG + h * 128 + 64 + F.lane]);
        F.MIX[(size_t)row * D + h * 128 + F.lane] = (bf16)f2bf(o0 * r * F.hnw[F.lane] * g0);
        F.MIX[(size_t)row * D + h * 128 + 64 + F.lane] = (bf16)f2bf(o1 * r * F.hnw[64 + F.lane] * g1);
    }
}

__device__ __forceinline__ void stage_attn_naive(Frame& F) {
    for (int unit = F.bid; unit < 256; unit += F.G) {
        const int b = unit >> 5, h = (unit >> 3) & 3, q8 = unit & 7;
        const int t = q8 * 512 + F.tid;
        const int limit = ((q8 * 8 + F.wave) + 1) * 64;
        const size_t row = (size_t)b * SEQ + t;
        for (int m = 0; m < 2; ++m) {
            float q[64];
            { const uint4* qp = (const uint4*)(F.PROJ + row * DIN + C_AQ + h * 128 + m * 64);
#pragma unroll
              for (int i = 0; i < 8; ++i) { const uint4 v = qp[i]; q[8 * i + 0] = bflo(v.x); q[8 * i + 1] = bfhi(v.x); q[8 * i + 2] = bflo(v.y); q[8 * i + 3] = bfhi(v.y);
                  q[8 * i + 4] = bflo(v.z); q[8 * i + 5] = bfhi(v.z); q[8 * i + 6] = bflo(v.w); q[8 * i + 7] = bfhi(v.w); } }
            float o[128];
#pragma unroll
            for (int i = 0; i < 128; ++i) o[i] = 0.f;
            float mx = -INFINITY, l = 0.f;
            const bf16* kbase = F.PROJ + (size_t)b * SEQ * DIN + C_AK + h * 128 + m * 64;
            const bf16* vbase = F.PROJ + (size_t)b * SEQ * DIN + C_AV + h * 128;
            for (int j = 0; j < limit; ++j) {
                const unsigned* kr = (const unsigned*)(kbase + (size_t)j * DIN);
                float s = 0.f;
#pragma unroll
                for (int i = 0; i < 32; ++i) { const unsigned w = kr[i]; s += q[2 * i] * bflo(w); s += q[2 * i + 1] * bfhi(w); }
                const float mn = fmaxf(mx, s), sc = __expf(mx - mn), pp = __expf(s - mn);
                l = l * sc + pp; mx = mn;
                const unsigned* vr = (const unsigned*)(vbase + (size_t)j * DIN);
#pragma unroll
                for (int i = 0; i < 64; ++i) { const unsigned w = vr[i]; o[2 * i] = o[2 * i] * sc + pp * bflo(w); o[2 * i + 1] = o[2 * i + 1] * sc + pp * bfhi(w); }
            }
            const float inv = 1.0f / l;
            float4* op = (float4*)(F.TMPO + ((size_t)m * T + row) * 512 + h * 128);
#pragma unroll
            for (int i = 0; i < 32; ++i) op[i] = make_float4(o[4 * i] * inv, o[4 * i + 1] * inv, o[4 * i + 2] * inv, o[4 * i + 3] * inv);
        }
    }
}
__device__ __forceinline__ float compute_lambda(const float* dl, int lane) {
    const float sa = wave_sum(dl[lane] * dl[64 + lane]), sb = wave_sum(dl[128 + lane] * dl[192 + lane]);
    return __expf(sa) - __expf(sb) + 0.2f;
}
__device__ __forceinline__ void stage_attn_fin(Frame& F) {
    const float lam = compute_lambda(F.dlam, F.lane);
    const int gw = F.bid * NWAVES + F.wave, NGW = F.G * NWAVES;
    for (int it = gw; it < T * 4; it += NGW) {
        const int row = it >> 2, h = it & 3;
        const size_t o = (size_t)row * 512 + h * 128 + F.lane;
        const float a0 = F.TMPO[o] - lam * F.TMPO[(size_t)T * 512 + o], a1 = F.TMPO[o + 64] - lam * F.TMPO[(size_t)T * 512 + o + 64];
        const float r = 1.0f / sqrtf(wave_sum(a0 * a0 + a1 * a1) * (1.f / 128.f) + RMS_EPS);
        F.MIX[(size_t)row * D + 512 + h * 128 + F.lane] = (bf16)f2bf(a0 * r * F.dnw[F.lane] * 0.8f);
        F.MIX[(size_t)row * D + 512 + h * 128 + 64 + F.lane] = (bf16)f2bf(a1 * r * F.dnw[64 + F.lane] * 0.8f);
    }
}

__device__ __forceinline__ void stage_rowstat(Frame& F) {
    const int gw = F.bid * NWAVES + F.wave, NGW = F.G * NWAVES;
    for (int m = gw; m < T; m += NGW) {
        const float4* xr = (const float4*)(F.out + (size_t)m * D) + F.lane; float s = 0.f;
#pragma unroll
        for (int j = 0; j < 4; ++j) { const float4 v = xr[64 * j]; s += (v.x * v.x + v.y * v.y) + (v.z * v.z + v.w * v.w); }
        s = wave_sum(s);
        if (F.lane < 16) F.PSQ[(size_t)m * 16 + F.lane] = (F.lane == 0) ? s : 0.f;
    }
}
__device__ __forceinline__ float row_rstd(const float* PSQ, int t) {
    const float4* p = (const float4*)(PSQ + (size_t)t * 16);
    const float4 a = p[0], b = p[1], c = p[2], d = p[3];
    const float s = ((a.x + a.y) + (a.z + a.w)) + ((b.x + b.y) + (b.z + b.w)) + ((c.x + c.y) + (c.z + c.w)) + ((d.x + d.y) + (d.z + d.w));
    return 1.0f / sqrtf(s * (1.f / D) + RMS_EPS);
}

__device__ __forceinline__ void stage_topk_naive(Frame& F) {
    float* sc = (float*)F.lds;
    float* tv = sc + 512;
    int* ti = (int*)(tv + 64);
    float* cs = (float*)(ti + 64);
    float* ts = cs + 512;
    int* tix = (int*)(ts + 32);
    const int g = F.tid >> 8, lt = F.tid & 255, half = lt >> 7, n = lt & 127;
    for (int t = F.bid; t < T; t += F.G) {
        const float rstd = row_rstd(F.PSQ, t);
        for (int hp = 0; hp < 4; ++hp) {
            const int h = hp * 2 + g;
            const unsigned* qv = (const unsigned*)(F.QH + (size_t)t * 2048 + h * 256 + half * 128);
            const unsigned* kv = (const unsigned*)(F.SKb + ((size_t)(h * 2 + half) * 128 + n) * 128);
            float s = 0.f;
#pragma unroll 8
            for (int k = 0; k < 64; ++k) { const unsigned a = qv[k], bq = kv[k]; s += bflo(a) * bflo(bq); s += bfhi(a) * bfhi(bq); }
            sc[g * 256 + lt] = s;
            __syncthreads();
            int rank = 0;
            for (int m = 0; m < 128; ++m) { const float v = sc[g * 256 + half * 128 + m]; rank += (v > s || (v == s && m < n)) ? 1 : 0; }
            if (rank < 16) { tv[(g * 2 + half) * 16 + rank] = s; ti[(g * 2 + half) * 16 + rank] = n; }
            __syncthreads();
            const int ci = lt >> 4, cj = lt & 15;
            const float cv = tv[(g * 2 + 0) * 16 + ci] + tv[(g * 2 + 1) * 16 + cj];
            const int cid = ti[(g * 2 + 0) * 16 + ci] * 128 + ti[(g * 2 + 1) * 16 + cj];
            cs[g * 256 + lt] = cv;
            __syncthreads();
            rank = 0;
            for (int m = 0; m < 256; ++m) { const float v = cs[g * 256 + m]; rank += (v > cv || (v == cv && m < lt)) ? 1 : 0; }
            if (rank < 16) { ts[g * 16 + rank] = cv; tix[g * 16 + rank] = cid; }
            __syncthreads();
            if (lt < 16) {
                const float mx = ts[g * 16 + 0]; float sum = 0.f;
                for (int k = 0; k < 16; ++k) sum += __expf((ts[g * 16 + k] - mx) * rstd);
                F.GW[(size_t)t * 128 + h * 16 + lt] = __expf((ts[g * 16 + lt] - mx) * rstd) / sum;
                F.IDX[(size_t)t * 128 + h * 16 + lt] = tix[g * 16 + lt];
            }
            __syncthreads();
        }
    }
}

__device__ __forceinline__ float gelu_tanh(float z) {
    const float y = 0.7978845608028654f * (z + 0.044715f * z * z * z);
    const float th = 1.0f - 2.0f / (1.0f + __expf(2.0f * y));
    return 0.5f * z * (1.0f + th);
}
__device__ __forceinline__ void unpack8(const uint4 v, float (&f)[8]) {
    f[0] = bflo(v.x); f[1] = bfhi(v.x); f[2] = bflo(v.y); f[3] = bfhi(v.y); f[4] = bflo(v.z); f[5] = bfhi(v.z); f[6] = bflo(v.w); f[7] = bfhi(v.w);
}
__device__ __forceinline__ void stage_peer_naive(Frame& F) {
    const int gw = F.bid * NWAVES + F.wave, NGW = F.G * NWAVES, lane = F.lane;
    for (int t = gw; t < T; t += NGW) {
        const float rstd = row_rstd(F.PSQ, t);
        float xa[8], xb[8];
        unpack8(*(const uint4*)(F.HB + (size_t)t * D + 8 * lane), xa);
        unpack8(*(const uint4*)(F.HB + (size_t)t * D + 512 + 8 * lane), xb);
        const int id0 = F.IDX[(size_t)t * 128 + lane], id1 = F.IDX[(size_t)t * 128 + 64 + lane];
        const float g0 = F.GW[(size_t)t * 128 + lane], g1 = F.GW[(size_t)t * 128 + 64 + lane];
        float acc[16];
#pragma unroll
        for (int i = 0; i < 16; ++i) acc[i] = 0.f;
        for (int k = 0; k < 128; ++k) {
            const int e = __shfl(k < 64 ? id0 : id1, k & 63);
            const float gk = __shfl(k < 64 ? g0 : g1, k & 63);
            float ua[8], ub[8];
            unpack8(*(const uint4*)(F.Ub + (size_t)e * D + 8 * lane), ua);
            unpack8(*(const uint4*)(F.Ub + (size_t)e * D + 512 + 8 * lane), ub);
            float dot = 0.f;
#pragma unroll
            for (int i = 0; i < 8; ++i) dot += ua[i] * xa[i] + ub[i] * xb[i];
            dot = wave_sum(dot);
            const float c = gk * gelu_tanh(dot * rstd);
            float va[8], vb[8];
            unpack8(*(const uint4*)(F.Vb + (size_t)e * D + 8 * lane), va);
            unpack8(*(const uint4*)(F.Vb + (size_t)e * D + 512 + 8 * lane), vb);
#pragma unroll
            for (int i = 0; i < 8; ++i) { acc[i] += c * va[i]; acc[8 + i] += c * vb[i]; }
        }
        float* orow = F.out + (size_t)t * D;
        const float4 h0 = *(const float4*)(orow + 8 * lane), h1 = *(const float4*)(orow + 8 * lane + 4), h2 = *(const float4*)(orow + 512 + 8 * lane), h3 = *(const float4*)(orow + 512 + 8 * lane + 4);
        float y[16] = {h0.x + acc[0], h0.y + acc[1], h0.z + acc[2], h0.w + acc[3], h1.x + acc[4], h1.y + acc[5], h1.z + acc[6], h1.w + acc[7],
                       h2.x + acc[8], h2.y + acc[9], h2.z + acc[10], h2.w + acc[11], h3.x + acc[12], h3.y + acc[13], h3.z + acc[14], h3.w + acc[15]};
        float ss = 0.f;
#pragma unroll
        for (int i = 0; i < 16; ++i) ss += y[i] * y[i];
        const float r = 1.0f / sqrtf(wave_sum(ss) * (1.f / D) + RMS_EPS);
        const float4 w0 = *(const float4*)(F.nfin + 8 * lane), w1 = *(const float4*)(F.nfin + 8 * lane + 4), w2 = *(const float4*)(F.nfin + 512 + 8 * lane), w3 = *(const float4*)(F.nfin + 512 + 8 * lane + 4);
        *(float4*)(orow + 8 * lane) = make_float4(y[0] * r * w0.x, y[1] * r * w0.y, y[2] * r * w0.z, y[3] * r * w0.w);
        *(float4*)(orow + 8 * lane + 4) = make_float4(y[4] * r * w1.x, y[5] * r * w1.y, y[6] * r * w1.z, y[7] * r * w1.w);
        *(float4*)(orow + 512 + 8 * lane) = make_float4(y[8] * r * w2.x, y[9] * r * w2.y, y[10] * r * w2.z, y[11] * r * w2.w);
        *(float4*)(orow + 512 + 8 * lane + 4) = make_float4(y[12] * r * w3.x, y[13] * r * w3.y, y[14] * r * w3.z, y[15] * r * w3.w);
    }
}

constexpr int N_PHASES = 11;
__global__ void __launch_bounds__(NTHREADS, 2) mk_fwd(Args args) {
    extern __shared__ __attribute__((aligned(16))) unsigned char lds[];
    Frame F;
    F.lds = lds;
    F.tid = threadIdx.x; F.lane = F.tid & 63; F.wave = __builtin_amdgcn_readfirstlane(F.tid >> 6);
    F.G = gridDim.x; F.bid = blockIdx.x;
    F.x = args.in[0]; F.nmw = args.in[1]; F.w_in = args.in[2]; F.lbp = args.in[3]; F.hnw = args.in[4]; F.dlam = args.in[5]; F.dnw = args.in[6];
    F.w_out = args.in[7]; F.nfw = args.in[8]; F.wq = args.in[9]; F.sk = args.in[10]; F.u = args.in[11]; F.v = args.in[12]; F.nfin = args.in[13];
    F.out = args.out;
    unsigned char* ws = args.ws;
    F.WinT = (bf16*)(ws + WS_WIN); F.WoT = (bf16*)(ws + WS_WO); F.WqT = (bf16*)(ws + WS_WQ); F.SKb = (bf16*)(ws + WS_SK);
    F.Ub = (bf16*)(ws + WS_UB); F.Vb = (bf16*)(ws + WS_VB); F.XN = (bf16*)(ws + WS_XN); F.MIX = (bf16*)(ws + WS_MIX);
    F.PROJ = (bf16*)(ws + WS_PROJ); F.HB = (bf16*)(ws + WS_HB); F.QH = (bf16*)(ws + WS_QH);
    F.HA = (float*)(ws + WS_HA); F.HO = (float*)(ws + WS_HO); F.TMPO = (float*)(ws + WS_TMPO); F.PSQ = (float*)(ws + WS_PSQ); F.GW = (float*)(ws + WS_G);
    F.IDX = (int*)(ws + WS_IDX);
    const int lo = args.ph_lo, hi = args.ph_hi;
#define IN(k) (lo <= (k) && (k) < hi)
    if (IN(0)) stage_prep(F);
    if (IN(1)) { Epi1 e{F.PROJ, F.HA, F.lbp}; gemm_naive(F, F.XN, F.WinT, T, DIN, D, e); }
    if (IN(2)) stage_hgrn_naive(F);
    if (IN(3)) stage_hgrn_fin(F);
    if (IN(4)) stage_attn_naive(F);
    if (IN(5)) stage_attn_fin(F);
    if (IN(6)) { Epi3 e{F.x, F.out, F.HB}; gemm_naive(F, F.MIX, F.WoT, T, D, D, e); }
    if (IN(7)) stage_rowstat(F);
    if (IN(8)) { Epi4 e{F.QH}; gemm_naive(F, F.HB, F.WqT, T, 2048, D, e); }
    if (IN(9)) stage_topk_naive(F);
    if (IN(10)) stage_peer_naive(F);
#undef IN
}

extern "C" void kernel_launch(void* const* d_in, const int* in_sizes, int n_in, void* d_out, int out_size, void* d_ws, size_t ws_size, hipStream_t stream) {
    static int grid = 0;
    if (grid == 0) {
        if (n_in != 14 || in_sizes[0] != T * D || out_size != T * D || ws_size < WS_END) {
            fprintf(stderr, "kernel_launch: unexpected shapes: n_in %d in0 %d out %d ws %zu (need %zu)\n", n_in, n_in > 0 ? in_sizes[0] : -1, out_size, ws_size, (size_t)WS_END);
            grid = -1; return; }
        int dev = 0, cus = 0;
        if (hipGetDevice(&dev) != hipSuccess || hipDeviceGetAttribute(&cus, hipDeviceAttributeMultiprocessorCount, dev) != hipSuccess) { grid = -1; return; }
        if (hipFuncSetAttribute((const void*)mk_fwd, hipFuncAttributeMaxDynamicSharedMemorySize, LDS_BYTES) != hipSuccess) { fprintf(stderr, "kernel_launch: hipFuncSetAttribute failed\n"); grid = -1; return; }
        (void)hipGetLastError();
        grid = cus;
    }
    if (grid < 0) return;
    Args a{};
    for (int i = 0; i < 14; ++i) a.in[i] = (const float*)d_in[i];
    a.out = (float*)d_out; a.ws = (unsigned char*)d_ws;
    for (int p = 0; p < N_PHASES; ++p) {
        a.ph_lo = p; a.ph_hi = p + 1;
        hipLaunchKernelGGL(mk_fwd, dim3(grid), dim3(NTHREADS), LDS_BYTES, stream, a);
    }
}
```

```cpp
#include <hip/hip_runtime.h>
#include <cstdio>
#include <cstdint>

constexpr int BATCH = 8, SEQ = 4096, T = BATCH * SEQ, D = 1024, DIN = 3584;
constexpr int NEXP = 16384;
constexpr float RMS_EPS = 1e-6f;
constexpr int NWAVES = 8, NTHREADS = NWAVES * 64;

constexpr int C_HQ = 0, C_HF = 512, C_HI = 1024, C_HG = 1536, C_AQ = 2048, C_AK = 2560, C_AV = 3072;

constexpr size_t MiB = 1u << 20;
constexpr size_t WS_CTL = 0;
constexpr size_t WS_WIN = 2 * MiB;
constexpr size_t WS_WO = 9 * MiB;
constexpr size_t WS_WQ = 11 * MiB;
constexpr size_t WS_SK = 15 * MiB;
constexpr size_t WS_U8 = 16 * MiB;
constexpr size_t WS_V8 = 32 * MiB;
constexpr size_t WS_US = 48 * MiB;
constexpr size_t WS_XN = 80 * MiB;
constexpr size_t WS_MIX = 80 * MiB;
constexpr size_t WS_PROJ = 144 * MiB;
constexpr size_t WS_HA = 368 * MiB;
constexpr size_t WS_HO = 432 * MiB;
constexpr size_t WS_PSQ = 496 * MiB;
constexpr size_t WS_HB = 144 * MiB;
constexpr size_t WS_QH = 208 * MiB;
constexpr size_t WS_IDX = 336 * MiB;
constexpr size_t WS_G = 352 * MiB;
constexpr size_t WS_DECG = 498 * MiB;
constexpr size_t WS_END = 499 * MiB;

constexpr int LDS_BYTES = 147456;
constexpr int MISC_OFF = 139520 + 64;

typedef unsigned short bf16;
#define LAS __attribute__((address_space(3)))

__device__ __forceinline__ unsigned f2bf(float f) { unsigned u = __builtin_bit_cast(unsigned, f); return (u + 0x7fffu + ((u >> 16) & 1u)) >> 16; }
__device__ __forceinline__ unsigned pk2(float lo, float hi) { return f2bf(lo) | (f2bf(hi) << 16); }
__device__ __forceinline__ float bf2f(unsigned b) { return __builtin_bit_cast(float, b << 16); }
__device__ __forceinline__ float bflo(unsigned w) { return __builtin_bit_cast(float, w << 16); }
__device__ __forceinline__ float bfhi(unsigned w) { return __builtin_bit_cast(float, w & 0xffff0000u); }
__device__ __forceinline__ float wave_sum(float v) {
#pragma unroll
    for (int o = 1; o < 64; o <<= 1) v += __shfl_xor(v, o);
    return v;
}


#define GAS __attribute__((address_space(1)))
typedef GAS unsigned gu32;
#define RLX_AGENT __ATOMIC_RELAXED, __HIP_MEMORY_SCOPE_AGENT
#define XB_TMO      128
#define XB_XCNT(j)  (256  + 64 * (j))
#define XB_XSUB(j)  (1280 + 64 * (j))
#define XB_XGEN(j)  (2304 + 64 * (j))
#define XB_TOP      3328
#define XB_TOPGEN   3392
#define XCD_BAR_WORDS 3456
#define XB_SPIN_CAP (1u << 22)
__device__ __forceinline__ unsigned xb_ld(unsigned* p)              { return __hip_atomic_load(p, __ATOMIC_RELAXED, __HIP_MEMORY_SCOPE_AGENT); }
__device__ __forceinline__ unsigned xb_add(unsigned* p, unsigned v) { return __hip_atomic_fetch_add(p, v, __ATOMIC_RELAXED, __HIP_MEMORY_SCOPE_AGENT); }
__device__ __forceinline__ unsigned xb_xcc_id() { return (unsigned)__builtin_amdgcn_s_getreg((3 << 11) | 20) & 0xFu; }
#define XB_SPIN(cond, bar) do { unsigned _sp = 0; while (cond) { __builtin_amdgcn_s_sleep(1); \
    if ((++_sp & 255u) == 0u) { if (xb_ld(&(bar)[XB_TMO])) break; if (_sp > XB_SPIN_CAP) { atomicAdd(&(bar)[XB_TMO], 1u); break; } } } } while (0)
struct XcdBarrier { unsigned* bar; unsigned x; volatile LAS unsigned* st; };
__device__ __forceinline__ XcdBarrier xcd_barrier_post(unsigned* bar, volatile LAS unsigned* st) {
    XcdBarrier b; b.bar = bar; b.x = xb_xcc_id(); b.st = st;
    if (threadIdx.x == 0) (void)xb_add(&bar[XB_XCNT(b.x)], 1u);
    return b;
}
__device__ __forceinline__ void xcd_barrier_complete(unsigned* bar, unsigned x, unsigned& nloc, unsigned& nx) {
    const unsigned G = gridDim.x * gridDim.y * gridDim.z;
    unsigned sum, cnt, mine, sp = 0u;
    for (;;) {
        sum = 0u; cnt = 0u; mine = 0u;
#pragma unroll
        for (unsigned j = 0; j < 16; ++j) { const unsigned c = xb_ld(&bar[XB_XCNT(j)]); sum += c; cnt += (c > 0u) ? 1u : 0u; mine = (j == x) ? c : mine; }
        if (sum == G) break;
        __builtin_amdgcn_s_sleep(1);
        if ((++sp & 255u) == 0u) { if (xb_ld(&bar[XB_TMO])) break; if (sp > XB_SPIN_CAP) { atomicAdd(&bar[XB_TMO], 1u); break; } }
    }
    nloc = mine > 0u ? mine : 1u; nx = cnt > 0u ? cnt : 1u;
}
__device__ __forceinline__ void xcd_barrier(const XcdBarrier& b) {
    asm volatile("s_waitcnt vmcnt(0)" ::: "memory");
    __syncthreads();
    if (threadIdx.x == 0) {
        unsigned* bar = b.bar;
        __builtin_amdgcn_s_waitcnt(0);
        unsigned nloc = b.st[0], nx = b.st[1];
        if (nloc == 0u) { xcd_barrier_complete(bar, b.x, nloc, nx); b.st[0] = nloc; b.st[1] = nx; }
        const unsigned old = xb_add(&bar[XB_XSUB(b.x)], 1u);
        const unsigned gen = old / nloc;
        if (old + 1u == (gen + 1u) * nloc) {
            __builtin_amdgcn_fence(__ATOMIC_RELEASE, "agent");
            asm volatile("s_waitcnt vmcnt(0)" ::: "memory");
            const unsigned og = xb_add(&bar[XB_TOP], 1u);
            const unsigned tg = og / nx;
            if (og + 1u == (tg + 1u) * nx) xb_add(&bar[XB_TOPGEN], 1u);
            else XB_SPIN(xb_ld(&bar[XB_TOPGEN]) == tg, bar);
            __builtin_amdgcn_fence(__ATOMIC_ACQUIRE, "agent");
            xb_add(&bar[XB_XGEN(b.x)], 1u);
            asm volatile("s_waitcnt vmcnt(0)" ::: "memory");
        } else {
            XB_SPIN(xb_ld(&bar[XB_XGEN(b.x)]) == gen, bar);
            __builtin_amdgcn_fence(__ATOMIC_ACQUIRE, "agent");
            asm volatile("s_waitcnt vmcnt(0)" ::: "memory");
        }
    }
    __syncthreads();
}

__device__ __forceinline__ void xcd_barrier_light(const XcdBarrier& b) {
    __syncthreads();
    if (threadIdx.x == 0) {
        unsigned* bar = b.bar;
        unsigned nloc = b.st[0], nx = b.st[1];
        if (nloc == 0u) { xcd_barrier_complete(bar, b.x, nloc, nx); b.st[0] = nloc; b.st[1] = nx; }
        const unsigned old = xb_add(&bar[XB_XSUB(b.x)], 1u);
        const unsigned gen = old / nloc;
        if (old + 1u == (gen + 1u) * nloc) {
            const unsigned og = xb_add(&bar[XB_TOP], 1u);
            const unsigned tg = og / nx;
            if (og + 1u == (tg + 1u) * nx) xb_add(&bar[XB_TOPGEN], 1u);
            else XB_SPIN(xb_ld(&bar[XB_TOPGEN]) == tg, bar);
            xb_add(&bar[XB_XGEN(b.x)], 1u);
        } else {
            XB_SPIN(xb_ld(&bar[XB_XGEN(b.x)]) == gen, bar);
        }
    }
    __syncthreads();
}

struct Args { const float* in[14]; float* out; unsigned char* ws; int ph_lo, ph_hi; };

struct Frame {
    unsigned char* lds;
    int tid, lane, wave, G, bid;
    const float *x, *nmw, *w_in, *lbp, *hnw, *dlam, *dnw, *w_out, *nfw, *wq, *sk, *u, *v, *nfin;
    float* out;
    bf16 *WinT, *WoT, *WqT, *SKb, *XN, *MIX, *PROJ, *HB, *QH;
    float *HA, *HO, *PSQ, *GW, *US, *DECG;
    int* IDX;
    unsigned char *U8, *V8;
};

__device__ __forceinline__ void transpose_item(const float* W, const float* scale, int K, int N, bf16* WT, float* scr, int item, int lane) {
    const int nblk = N / 32, kb = item / nblk, nb = item % nblk, k0 = 64 * kb, n0 = 32 * nb;
#pragma unroll 8
    for (int i = 0; i < 32; ++i) { const int kk = 2 * i + (lane >> 5); float s = scale ? scale[k0 + kk] : 1.0f; scr[kk * 33 + (lane & 31)] = W[(size_t)(k0 + kk) * N + n0 + (lane & 31)] * s; }
    __builtin_amdgcn_s_waitcnt(0xc07f); asm volatile("" ::: "memory");
    const int c = lane & 7;
#pragma unroll
    for (int j = 0; j < 4; ++j) { const int n = (lane >> 3) + 8 * j; const float* s = scr + (8 * c) * 33 + n;
        uint4 o; o.x = pk2(s[0 * 33], s[1 * 33]); o.y = pk2(s[2 * 33], s[3 * 33]); o.z = pk2(s[4 * 33], s[5 * 33]); o.w = pk2(s[6 * 33], s[7 * 33]);
        *(uint4*)(WT + (size_t)(n0 + n) * K + k0 + 8 * c) = o; }
    __builtin_amdgcn_s_waitcnt(0xc07f); asm volatile("" ::: "memory");
}

template <int CTRL, int RM> __device__ __forceinline__ unsigned qe_umax(unsigned v) { const unsigned t = (unsigned)__builtin_amdgcn_update_dpp(0, (int)v, CTRL, RM, 0xF, false); return v > t ? v : t; }
__device__ __forceinline__ float qe_wave_max(float f) {
    unsigned v = __float_as_uint(f);
    v = qe_umax<0xB1, 0xF>(v); v = qe_umax<0x4E, 0xF>(v); v = qe_umax<0x141, 0xF>(v); v = qe_umax<0x140, 0xF>(v); v = qe_umax<0x142, 0xA>(v); v = qe_umax<0x143, 0xC>(v);
    return __uint_as_float((unsigned)__builtin_amdgcn_readlane((int)v, 63));
}
__device__ __forceinline__ unsigned qe_pack(const float4 a, const float s) {
    const int q0 = (int)rintf(a.x * s), q1 = (int)rintf(a.y * s), q2 = (int)rintf(a.z * s), q3 = (int)rintf(a.w * s);
    return (unsigned)(q0 & 0xff) | ((unsigned)(q1 & 0xff) << 8) | ((unsigned)(q2 & 0xff) << 16) | ((unsigned)(q3 & 0xff) << 24);
}
__device__ __forceinline__ void quant_experts(Frame& F, int e0, int NR) {
    const float4* wr = (const float4*)F.nfw + F.lane;
    const int per = NR / NWAVES;
    for (int i0 = 0; i0 < per; i0 += 4) {
        const int eb = e0 + F.wave * per + i0;
        float4 a[4][4], b[4][4];
#pragma unroll
        for (int r = 0; r < 4; ++r) { const float4* ur = (const float4*)(F.u + (size_t)(eb + r) * D) + F.lane; const float4* vr = (const float4*)(F.v + (size_t)(eb + r) * D) + F.lane;
#pragma unroll
            for (int j = 0; j < 4; ++j) { a[r][j] = ur[64 * j]; b[r][j] = vr[64 * j]; } }
#pragma unroll
        for (int r = 0; r < 4; ++r) {
            float mu = 0.f, mv = 0.f;
#pragma unroll
            for (int j = 0; j < 4; ++j) { const float4 w = wr[64 * j]; a[r][j].x *= w.x; a[r][j].y *= w.y; a[r][j].z *= w.z; a[r][j].w *= w.w;
                mu = fmaxf(mu, fmaxf(fmaxf(fabsf(a[r][j].x), fabsf(a[r][j].y)), fmaxf(fabsf(a[r][j].z), fabsf(a[r][j].w))));
                mv = fmaxf(mv, fmaxf(fmaxf(fabsf(b[r][j].x), fabsf(b[r][j].y)), fmaxf(fabsf(b[r][j].z), fabsf(b[r][j].w)))); }
            mu = qe_wave_max(mu); mv = qe_wave_max(mv);
            const float iu = mu > 0.f ? 127.0f / mu : 0.f, iv = mv > 0.f ? 127.0f / mv : 0.f;
            unsigned* u8 = (unsigned*)(F.U8 + (size_t)(eb + r) * D) + F.lane; unsigned* v8 = (unsigned*)(F.V8 + (size_t)(eb + r) * D) + F.lane;
#pragma unroll
            for (int j = 0; j < 4; ++j) { u8[64 * j] = qe_pack(a[r][j], iu); v8[64 * j] = qe_pack(b[r][j], iv); }
            if (F.lane == 0) { F.US[2 * (eb + r)] = mu * (1.0f / 127.0f); F.US[2 * (eb + r) + 1] = mv * (1.0f / 127.0f); }
        }
    }
}

__device__ __forceinline__ void stage_prep(Frame& F, const int parts = 7) {
    float* scr = (float*)(F.lds + F.wave * 16384);
    const int gw = F.bid * NWAVES + F.wave, NGW = F.G * NWAVES;
    constexpr int I_IN = (D / 64) * (DIN / 32), I_O = (D / 64) * (D / 32), I_Q = (D / 64) * (2048 / 32);
    if (parts & 1) for (int it = gw; it < I_IN + I_O + I_Q; it += NGW) {
        int r = it;
        if (r < I_IN) { transpose_item(F.w_in, nullptr, D, DIN, F.WinT, scr, r, F.lane); continue; } r -= I_IN;
        if (r < I_O) { transpose_item(F.w_out, nullptr, D, D, F.WoT, scr, r, F.lane); continue; } r -= I_O;
        transpose_item(F.wq, F.nfw, D, 2048, F.WqT, scr, r, F.lane);
    }
    const size_t gt = (size_t)F.bid * NTHREADS + F.tid, NGT = (size_t)F.G * NTHREADS;
    if (parts & 2) for (int e = gw; e < NEXP; e += NGW) {
        const float4* ur = (const float4*)(F.u + (size_t)e * D) + F.lane; const float4* vr = (const float4*)(F.v + (size_t)e * D) + F.lane; const float4* wr = (const float4*)F.nfw + F.lane;
        float4 a[4], b[4]; float mu = 0.f, mv = 0.f;
#pragma unroll
        for (int j = 0; j < 4; ++j) { const float4 w = wr[64 * j]; a[j] = ur[64 * j]; b[j] = vr[64 * j]; a[j].x *= w.x; a[j].y *= w.y; a[j].z *= w.z; a[j].w *= w.w;
            mu = fmaxf(mu, fmaxf(fmaxf(fabsf(a[j].x), fabsf(a[j].y)), fmaxf(fabsf(a[j].z), fabsf(a[j].w))));
            mv = fmaxf(mv, fmaxf(fmaxf(fabsf(b[j].x), fabsf(b[j].y)), fmaxf(fabsf(b[j].z), fabsf(b[j].w)))); }
#pragma unroll
        for (int o = 1; o < 64; o <<= 1) { mu = fmaxf(mu, __shfl_xor(mu, o)); mv = fmaxf(mv, __shfl_xor(mv, o)); }
        const float iu = mu > 0.f ? 127.0f / mu : 0.f, iv = mv > 0.f ? 127.0f / mv : 0.f;
        unsigned* u8 = (unsigned*)(F.U8 + (size_t)e * D) + F.lane; unsigned* v8 = (unsigned*)(F.V8 + (size_t)e * D) + F.lane;
#pragma unroll
        for (int j = 0; j < 4; ++j) {
            const int q0 = (int)rintf(a[j].x * iu), q1 = (int)rintf(a[j].y * iu), q2 = (int)rintf(a[j].z * iu), q3 = (int)rintf(a[j].w * iu);
            u8[64 * j] = (unsigned)(q0 & 0xff) | ((unsigned)(q1 & 0xff) << 8) | ((unsigned)(q2 & 0xff) << 16) | ((unsigned)(q3 & 0xff) << 24);
            const int p0 = (int)rintf(b[j].x * iv), p1 = (int)rintf(b[j].y * iv), p2 = (int)rintf(b[j].z * iv), p3 = (int)rintf(b[j].w * iv);
            v8[64 * j] = (unsigned)(p0 & 0xff) | ((unsigned)(p1 & 0xff) << 8) | ((unsigned)(p2 & 0xff) << 16) | ((unsigned)(p3 & 0xff) << 24); }
        if (F.lane == 0) { F.US[2 * e] = mu * (1.0f / 127.0f); F.US[2 * e + 1] = mv * (1.0f / 127.0f); }
    }
    if (parts & 1) for (size_t i = gt; i < (size_t)8 * 2 * 128 * 128 / 8; i += NGT) {
        const float4 c = *(const float4*)(F.sk + i * 8), d = *(const float4*)(F.sk + i * 8 + 4);
        uint4 p; p.x = pk2(c.x, c.y); p.y = pk2(c.z, c.w); p.z = pk2(d.x, d.y); p.w = pk2(d.z, d.w);
        *(uint4*)(F.SKb + i * 8) = p;
    }
    if (parts & 4) {
        float4 wv[4];
#pragma unroll
        for (int j = 0; j < 4; ++j) wv[j] = ((const float4*)F.nmw)[F.lane + 64 * j];
        for (int m = gw; m < T; m += 2 * NGW) {
            const int m1 = m + NGW; const bool has1 = m1 < T;
            const float4* xr0 = (const float4*)(F.x + (size_t)m * D) + F.lane; const float4* xr1 = (const float4*)(F.x + (size_t)(has1 ? m1 : m) * D) + F.lane;
            float4 v0[4], v1[4]; float s0 = 0.f, s1 = 0.f;
#pragma unroll
            for (int j = 0; j < 4; ++j) { v0[j] = xr0[64 * j]; v1[j] = xr1[64 * j]; }
#pragma unroll
            for (int j = 0; j < 4; ++j) { s0 += (v0[j].x * v0[j].x + v0[j].y * v0[j].y) + (v0[j].z * v0[j].z + v0[j].w * v0[j].w); s1 += (v1[j].x * v1[j].x + v1[j].y * v1[j].y) + (v1[j].z * v1[j].z + v1[j].w * v1[j].w); }
#pragma unroll
            for (int o = 1; o < 64; o <<= 1) { s0 += __shfl_xor(s0, o); s1 += __shfl_xor(s1, o); }
            const float r0 = 1.0f / sqrtf(s0 * (1.f / D) + RMS_EPS), r1 = 1.0f / sqrtf(s1 * (1.f / D) + RMS_EPS);
            unsigned long long* o0 = (unsigned long long*)(F.XN + (size_t)m * D) + F.lane; unsigned long long* o1 = (unsigned long long*)(F.XN + (size_t)m1 * D) + F.lane;
#pragma unroll
            for (int j = 0; j < 4; ++j) {
                o0[64 * j] = (unsigned long long)pk2(v0[j].x * r0 * wv[j].x, v0[j].y * r0 * wv[j].y) | ((unsigned long long)pk2(v0[j].z * r0 * wv[j].z, v0[j].w * r0 * wv[j].w) << 32);
                if (has1) o1[64 * j] = (unsigned long long)pk2(v1[j].x * r1 * wv[j].x, v1[j].y * r1 * wv[j].y) | ((unsigned long long)pk2(v1[j].z * r1 * wv[j].z, v1[j].w * r1 * wv[j].w) << 32); }
        }
    }
}

namespace pg8 {
#define PG8_LAS __attribute__((address_space(3)))
typedef unsigned short bf16_t;
typedef short bf16x8 __attribute__((ext_vector_type(8)));
typedef float f32x4 __attribute__((ext_vector_type(4)));
typedef unsigned u32x4 __attribute__((ext_vector_type(4)));
constexpr int BM = 256, BK = 64, HALF = 128, HTB = HALF * BK * 2  , STAGE_BYTES = 8 * HTB, NXCD = 8, WGM = 8;

__host__ __device__ __forceinline__ int lds_byte(int r, int c) { const int st = (r >> 4) * 2 + (c >> 5), rr = r & 15, cc = c & 31, ob = rr * 64 + cc * 2; return st * 1024 + (ob ^ (((ob >> 9) & 1) << 5)); }
__host__ __device__ __forceinline__ void stage_rc(int b, int& R, int& C) { const int st = b / 1024, sb = b % 1024, swz = sb ^ (((sb >> 9) & 1) << 5); R = (st >> 1) * 16 + swz / 64; C = (st & 1) * 32 + (swz % 64) / 2; }
__host__ __device__ __forceinline__ int perm32(int rho) { const int n = rho >> 4, i = rho & 15; return 8 * (i >> 2) + 4 * n + (i & 3); }

struct Unit { int pm, pn; };
struct Gemm { const bf16_t* A; const bf16_t* Bt; int M, N, K; };

struct StaticOrder {
    int nM, nN, nwg, G, c;
    __host__ __device__ void init(int M, int N, int G_, int c_) { nM = M / BM; nN = N / BM; nwg = nM * nN; G = G_; c = c_; }
    __host__ __device__ bool next(int i, Unit& u) const {
        const long L = (long)i * G + c; if (L >= nwg) return false;
        int wgid = (int)L; { const int q = nwg / NXCD, r = nwg % NXCD, xcd = wgid % NXCD, off = wgid / NXCD; wgid = (xcd < r ? xcd * (q + 1) : r * (q + 1) + (xcd - r) * q) + off; }
        const int nig = WGM * nN, gid = wgid / nig, fm = gid * WGM, gsz = (nM - fm) < WGM ? (nM - fm) : WGM;
        u.pm = fm + ((wgid % nig) % gsz); u.pn = (wgid % nig) / gsz; return true;
    }
    __device__ __forceinline__ void a_ready(const Unit&) const {}
    __device__ __forceinline__ void done(const Unit&) const {}
};

__device__ __forceinline__ unsigned cvt_pk_bf16(float lo, float hi) { unsigned r; asm volatile("v_cvt_pk_bf16_f32 %0, %1, %2" : "=v"(r) : "v"(lo), "v"(hi)); return r; }
template <class Epi, class Sched, bool ALIGN_EPI = false, bool SP2 = false>
__device__ __forceinline__ void gemm_phase(PG8_LAS unsigned char* lds, const Gemm g, const Sched& S, const Epi& E) {
    const int tid = threadIdx.x, wid = __builtin_amdgcn_readfirstlane(tid >> 6), lane = tid & 63, wr = wid >> 2, wc = wid & 3, fr = lane & 15, fq = lane >> 4;
    const int K = g.K, nt = K / BK;
    unsigned voffA[2], voffB[2];
#pragma unroll
    for (int i = 0; i < 2; ++i) { int R, C; stage_rc(tid * 16 + i * 8192, R, C); const int Rb = Epi::PERM ? ((R & ~31) + perm32(R & 31)) : R;
        voffA[i] = (unsigned)(R * K + C) * 2u; voffB[i] = (unsigned)(Rb * K + C) * 2u; }
    const size_t kstep = (size_t)(BK * 2);
    const size_t hstep = (size_t)HALF * K * 2;
    const size_t tstep = 2 * hstep;
    const unsigned ldsw = (unsigned)wid * 1024u;
    const int aoff = lds_byte(wr * 64 + fr, fq * 8), boff = lds_byte(wc * 32 + fr, fq * 8);
#define PG8_SA(b, h) (((b) * 2 + (h)) * HTB)
#define PG8_SB(b, h) ((4 + (b) * 2 + (h)) * HTB)
#define PG8_STAGE(bufoff, gbase, voff) do { _Pragma("unroll") for (int _i = 0; _i < 2; ++_i) \
        __builtin_amdgcn_global_load_lds((const unsigned*)((const char*)(gbase) + (voff)[_i]), (PG8_LAS unsigned*)(lds + (bufoff) + ldsw + _i * 8192), 16, 0, 0); } while (0)
#define PG8_LDA(dst, b, h) do { _Pragma("unroll") for (int m = 0; m < 4; ++m) _Pragma("unroll") for (int k = 0; k < 2; ++k) dst[m][k] = *(const PG8_LAS bf16x8*)(lds + PG8_SA(b, h) + aoff + m * 2048 + k * 1024); } while (0)
#define PG8_LDB(dst, b, h) do { _Pragma("unroll") for (int n = 0; n < 2; ++n) _Pragma("unroll") for (int k = 0; k < 2; ++k) dst[n][k] = *(const PG8_LAS bf16x8*)(lds + PG8_SB(b, h) + boff + n * 2048 + k * 1024); } while (0)
#define PG8_MMA(ai, bj, At, Bt) do { __builtin_amdgcn_s_setprio(1); _Pragma("unroll") for (int m = 0; m < 4; ++m) _Pragma("unroll") for (int n = 0; n < 2; ++n) _Pragma("unroll") for (int k = 0; k < 2; ++k) \
        acc[ai][bj][m][n] = __builtin_amdgcn_mfma_f32_16x16x32_bf16(Bt[n][k], At[m][k], acc[ai][bj][m][n], 0, 0, 0); __builtin_amdgcn_s_setprio(0); } while (0)
#define PG8_WAIT_V(n) asm volatile("s_waitcnt vmcnt(" #n ")" ::: "memory")
#define PG8_WAIT_L(n) asm volatile("s_waitcnt lgkmcnt(" #n ")" ::: "memory")
#define PG8_BAR __builtin_amdgcn_s_barrier()
#define PG8_SCHED __builtin_amdgcn_sched_barrier(0)
    Unit cur, nxt; int ui = 0;
    if (!S.next(0, cur)) return;
    f32x4 acc[2][2][4][2];
#pragma unroll
    for (int a = 0; a < 2; ++a)
#pragma unroll
        for (int b = 0; b < 2; ++b)
#pragma unroll
            for (int m = 0; m < 4; ++m)
#pragma unroll
                for (int n = 0; n < 2; ++n) acc[a][b][m][n] = (f32x4){0.f, 0.f, 0.f, 0.f};
    bf16x8 At[4][2], B0[2][2], B1[2][2];
    const char* cA = (const char*)g.A + (size_t)cur.pm * tstep; const char* cB = (const char*)g.Bt + (size_t)cur.pn * tstep;
    S.a_ready(cur);
    if constexpr (SP2) {
        PG8_STAGE(PG8_SB(0, 0), cB, voffB); PG8_STAGE(PG8_SB(0, 1), cB + hstep, voffB); PG8_STAGE(PG8_SA(0, 0), cA, voffA); PG8_STAGE(PG8_SA(0, 1), cA + hstep, voffA);
        if (wr == 1) PG8_BAR;
        PG8_WAIT_V(2); PG8_BAR;
        PG8_STAGE(PG8_SB(1, 0), cB + kstep, voffB); PG8_STAGE(PG8_SA(1, 0), cA + kstep, voffA); PG8_STAGE(PG8_SB(1, 1), cB + hstep + kstep, voffB);
        PG8_WAIT_V(6); PG8_BAR;
    } else {
        PG8_STAGE(PG8_SB(0, 0), cB, voffB); PG8_STAGE(PG8_SA(0, 0), cA, voffA); PG8_STAGE(PG8_SB(0, 1), cB + hstep, voffB); PG8_STAGE(PG8_SA(0, 1), cA + hstep, voffA);
        if (wr == 1) PG8_BAR;
        PG8_WAIT_V(4); PG8_BAR;
        PG8_STAGE(PG8_SB(1, 0), cB + kstep, voffB); PG8_STAGE(PG8_SA(1, 0), cA + kstep, voffA); PG8_STAGE(PG8_SB(1, 1), cB + hstep + kstep, voffB);
        PG8_WAIT_V(6); PG8_BAR;
    }
    for (;;) {
        const bool has_next = S.next(ui + 1, nxt);
        const char* nA = has_next ? (const char*)g.A + (size_t)nxt.pm * tstep : cA; const char* nB = has_next ? (const char*)g.Bt + (size_t)nxt.pn * tstep : cB;
        for (int t = 0; t < nt; t += 2) {
            const bool last = (t == nt - 2);
            const char* a1 = cA + (size_t)(t + 1) * kstep;
            const char* a2 = last ? nA : cA + (size_t)(t + 2) * kstep; const char* b2 = last ? nB : cB + (size_t)(t + 2) * kstep;
            const char* a3 = a2 + kstep; const char* b3 = b2 + kstep;
            if (last && has_next) S.a_ready(nxt);
            if constexpr (SP2) {
            PG8_LDB(B0, 0, 0); PG8_LDB(B1, 0, 1); PG8_SCHED; PG8_LDA(At, 0, 0); PG8_STAGE(PG8_SA(1, 1), a1 + hstep, voffA);
            PG8_WAIT_V(8); PG8_WAIT_L(0); PG8_BAR; PG8_MMA(0, 0, At, B0); PG8_MMA(0, 1, At, B1); PG8_BAR; PG8_SCHED;
            PG8_LDA(At, 0, 1); PG8_STAGE(PG8_SB(0, 0), b2, voffB); PG8_STAGE(PG8_SB(0, 1), b2 + hstep, voffB); PG8_STAGE(PG8_SA(0, 0), a2, voffA);
            PG8_WAIT_V(8); PG8_WAIT_L(0); PG8_BAR; PG8_MMA(1, 0, At, B0); PG8_MMA(1, 1, At, B1); PG8_BAR; PG8_SCHED;
            PG8_LDB(B0, 1, 0); PG8_LDB(B1, 1, 1); PG8_SCHED; PG8_LDA(At, 1, 0); PG8_STAGE(PG8_SA(0, 1), a2 + hstep, voffA);
            PG8_WAIT_V(8); PG8_WAIT_L(0); PG8_BAR; PG8_MMA(0, 0, At, B0); PG8_MMA(0, 1, At, B1); PG8_BAR; PG8_SCHED;
            PG8_LDA(At, 1, 1); PG8_STAGE(PG8_SB(1, 0), b3, voffB); PG8_STAGE(PG8_SB(1, 1), b3 + hstep, voffB); PG8_STAGE(PG8_SA(1, 0), a3, voffA);
            PG8_WAIT_V(8); PG8_WAIT_L(0); PG8_BAR; PG8_MMA(1, 0, At, B0); PG8_MMA(1, 1, At, B1); PG8_BAR; PG8_SCHED;
            } else {
            PG8_LDB(B0, 0, 0); PG8_SCHED; PG8_LDA(At, 0, 0); PG8_STAGE(PG8_SA(1, 1), a1 + hstep, voffA);
            PG8_WAIT_L(8); PG8_BAR; PG8_WAIT_L(0); PG8_MMA(0, 0, At, B0); PG8_BAR; PG8_SCHED;
            PG8_LDB(B1, 0, 1); PG8_STAGE(PG8_SB(0, 0), b2, voffB);
            PG8_BAR; PG8_WAIT_L(0); PG8_MMA(0, 1, At, B1); PG8_BAR;
            PG8_LDA(At, 0, 1); PG8_STAGE(PG8_SA(0, 0), a2, voffA);
            PG8_BAR; PG8_WAIT_L(0); PG8_MMA(1, 0, At, B0); PG8_BAR; PG8_SCHED;
            PG8_STAGE(PG8_SB(0, 1), b2 + hstep, voffB);
            PG8_WAIT_V(6); PG8_BAR; PG8_MMA(1, 1, At, B1); PG8_BAR;
            PG8_LDB(B0, 1, 0); PG8_SCHED; PG8_LDA(At, 1, 0); PG8_STAGE(PG8_SA(0, 1), a2 + hstep, voffA);
            PG8_WAIT_L(8); PG8_BAR; PG8_WAIT_L(0); PG8_MMA(0, 0, At, B0); PG8_BAR; PG8_SCHED;
            PG8_LDB(B1, 1, 1); PG8_STAGE(PG8_SB(1, 0), b3, voffB);
            PG8_BAR; PG8_WAIT_L(0); PG8_MMA(0, 1, At, B1); PG8_BAR;
            PG8_LDA(At, 1, 1); PG8_STAGE(PG8_SA(1, 0), a3, voffA);
            PG8_BAR; PG8_WAIT_L(0); PG8_MMA(1, 0, At, B0); PG8_BAR; PG8_SCHED;
            PG8_STAGE(PG8_SB(1, 1), b3 + hstep, voffB);
            PG8_WAIT_V(6); PG8_BAR; PG8_MMA(1, 1, At, B1); PG8_BAR;
            }
        }
        if constexpr (ALIGN_EPI) { if (wr == 0) PG8_BAR; }
        if constexpr (!Epi::AFTER_DRAIN) { E(acc, cur, wr, wc, fr, fq); S.done(cur); }
        if (!has_next) break;
#pragma unroll
        for (int a = 0; a < 2; ++a)
#pragma unroll
            for (int b = 0; b < 2; ++b)
#pragma unroll
                for (int m = 0; m < 4; ++m)
#pragma unroll
                    for (int n = 0; n < 2; ++n) acc[a][b][m][n] = (f32x4){0.f, 0.f, 0.f, 0.f};
        cur = nxt; cA = nA; cB = nB; ++ui;
        if constexpr (ALIGN_EPI) { if (wr == 1) PG8_BAR; }
    }
    PG8_WAIT_V(0);
    if constexpr (!ALIGN_EPI) { if (wr == 0) PG8_BAR; }
    PG8_BAR;
    if constexpr (Epi::AFTER_DRAIN) { E.fused(acc, cur, wr, wc, fr, fq, lds, wid, lane); S.done(cur); }
#undef PG8_SA
#undef PG8_SB
#undef PG8_STAGE
#undef PG8_LDA
#undef PG8_LDB
#undef PG8_MMA
#undef PG8_WAIT_V
#undef PG8_WAIT_L
#undef PG8_BAR
#undef PG8_SCHED
}
}

__device__ __forceinline__ uint4 pack8(const float (&v)[8]) { uint4 w; w.x = pk2(v[0], v[1]); w.y = pk2(v[2], v[3]); w.z = pk2(v[4], v[5]); w.w = pk2(v[6], v[7]); return w; }
struct EpiIn {
    static constexpr bool PERM = true, AFTER_DRAIN = false;
    bf16* PROJ; float* HA; const float* lbp;
    template <int GRP> __device__ __forceinline__ void run(const pg8::f32x4 (&acc)[2][2][4][2], int row0, int col0, float sc) const {
#pragma unroll
        for (int bj = 0; bj < 2; ++bj) {
            float lb[8];
            if (GRP == 1) {
#pragma unroll
                for (int i = 0; i < 8; ++i) { const int j = col0 - C_HF + bj * 128 + i; lb[i] = 1.0f / (1.0f + __expf(lbp[512 + j] - lbp[j])); }
            }
#pragma unroll
            for (int ai = 0; ai < 2; ++ai)
#pragma unroll
                for (int m = 0; m < 4; ++m) { const size_t row = (size_t)(row0 + ai * 128 + m * 16);
                    float v[8];
#pragma unroll
                    for (int i = 0; i < 4; ++i) { v[i] = acc[ai][bj][m][0][i]; v[4 + i] = acc[ai][bj][m][1][i]; }
                    if (GRP == 0) {
#pragma unroll
                        for (int i = 0; i < 8; ++i) v[i] *= sc;
                    } else if (GRP == 1) {
                        float a[8];
#pragma unroll
                        for (int i = 0; i < 8; ++i) { const float ex = __expf(-fminf(fmaxf(v[i], -30.f), 30.f)); const float sig = 1.0f / (1.0f + ex), omsig = ex * sig;
                            const float f = lb[i] + (1.0f - lb[i]) * sig; a[i] = __log2f(f); v[i] = (1.0f - lb[i]) * omsig; }
                        float4* hp = (float4*)(HA + row * 512 + (col0 - C_HF) + bj * 128);
                        hp[0] = make_float4(a[0], a[1], a[2], a[3]); hp[1] = make_float4(a[4], a[5], a[6], a[7]);
                    } else if (GRP == 3) {
#pragma unroll
                        for (int i = 0; i < 8; ++i) v[i] = v[i] * __builtin_amdgcn_rcpf(1.0f + __expf(-v[i]));
                    }
                    *(uint4*)(PROJ + row * DIN + col0 + bj * 128) = pack8(v);
                    asm volatile("" ::: "memory");
                }
        }
    }
    __device__ __forceinline__ void operator()(const pg8::f32x4 (&acc)[2][2][4][2], const pg8::Unit& u, int wr, int wc, int fr, int fq) const {
        const int row0 = u.pm * 256 + wr * 64 + fr, col0 = u.pn * 256 + wc * 32 + 8 * fq, grp = u.pn >> 1;
        const float sc = (grp == 0) ? 0.08838834764831845f : ((grp == 4) ? 0.18033688011112042f : 1.0f);
        if (grp == 1) run<1>(acc, row0, col0, sc); else if (grp == 3) run<3>(acc, row0, col0, sc); else run<0>(acc, row0, col0, sc);
    }
};
struct EpiOut {
    static constexpr bool PERM = true, AFTER_DRAIN = false;
    const float* x; bf16* HB; float* PSQ;
    __device__ __forceinline__ void operator()(const pg8::f32x4 (&acc)[2][2][4][2], const pg8::Unit& u, int wr, int wc, int fr, int fq) const {
        const int row0 = u.pm * 256 + wr * 64 + fr, col0 = u.pn * 256 + wc * 32 + 8 * fq;
#pragma unroll
        for (int ai = 0; ai < 2; ++ai) {
            float4 xv[4][2][2];
#pragma unroll
            for (int m = 0; m < 4; ++m)
#pragma unroll
                for (int bj = 0; bj < 2; ++bj) { const size_t off = (size_t)(row0 + ai * 128 + m * 16) * D + col0 + bj * 128;
                    xv[m][bj][0] = *(const float4*)(x + off); xv[m][bj][1] = *(const float4*)(x + off + 4); }
#pragma unroll
            for (int m = 0; m < 4; ++m) { const size_t row = (size_t)(row0 + ai * 128 + m * 16); float ss = 0.f;
#pragma unroll
                for (int bj = 0; bj < 2; ++bj) { const size_t off = row * D + col0 + bj * 128;
                    const float4 x0 = xv[m][bj][0], x1 = xv[m][bj][1];
                    float h[8] = {x0.x + acc[ai][bj][m][0][0], x0.y + acc[ai][bj][m][0][1], x0.z + acc[ai][bj][m][0][2], x0.w + acc[ai][bj][m][0][3],
                                  x1.x + acc[ai][bj][m][1][0], x1.y + acc[ai][bj][m][1][1], x1.z + acc[ai][bj][m][1][2], x1.w + acc[ai][bj][m][1][3]};
                    *(uint4*)(HB + off) = pack8(h);
#pragma unroll
                    for (int i = 0; i < 8; ++i) ss += h[i] * h[i]; }
                ss += __shfl_xor(ss, 16); ss += __shfl_xor(ss, 32);
                if (fq == 0) PSQ[row * 16 + u.pn * 4 + wc] = ss; }
            asm volatile("" ::: "memory");
        }
    }
};
struct EpiQ {
    static constexpr bool PERM = true, AFTER_DRAIN = false;
    bf16* QH;
    __device__ __forceinline__ void operator()(const pg8::f32x4 (&acc)[2][2][4][2], const pg8::Unit& u, int wr, int wc, int fr, int fq) const {
        const int row0 = u.pm * 256 + wr * 64 + fr, col0 = u.pn * 256 + wc * 32 + 8 * fq;
#pragma unroll
        for (int ai = 0; ai < 2; ++ai)
#pragma unroll
            for (int m = 0; m < 4; ++m) { const size_t row = (size_t)(row0 + ai * 128 + m * 16);
#pragma unroll
                for (int bj = 0; bj < 2; ++bj) { float v[8];
#pragma unroll
                    for (int i = 0; i < 4; ++i) { v[i] = acc[ai][bj][m][0][i]; v[4 + i] = acc[ai][bj][m][1][i]; }
                    *(uint4*)(QH + row * 2048 + col0 + bj * 128) = pack8(v); } }
    }
};

__device__ __forceinline__ float compute_lambda(const float* dl, int lane) {
    const float sa = wave_sum(dl[lane] * dl[64 + lane]), sb = wave_sum(dl[128 + lane] * dl[192 + lane]);
    return __expf(sa) - __expf(sb) + 0.2f;
}
namespace hg {
typedef short bf16x8 __attribute__((ext_vector_type(8)));
typedef short s16x4 __attribute__((ext_vector_type(4)));
typedef float f32x4 __attribute__((ext_vector_type(4)));
typedef unsigned u32x4 __attribute__((ext_vector_type(4)));
typedef unsigned u32x2 __attribute__((ext_vector_type(2)));
typedef float f32x2 __attribute__((ext_vector_type(2)));
constexpr int QT = 0, KT = 16384, VT = 32768, AT = 49152, PT = 81920, OT = 90112, SEG = 122880, DEC = 126976;
__device__ __forceinline__ int swzA(int row) { return row & 15; }
__device__ __forceinline__ int swzB(int row) { return ((row & 3) << 1) | (((row >> 3) & 1) << 3); }
__device__ __forceinline__ int swzP(int row) { return (((row >> 1) & 1) << 1) | (((row >> 3) & 1) << 2); }
__device__ __forceinline__ s16x4 vtr(const LAS unsigned char* p) { return __builtin_bit_cast(s16x4, __builtin_amdgcn_ds_read_tr16_b64_v4i16((LAS s16x4*)p)); }
__device__ __forceinline__ bf16x8 cat(s16x4 a, s16x4 b) { return (bf16x8){a[0], a[1], a[2], a[3], b[0], b[1], b[2], b[3]}; }
__device__ __forceinline__ unsigned cvtpk(float lo, float hi) { typedef float f2 __attribute__((ext_vector_type(2))); typedef __bf16 b2 __attribute__((ext_vector_type(2))); f2 v = {lo, hi}; b2 b = __builtin_convertvector(v, b2); return __builtin_bit_cast(unsigned, b); }

__device__ __forceinline__ void hgrn_pre(Frame& F, int task) {
    LAS unsigned char* lds = (LAS unsigned char*)F.lds;
    const int tid = F.tid, lane = F.lane, w = F.wave, c16 = lane & 15, g = lane >> 4, q4 = c16 >> 2, p4 = c16 & 3;
    const int c = task & 63, h = (task >> 6) & 3, b = task >> 8;
    const size_t row0 = (size_t)b * SEQ + (size_t)c * 64;
    const int srow = tid >> 4, sch = tid & 15;
#pragma unroll
    for (int i = 0; i < 2; ++i) { const int row = srow + 32 * i; const bf16* rp = F.PROJ + (row0 + row) * DIN + h * 128 + sch * 8;
        *(LAS u32x4*)(lds + QT + row * 256 + ((sch ^ swzA(row)) << 4)) = *(const u32x4*)(rp + C_HQ);
        *(LAS u32x4*)(lds + KT + row * 256 + ((sch ^ swzB(row)) << 4)) = *(const u32x4*)(rp + C_HF);
        *(LAS u32x4*)(lds + VT + row * 256 + ((sch ^ swzB(row)) << 4)) = *(const u32x4*)(rp + C_HI); }
#pragma unroll
    for (int i = 0; i < 4; ++i) { const int p = tid + 512 * i; *(LAS u32x4*)(lds + AT + (p >> 5) * 512 + (p & 31) * 16) = *(const u32x4*)(F.HA + (row0 + (p >> 5)) * 512 + h * 128 + (p & 31) * 4); }
    __syncthreads();
    {
        const int dp = tid & 63, ts = tid >> 6, d = 2 * dp;
        const LAS float* at = (const LAS float*)(lds + AT);
        LAS float* seg = (LAS float*)(lds + SEG);
        float cs0[8], cs1[8]; float r0 = 0.f, r1 = 0.f;
#pragma unroll
        for (int tt = 0; tt < 8; ++tt) { const f32x2 a = *(const LAS f32x2*)(at + (8 * ts + tt) * 128 + d); r0 += a.x; r1 += a.y; cs0[tt] = r0; cs1[tt] = r1; }
        *(LAS f32x2*)(seg + ts * 128 + d) = (f32x2){r0, r1};
        __syncthreads();
        float off0 = 0.f, off1 = 0.f, bl0 = 0.f, bl1 = 0.f;
#pragma unroll
        for (int k = 0; k < 8; ++k) { const f32x2 s = *(const LAS f32x2*)(seg + k * 128 + d); if (k < ts) { off0 += s.x; off1 += s.y; } bl0 += s.x; bl1 += s.y; }
        if (ts == 0) *(f32x2*)(F.DECG + ((size_t)(b * 64 + c) * 4 + h) * 128 + d) = (f32x2){__builtin_amdgcn_exp2f(fmaxf(bl0, -120.f)), __builtin_amdgcn_exp2f(fmaxf(bl1, -120.f))};
#pragma unroll
        for (int tt = 0; tt < 8; ++tt) { const int t = 8 * ts + tt;
            const float x0 = (off0 + cs0[tt]) - bl0, x1 = (off1 + cs1[tt]) - bl1;
            const float eq0 = __builtin_amdgcn_exp2f(fminf(x0, 120.f)), eq1 = __builtin_amdgcn_exp2f(fminf(x1, 120.f));
            const float ek0 = __builtin_amdgcn_exp2f(fmaxf(-x0, -120.f)), ek1 = __builtin_amdgcn_exp2f(fmaxf(-x1, -120.f));
            LAS unsigned* pq = (LAS unsigned*)(lds + QT + t * 256 + (((d >> 3) ^ swzA(t)) << 4) + (d & 7) * 2);
            LAS unsigned* pk = (LAS unsigned*)(lds + KT + t * 256 + (((d >> 3) ^ swzB(t)) << 4) + (d & 7) * 2);
            const unsigned qv = *pq, kv = *pk;
            *pq = cvtpk(bflo(qv) * eq0, bfhi(qv) * eq1); *pk = cvtpk(bflo(kv) * ek0, bfhi(kv) * ek1); }
    }
    __syncthreads();
#pragma unroll
    for (int i = 0; i < 2; ++i) { const int row = srow + 32 * i; bf16* rp = F.PROJ + (row0 + row) * DIN + h * 128 + sch * 8;
        *(u32x4*)(rp + C_HQ) = *(const LAS u32x4*)(lds + QT + row * 256 + ((sch ^ swzA(row)) << 4));
        *(u32x4*)(rp + C_HF) = *(const LAS u32x4*)(lds + KT + row * 256 + ((sch ^ swzB(row)) << 4)); }
#pragma unroll
    for (int rep = 0; rep < 2; ++rep) {
        const int idx = w + 8 * rep;
        if (idx < 12) {
            int tb, sb; bool zero = false;
            if (idx == 10) { tb = 0; sb = 1; zero = true; } else if (idx == 11) { tb = 2; sb = 3; zero = true; }
            else { tb = (idx >= 6) ? 3 : (idx >= 3) ? 2 : (idx >= 1) ? 1 : 0; sb = idx - (tb * (tb + 1)) / 2; }
            f32x4 acc = (f32x4){0.f, 0.f, 0.f, 0.f};
            if (!zero) {
                const int tr = 16 * tb + c16, sr = 16 * sb + c16;
#pragma unroll
                for (int ks = 0; ks < 4; ++ks) {
                    const bf16x8 a = *(const LAS bf16x8*)(lds + QT + tr * 256 + (((4 * ks + g) ^ swzA(tr)) << 4));
                    const bf16x8 bb = *(const LAS bf16x8*)(lds + KT + sr * 256 + (((4 * ks + g) ^ swzB(sr)) << 4));
                    acc = __builtin_amdgcn_mfma_f32_16x16x32_bf16(a, bb, acc, 0, 0, 0);
                }
                if (tb == sb) {
#pragma unroll
                    for (int r = 0; r < 4; ++r) if (c16 > 4 * g + r) acc[r] = 0.f;
                }
            }
            const int s = 16 * sb + c16;
            u32x2 pk; pk.x = cvtpk(acc[0], acc[1]); pk.y = cvtpk(acc[2], acc[3]);
            *(LAS u32x2*)(lds + PT + s * 128 + (((2 * tb + (g >> 1)) ^ swzP(s)) << 4) + (g & 1) * 8) = pk;
        }
    }
    __syncthreads();
    bf16x8 Vf[2];
#pragma unroll
    for (int ks2 = 0; ks2 < 2; ++ks2) {
        const int r0 = 32 * ks2 + 8 * g + q4, r1 = r0 + 4;
        Vf[ks2] = cat(vtr(lds + VT + r0 * 256 + (((2 * w + (p4 >> 1)) ^ swzB(r0)) << 4) + (p4 & 1) * 8), vtr(lds + VT + r1 * 256 + (((2 * w + (p4 >> 1)) ^ swzB(r1)) << 4) + (p4 & 1) * 8));
    }
    LAS float* ot = (LAS float*)(lds + OT);
#pragma unroll
    for (int tb = 0; tb < 4; ++tb) {
        f32x4 O = (f32x4){0.f, 0.f, 0.f, 0.f};
#pragma unroll
        for (int ks2 = 0; ks2 < 2; ++ks2) {
            if (ks2 <= (tb >> 1)) {
                const int r0 = 32 * ks2 + 8 * g + q4, r1 = r0 + 4;
                const s16x4 lo = vtr(lds + PT + r0 * 128 + (((2 * tb + (p4 >> 1)) ^ swzP(r0)) << 4) + (p4 & 1) * 8);
                const s16x4 hh = vtr(lds + PT + r1 * 128 + (((2 * tb + (p4 >> 1)) ^ swzP(r1)) << 4) + (p4 & 1) * 8);
                O = __builtin_amdgcn_mfma_f32_16x16x32_bf16(cat(lo, hh), Vf[ks2], O, 0, 0, 0);
            }
        }
#pragma unroll
        for (int r = 0; r < 4; ++r) ot[(16 * tb + 4 * g + r) * 128 + 16 * w + c16] = O[r];
    }
    __syncthreads();
#pragma unroll
    for (int i = 0; i < 4; ++i) { const int p = tid + 512 * i; *(u32x4*)(F.HO + (row0 + (p >> 5)) * 512 + h * 128 + (p & 31) * 4) = *(const LAS u32x4*)(lds + OT + (p >> 5) * 512 + (p & 31) * 16); }
    __syncthreads();
}

__device__ __forceinline__ void hgrn_scan(Frame& F, int b, int h) {
    LAS unsigned char* lds = (LAS unsigned char*)F.lds;
    const int tid = F.tid, lane = F.lane, w = F.wave;
    const size_t row0 = (size_t)b * SEQ;
    f32x4 S[8];
#pragma unroll
    for (int i = 0; i < 8; ++i) S[i] = (f32x4){0.f, 0.f, 0.f, 0.f};
    u32x4 sq[2], sk[2], sv[2], so[4], sgn[2]; float sdec = 0.f;
    const int srow = tid >> 4, sch = tid & 15;
    float hw[8];
    { const float4 a = *(const float4*)(F.hnw + sch * 8), bq = *(const float4*)(F.hnw + sch * 8 + 4); hw[0] = a.x; hw[1] = a.y; hw[2] = a.z; hw[3] = a.w; hw[4] = bq.x; hw[5] = bq.y; hw[6] = bq.z; hw[7] = bq.w; }
#define HG_LOAD(c) do { _Pragma("unroll") for (int i = 0; i < 2; ++i) { const bf16* rp = F.PROJ + (row0 + (size_t)(c) * 64 + srow + 32 * i) * DIN + h * 128 + sch * 8; \
        sq[i] = *(const u32x4*)(rp + C_HQ); sk[i] = *(const u32x4*)(rp + C_HF); sv[i] = *(const u32x4*)(rp + C_HI); sgn[i] = *(const u32x4*)(rp + C_HG); } \
    _Pragma("unroll") for (int i = 0; i < 4; ++i) { const int p = tid + 512 * i; so[i] = *(const u32x4*)(F.HO + (row0 + (size_t)(c) * 64 + (p >> 5)) * 512 + h * 128 + (p & 31) * 4); } \
    if (tid < 128) sdec = F.DECG[((size_t)(b * 64 + (c)) * 4 + h) * 128 + tid]; } while (0)
    HG_LOAD(0);
    for (int c = 0; c < SEQ / 64; ++c) {
        int lz = lane; asm volatile("" : "+v"(lz));
        const int c16 = lz & 15, g = lz >> 4, q4 = c16 >> 2, p4 = c16 & 3;
        u32x4 sgt[2]; sgt[0] = sgn[0]; sgt[1] = sgn[1];
#pragma unroll
        for (int i = 0; i < 2; ++i) { const int row = srow + 32 * i;
            *(LAS u32x4*)(lds + QT + row * 256 + ((sch ^ swzA(row)) << 4)) = sq[i];
            *(LAS u32x4*)(lds + KT + row * 256 + ((sch ^ swzB(row)) << 4)) = sk[i];
            *(LAS u32x4*)(lds + VT + row * 256 + ((sch ^ swzB(row)) << 4)) = sv[i]; }
#pragma unroll
        for (int i = 0; i < 4; ++i) { const int p = tid + 512 * i; *(LAS u32x4*)(lds + OT + (p >> 5) * 512 + (p & 31) * 16) = so[i]; }
        if (tid < 128) ((LAS float*)(lds + DEC))[tid] = sdec;
        __syncthreads();
        if (c + 1 < SEQ / 64) HG_LOAD(c + 1);
        bf16x8 Bf[4];
        {
            const LAS float* dec = (const LAS float*)(lds + DEC);
#pragma unroll
            for (int db = 0; db < 8; ++db) { const f32x4 dv = *(const LAS f32x4*)(dec + 16 * db + 4 * g); S[db] = S[db] * dv; }
#pragma unroll
            for (int ks = 0; ks < 4; ++ks) { u32x4 t; t.x = cvtpk(S[2 * ks][0], S[2 * ks][1]); t.y = cvtpk(S[2 * ks][2], S[2 * ks][3]); t.z = cvtpk(S[2 * ks + 1][0], S[2 * ks + 1][1]); t.w = cvtpk(S[2 * ks + 1][2], S[2 * ks + 1][3]);
                Bf[ks] = __builtin_bit_cast(bf16x8, t); }
        }
        LAS float* ot = (LAS float*)(lds + OT);
#pragma unroll
        for (int tb = 0; tb < 4; ++tb) {
            f32x4 O;
#pragma unroll
            for (int r = 0; r < 4; ++r) O[r] = ot[(16 * tb + 4 * g + r) * 128 + 16 * w + c16];
            const int tr = 16 * tb + c16;
#pragma unroll
            for (int ks = 0; ks < 4; ++ks) {
                const s16x4 lo = *(const LAS s16x4*)(lds + QT + tr * 256 + (((4 * ks + (g >> 1)) ^ swzA(tr)) << 4) + (g & 1) * 8);
                const s16x4 hh = *(const LAS s16x4*)(lds + QT + tr * 256 + (((4 * ks + 2 + (g >> 1)) ^ swzA(tr)) << 4) + (g & 1) * 8);
                O = __builtin_amdgcn_mfma_f32_16x16x32_bf16(cat(lo, hh), Bf[ks], O, 0, 0, 0);
            }
#pragma unroll
            for (int r = 0; r < 4; ++r) ot[(16 * tb + 4 * g + r) * 128 + 16 * w + c16] = O[r];
        }
        bf16x8 Vf[2];
#pragma unroll
        for (int ks2 = 0; ks2 < 2; ++ks2) {
            const int r0 = 32 * ks2 + 8 * g + q4, r1 = r0 + 4;
            Vf[ks2] = cat(vtr(lds + VT + r0 * 256 + (((2 * w + (p4 >> 1)) ^ swzB(r0)) << 4) + (p4 & 1) * 8), vtr(lds + VT + r1 * 256 + (((2 * w + (p4 >> 1)) ^ swzB(r1)) << 4) + (p4 & 1) * 8));
        }
#pragma unroll
        for (int db = 0; db < 8; ++db)
#pragma unroll
            for (int ks2 = 0; ks2 < 2; ++ks2) {
                const int r0 = 32 * ks2 + 8 * g + q4, r1 = r0 + 4;
                const s16x4 lo = vtr(lds + KT + r0 * 256 + (((2 * db + (p4 >> 1)) ^ swzB(r0)) << 4) + (p4 & 1) * 8);
                const s16x4 hh = vtr(lds + KT + r1 * 256 + (((2 * db + (p4 >> 1)) ^ swzB(r1)) << 4) + (p4 & 1) * 8);
                S[db] = __builtin_amdgcn_mfma_f32_16x16x32_bf16(cat(lo, hh), Vf[ks2], S[db], 0, 0, 0);
            }
        __syncthreads();
#pragma unroll
        for (int i = 0; i < 2; ++i) { const int t = srow + 32 * i; const size_t row = row0 + (size_t)c * 64 + t;
            const f32x4 xa = *(const LAS f32x4*)(ot + t * 128 + sch * 8), xb = *(const LAS f32x4*)(ot + t * 128 + sch * 8 + 4);
            float ss = (xa[0] * xa[0] + xa[1] * xa[1]) + (xa[2] * xa[2] + xa[3] * xa[3]) + (xb[0] * xb[0] + xb[1] * xb[1]) + (xb[2] * xb[2] + xb[3] * xb[3]);
            ss += __builtin_bit_cast(float, __builtin_amdgcn_update_dpp(0, __builtin_bit_cast(int, ss), 0xB1, 0xF, 0xF, false));
            ss += __builtin_bit_cast(float, __builtin_amdgcn_update_dpp(0, __builtin_bit_cast(int, ss), 0x4E, 0xF, 0xF, false));
            ss += __builtin_bit_cast(float, __builtin_amdgcn_update_dpp(0, __builtin_bit_cast(int, ss), 0x141, 0xF, 0xF, false));
            ss += __builtin_bit_cast(float, __builtin_amdgcn_update_dpp(0, __builtin_bit_cast(int, ss), 0x140, 0xF, 0xF, false));
            const float r = 1.0f / sqrtf(ss * (1.f / 128.f) + RMS_EPS);
            const u32x4 gt = sgt[i];
            u32x4 o;
            o.x = cvtpk(xa[0] * r * hw[0] * bflo(gt.x), xa[1] * r * hw[1] * bfhi(gt.x)); o.y = cvtpk(xa[2] * r * hw[2] * bflo(gt.y), xa[3] * r * hw[3] * bfhi(gt.y));
            o.z = cvtpk(xb[0] * r * hw[4] * bflo(gt.z), xb[1] * r * hw[5] * bfhi(gt.z)); o.w = cvtpk(xb[2] * r * hw[6] * bflo(gt.w), xb[3] * r * hw[7] * bfhi(gt.w));
            *(u32x4*)(F.MIX + row * D + h * 128 + sch * 8) = o; }
        __syncthreads();
    }
#undef HG_LOAD
}
}

namespace da {
typedef short bf16x8 __attribute__((ext_vector_type(8)));
typedef short s16x4 __attribute__((ext_vector_type(4)));
typedef float f32x16 __attribute__((ext_vector_type(16)));
constexpr int V_OFF = 16384, BUF_BYTES = 32768;
__device__ __forceinline__ s16x4 vtr(const LAS unsigned char* p) { return __builtin_bit_cast(s16x4, __builtin_amdgcn_ds_read_tr16_b64_v4i16((LAS s16x4*)p)); }
__device__ __forceinline__ unsigned cvtpk(float lo, float hi) { typedef float f2 __attribute__((ext_vector_type(2))); typedef __bf16 b2 __attribute__((ext_vector_type(2))); f2 v = {lo, hi}; b2 b = __builtin_convertvector(v, b2); return __builtin_bit_cast(unsigned, b); }

__device__ __forceinline__ float max3f(float a, float b, float c) { float r; asm("v_max3_f32 %0, %1, %2, %3" : "=v"(r) : "v"(a), "v"(b), "v"(c)); return r; }
__device__ __forceinline__ float exp2_pin(float x) { float y; asm volatile("v_exp_f32_e32 %0, %1" : "=v"(y) : "v"(x)); return y; }
__device__ __forceinline__ float max2f(float a, float b) { float r; asm("v_max_f32_e32 %0, %1, %2" : "=v"(r) : "v"(a), "v"(b)); return r; }
constexpr float RESC_THR = 8.0f;
__device__ __forceinline__ void attn_unit(Frame& F, int b, int h, int qblk, float lam) {
    LAS unsigned char* lds = (LAS unsigned char*)F.lds;
    const int lane = F.lane, r32 = lane & 31, hi = lane >> 5, w = F.wave, rg = w >> 1, map = w & 1;
    const int t0 = qblk * 128 + rg * 32;
    const int ntile_blk = 2 * qblk + 2, ntile_w = 2 * qblk + (rg >> 1) + 1;
    const bf16* base = F.PROJ + (size_t)b * SEQ * DIN;
    const bf16* gk = base + (size_t)(8 * w + (lane >> 3)) * DIN + C_AK + h * 128 + (((lane & 7) ^ ((4 * w + (lane >> 4)) & 7)) * 8);
    const bf16* gv = base + (size_t)(4 * w + (lane >> 4)) * DIN + C_AV + h * 128 + (((lane & 15) ^ ((lane >> 4) << 2)) * 8);
#define DA_DMA(tile, buf) do { const size_t to_ = (size_t)(tile) * 64 * DIN; LAS unsigned char* lb_ = lds + (buf) * BUF_BYTES + w * 1024; \
        __builtin_amdgcn_global_load_lds((const unsigned*)(gk + to_), (LAS unsigned*)(lb_), 16, 0, 0); \
        __builtin_amdgcn_global_load_lds((const unsigned*)(gk + to_ + 64), (LAS unsigned*)(lb_ + 8192), 16, 0, 0); \
        __builtin_amdgcn_global_load_lds((const unsigned*)(gv + to_), (LAS unsigned*)(lb_ + V_OFF), 16, 0, 0); \
        __builtin_amdgcn_global_load_lds((const unsigned*)(gv + to_ + (size_t)32 * DIN), (LAS unsigned*)(lb_ + V_OFF + 8192), 16, 0, 0); } while (0)
    DA_DMA(0, 0); DA_DMA(1, 1);
    if (ntile_blk > 2) DA_DMA(2, 2);
    bf16x8 qr[4];
#pragma unroll
    for (int d0 = 0; d0 < 4; ++d0) qr[d0] = *(const bf16x8*)(base + (size_t)(t0 + r32) * DIN + C_AQ + h * 128 + map * 64 + 16 * d0 + 8 * hi);
    asm volatile("s_waitcnt vmcnt(0)" : "+v"(qr[0]), "+v"(qr[1]), "+v"(qr[2]), "+v"(qr[3]) :: "memory");
    f32x16 o[4], negm;
#pragma unroll
    for (int eb = 0; eb < 4; ++eb)
#pragma unroll
        for (int r = 0; r < 16; ++r) o[eb][r] = 0.f;
#pragma unroll
    for (int r = 0; r < 16; ++r) negm[r] = 0.f;
    float mref = 0.f, l = 0.f;
    const int koff = map * 8192 + r32 * 128;
    const int q4 = (lane & 15) >> 2, p4 = lane & 3, eh = (lane >> 4) & 1;
    int voff[4];
#pragma unroll
    for (int eb = 0; eb < 4; ++eb) voff[eb] = V_OFF + (4 * hi + q4) * 256 + (p4 & 1) * 8 + (((((eb ^ q4) << 2) + 2 * eh + (p4 >> 1))) << 4);
#define DA_KFRAG(slot_, d0_, half_) (*(const LAS bf16x8*)(lds + (slot_) * BUF_BYTES + koff + (half_) * (32 * 128) + ((((2 * (d0_) + hi) ^ ((r32 >> 1) & 7))) << 4)))
#define DA_ROWMAX(c0_, c1_) ({ float a_ = fmaxf(fmaxf(c0_[0], c0_[1]), c1_[0]), b_ = fmaxf(fmaxf(c0_[2], c0_[3]), c1_[1]); a_ = fmaxf(fmaxf(a_, c1_[2]), c1_[3]); \
        _Pragma("unroll") for (int r = 4; r < 16; r += 4) { a_ = fmaxf(fmaxf(a_, c0_[r]), c0_[r + 1]); b_ = fmaxf(fmaxf(b_, c0_[r + 2]), c0_[r + 3]); a_ = fmaxf(fmaxf(a_, c1_[r]), c1_[r + 1]); b_ = fmaxf(fmaxf(b_, c1_[r + 2]), c1_[r + 3]); } \
        float m_ = fmaxf(a_, b_); auto rr_ = __builtin_amdgcn_permlane32_swap(__float_as_uint(m_), __float_as_uint(m_), false, false); fmaxf(__uint_as_float(rr_[0]), __uint_as_float(rr_[1])); })
    __builtin_amdgcn_s_barrier(); asm volatile("" ::: "memory");
    f32x16 pp0 = negm, pp1 = negm;
#pragma unroll
    for (int d0 = 0; d0 < 4; ++d0) { pp0 = __builtin_amdgcn_mfma_f32_32x32x16_bf16(DA_KFRAG(0, d0, 0), qr[d0], pp0, 0, 0, 0); pp1 = __builtin_amdgcn_mfma_f32_32x32x16_bf16(DA_KFRAG(0, d0, 1), qr[d0], pp1, 0, 0, 0); }
    { const float mx = DA_ROWMAX(pp0, pp1); mref = mx;
#pragma unroll
      for (int r = 0; r < 16; ++r) { negm[r] = -mref; pp0[r] = __builtin_amdgcn_exp2f(pp0[r] - mx); pp1[r] = __builtin_amdgcn_exp2f(pp1[r] - mx); } }
    asm volatile("s_waitcnt lgkmcnt(0)" ::: "memory");
    __builtin_amdgcn_s_barrier(); asm volatile("" ::: "memory");
    for (int t = 1; t <= ntile_blk; ++t) {
        if (t + 2 < ntile_blk) DA_DMA(t + 2, (t + 2) & 3);
        const int sc = t & 3, sp = (t - 1) & 3;
        if (t <= ntile_w) {
            const bool cur = t < ntile_w;
            f32x16 c0 = negm, c1 = negm;
            bf16x8 kf[8];
#pragma unroll
            for (int d0 = 0; d0 < 4; ++d0) { kf[2 * d0] = DA_KFRAG(sc, d0, 0); kf[2 * d0 + 1] = DA_KFRAG(sc, d0, 1); }
            unsigned pw[2][2][4]; float rs = 0.f;
#pragma unroll
            for (int r = 0; r < 16; ++r) rs += pp0[r] + pp1[r];
#pragma unroll
            for (int s = 0; s < 2; ++s)
#pragma unroll
                for (int j = 0; j < 4; ++j) { pw[0][s][j] = cvtpk(pp0[8 * s + 2 * j], pp0[8 * s + 2 * j + 1]); pw[1][s][j] = cvtpk(pp1[8 * s + 2 * j], pp1[8 * s + 2 * j + 1]); }
#pragma unroll
            for (int d0 = 0; d0 < 4; ++d0) { c0 = __builtin_amdgcn_mfma_f32_32x32x16_bf16(kf[2 * d0], qr[d0], c0, 0, 0, 0); c1 = __builtin_amdgcn_mfma_f32_32x32x16_bf16(kf[2 * d0 + 1], qr[d0], c1, 0, 0, 0); }
            __builtin_amdgcn_sched_group_barrier(0x100, 8, 0); __builtin_amdgcn_sched_group_barrier(0x2, 10, 0);
#pragma unroll
            for (int i = 0; i < 8; ++i) { __builtin_amdgcn_sched_group_barrier(0x8, 1, 0); __builtin_amdgcn_sched_group_barrier(0x2, 4, 0); }
            l += rs;
            bool resc = false; float f = 1.0f;
            if (cur) {
                const float mx = DA_ROWMAX(c0, c1);
                if (__any(mx > RESC_THR)) {
                    const float dl = fmaxf(mx, 0.f); f = __builtin_amdgcn_exp2f(-dl); mref += dl; l *= f; resc = true;
#pragma unroll
                    for (int r = 0; r < 16; ++r) { c0[r] -= dl; c1[r] -= dl; negm[r] = -mref; }
                }
            }
            {
                typedef unsigned u4 __attribute__((ext_vector_type(4)));
                const LAS unsigned char* vb_ = lds + sp * BUF_BYTES;
#define DA_VA(k_) (vb_ + voff[(k_) >> 2] + (16 * ((k_) & 3)) * 256)
                s16x4 lo_a = vtr(DA_VA(0)), hh_a = vtr(DA_VA(0) + 8 * 256), lo_b = vtr(DA_VA(1)), hh_b = vtr(DA_VA(1) + 8 * 256);
#pragma unroll
                for (int k = 0; k < 16; ++k) {
                    const s16x4 lo = lo_a, hh = hh_a;
                    lo_a = lo_b; hh_a = hh_b;
                    if (k < 14) { lo_b = vtr(DA_VA(k + 2)); hh_b = vtr(DA_VA(k + 2) + 8 * 256); }
                    const bf16x8 av = {lo[0], lo[1], lo[2], lo[3], hh[0], hh[1], hh[2], hh[3]};
                    const u4 pv = {pw[(k >> 1) & 1][k & 1][0], pw[(k >> 1) & 1][k & 1][1], pw[(k >> 1) & 1][k & 1][2], pw[(k >> 1) & 1][k & 1][3]};
                    o[k >> 2] = __builtin_amdgcn_mfma_f32_32x32x16_bf16(av, __builtin_bit_cast(bf16x8, pv), o[k >> 2], 0, 0, 0);
                    if (k < 8) { c0[2 * k] = exp2_pin(c0[2 * k]); c0[2 * k + 1] = exp2_pin(c0[2 * k + 1]); }
                    else { c1[2 * (k - 8)] = exp2_pin(c1[2 * (k - 8)]); c1[2 * (k - 8) + 1] = exp2_pin(c1[2 * (k - 8) + 1]); }
                }
#undef DA_VA
            }
            if (resc) {
#pragma unroll
                for (int eb = 0; eb < 4; ++eb)
#pragma unroll
                    for (int r = 0; r < 16; ++r) o[eb][r] *= f;
            }
            pp0 = c0; pp1 = c1;
        }
        if (t + 2 < ntile_blk) asm volatile("s_waitcnt vmcnt(4)" ::: "memory"); else asm volatile("s_waitcnt vmcnt(0)" ::: "memory");
        asm volatile("s_waitcnt lgkmcnt(0)" ::: "memory");
        __builtin_amdgcn_s_barrier(); asm volatile("" ::: "memory");
    }
#undef DA_KFRAG
#undef DA_ROWMAX
#undef DA_DMA
    l += __shfl_xor(l, 32);
    const float inv = 1.0f / l;
    LAS float* X = (LAS float*)lds + rg * 4096;
    if (map == 1) {
#pragma unroll
        for (int eb = 0; eb < 4; ++eb)
#pragma unroll
            for (int r = 0; r < 16; ++r) X[(eb * 16 + r) * 64 + lane] = o[eb][r] * inv;
    }
    __syncthreads();
    if (map == 0) {
        float ss = 0.f;
#pragma unroll
        for (int eb = 0; eb < 4; ++eb)
#pragma unroll
            for (int r = 0; r < 16; ++r) { const float d = o[eb][r] * inv - lam * X[(eb * 16 + r) * 64 + lane]; o[eb][r] = d; ss += d * d; }
        ss += __shfl_xor(ss, 32);
        const float rstd = 0.8f / sqrtf(ss * (1.f / 128.f) + RMS_EPS);
        bf16* orow = F.MIX + (size_t)(b * SEQ + t0 + r32) * D + 512 + h * 128;
#pragma unroll
        for (int eb = 0; eb < 4; ++eb)
#pragma unroll
            for (int r4 = 0; r4 < 4; ++r4) { const int e0 = 32 * eb + 8 * r4 + 4 * hi; const float4 wv = *(const float4*)(F.dnw + e0);
                uint2 pk; pk.x = pk2(o[eb][4 * r4 + 0] * rstd * wv.x, o[eb][4 * r4 + 1] * rstd * wv.y); pk.y = pk2(o[eb][4 * r4 + 2] * rstd * wv.z, o[eb][4 * r4 + 3] * rstd * wv.w);
                *(uint2*)(orow + e0) = pk; }
    }
    __syncthreads();
}
constexpr int QE_ROWS = 64;
__device__ __forceinline__ void attn_phase(Frame& F, unsigned* ctl, volatile LAS unsigned* MISC, int cbase = 1024) {
    const float lam = compute_lambda(F.dlam, F.lane);
    const int x = F.bid & 7;
    if (F.tid == 0) MISC[16] = atomicAdd(&ctl[cbase + 64 * x], 1u);
    __syncthreads();
    for (;;) {
        const unsigned u = MISC[16];
        __syncthreads();
        if (u >= 128u + (unsigned)(NEXP / 8 / QE_ROWS)) break;
        unsigned nxt = 0u;
        if (F.tid == 0) nxt = atomicAdd(&ctl[cbase + 64 * x], 1u);
        if (u % 5u != 4u) { const unsigned a = u - (u + 1u) / 5u; attn_unit(F, (4 * x + (int)(a & 3)) >> 2, (int)(a & 3), 31 - (int)(a >> 2), lam); }
        else quant_experts(F, x * (NEXP / 8) + (int)(u / 5u) * QE_ROWS, QE_ROWS);
        if (F.tid == 0) MISC[16] = nxt;
        __syncthreads();
    }
}
}

__device__ __forceinline__ float row_rstd(const float* PSQ, int t) {
    const float4* p = (const float4*)(PSQ + (size_t)t * 16);
    const float4 a = p[0], b = p[1], c = p[2], d = p[3];
    const float s = ((a.x + a.y) + (a.z + a.w)) + ((b.x + b.y) + (b.z + b.w)) + ((c.x + c.y) + (c.z + c.w)) + ((d.x + d.y) + (d.z + d.w));
    return 1.0f / sqrtf(s * (1.f / D) + RMS_EPS);
}

__device__ __forceinline__ float gelu_tanh(float z) {
    const float y = 0.7978845608028654f * (z + 0.044715f * z * z * z);
    const float th = 1.0f - 2.0f / (1.0f + __expf(2.0f * y));
    return 0.5f * z * (1.0f + th);
}
__device__ __forceinline__ void unpack8(const uint4 v, float (&f)[8]) {
    f[0] = bflo(v.x); f[1] = bfhi(v.x); f[2] = bflo(v.y); f[3] = bfhi(v.y); f[4] = bflo(v.z); f[5] = bfhi(v.z); f[6] = bflo(v.w); f[7] = bfhi(v.w);
}
namespace tk {
typedef short bf16x8 __attribute__((ext_vector_type(8)));
typedef float f32x16 __attribute__((ext_vector_type(16)));
typedef unsigned u32x4 __attribute__((ext_vector_type(4)));
constexpr int NC = 50;
constexpr int CI[NC] = {0, 0, 0, 0, 0, 0, 0, 0, 0, 0, 0, 0, 0, 0, 0, 0, 1, 1, 1, 1, 1, 1, 1, 1, 2, 2, 2, 2, 2, 3, 3, 3, 3, 4, 4, 4, 5, 5, 6, 6, 7, 7, 8, 9, 10, 11, 12, 13, 14, 15};
constexpr int CJ[NC] = {0, 1, 2, 3, 4, 5, 6, 7, 8, 9, 10, 11, 12, 13, 14, 15, 0, 1, 2, 3, 4, 5, 6, 7, 0, 1, 2, 3, 4, 0, 1, 2, 3, 0, 1, 2, 0, 1, 0, 1, 0, 1, 0, 0, 0, 0, 0, 0, 0, 0};
constexpr int SLOT_OFF = 65536;
#define TK_SORT16(A) do { int h_, l_; \
    h_ = max(A[0], A[1]); l_ = min(A[0], A[1]); A[0] = h_; A[1] = l_; \
    h_ = max(A[3], A[2]); l_ = min(A[3], A[2]); A[3] = h_; A[2] = l_; \
    h_ = max(A[4], A[5]); l_ = min(A[4], A[5]); A[4] = h_; A[5] = l_; \
    h_ = max(A[7], A[6]); l_ = min(A[7], A[6]); A[7] = h_; A[6] = l_; \
    h_ = max(A[8], A[9]); l_ = min(A[8], A[9]); A[8] = h_; A[9] = l_; \
    h_ = max(A[11], A[10]); l_ = min(A[11], A[10]); A[11] = h_; A[10] = l_; \
    h_ = max(A[12], A[13]); l_ = min(A[12], A[13]); A[12] = h_; A[13] = l_; \
    h_ = max(A[15], A[14]); l_ = min(A[15], A[14]); A[15] = h_; A[14] = l_; \
    h_ = max(A[0], A[2]); l_ = min(A[0], A[2]); A[0] = h_; A[2] = l_; \
    h_ = max(A[1], A[3]); l_ = min(A[1], A[3]); A[1] = h_; A[3] = l_; \
    h_ = max(A[6], A[4]); l_ = min(A[6], A[4]); A[6] = h_; A[4] = l_; \
    h_ = max(A[7], A[5]); l_ = min(A[7], A[5]); A[7] = h_; A[5] = l_; \
    h_ = max(A[8], A[10]); l_ = min(A[8], A[10]); A[8] = h_; A[10] = l_; \
    h_ = max(A[9], A[11]); l_ = min(A[9], A[11]); A[9] = h_; A[11] = l_; \
    h_ = max(A[14], A[12]); l_ = min(A[14], A[12]); A[14] = h_; A[12] = l_; \
    h_ = max(A[15], A[13]); l_ = min(A[15], A[13]); A[15] = h_; A[13] = l_; \
    h_ = max(A[0], A[1]); l_ = min(A[0], A[1]); A[0] = h_; A[1] = l_; \
    h_ = max(A[2], A[3]); l_ = min(A[2], A[3]); A[2] = h_; A[3] = l_; \
    h_ = max(A[5], A[4]); l_ = min(A[5], A[4]); A[5] = h_; A[4] = l_; \
    h_ = max(A[7], A[6]); l_ = min(A[7], A[6]); A[7] = h_; A[6] = l_; \
    h_ = max(A[8], A[9]); l_ = min(A[8], A[9]); A[8] = h_; A[9] = l_; \
    h_ = max(A[10], A[11]); l_ = min(A[10], A[11]); A[10] = h_; A[11] = l_; \
    h_ = max(A[13], A[12]); l_ = min(A[13], A[12]); A[13] = h_; A[12] = l_; \
    h_ = max(A[15], A[14]); l_ = min(A[15], A[14]); A[15] = h_; A[14] = l_; \
    h_ = max(A[0], A[4]); l_ = min(A[0], A[4]); A[0] = h_; A[4] = l_; \
    h_ = max(A[1], A[5]); l_ = min(A[1], A[5]); A[1] = h_; A[5] = l_; \
    h_ = max(A[2], A[6]); l_ = min(A[2], A[6]); A[2] = h_; A[6] = l_; \
    h_ = max(A[3], A[7]); l_ = min(A[3], A[7]); A[3] = h_; A[7] = l_; \
    h_ = max(A[12], A[8]); l_ = min(A[12], A[8]); A[12] = h_; A[8] = l_; \
    h_ = max(A[13], A[9]); l_ = min(A[13], A[9]); A[13] = h_; A[9] = l_; \
    h_ = max(A[14], A[10]); l_ = min(A[14], A[10]); A[14] = h_; A[10] = l_; \
    h_ = max(A[15], A[11]); l_ = min(A[15], A[11]); A[15] = h_; A[11] = l_; \
    h_ = max(A[0], A[2]); l_ = min(A[0], A[2]); A[0] = h_; A[2] = l_; \
    h_ = max(A[1], A[3]); l_ = min(A[1], A[3]); A[1] = h_; A[3] = l_; \
    h_ = max(A[4], A[6]); l_ = min(A[4], A[6]); A[4] = h_; A[6] = l_; \
    h_ = max(A[5], A[7]); l_ = min(A[5], A[7]); A[5] = h_; A[7] = l_; \
    h_ = max(A[10], A[8]); l_ = min(A[10], A[8]); A[10] = h_; A[8] = l_; \
    h_ = max(A[11], A[9]); l_ = min(A[11], A[9]); A[11] = h_; A[9] = l_; \
    h_ = max(A[14], A[12]); l_ = min(A[14], A[12]); A[14] = h_; A[12] = l_; \
    h_ = max(A[15], A[13]); l_ = min(A[15], A[13]); A[15] = h_; A[13] = l_; \
    h_ = max(A[0], A[1]); l_ = min(A[0], A[1]); A[0] = h_; A[1] = l_; \
    h_ = max(A[2], A[3]); l_ = min(A[2], A[3]); A[2] = h_; A[3] = l_; \
    h_ = max(A[4], A[5]); l_ = min(A[4], A[5]); A[4] = h_; A[5] = l_; \
    h_ = max(A[6], A[7]); l_ = min(A[6], A[7]); A[6] = h_; A[7] = l_; \
    h_ = max(A[9], A[8]); l_ = min(A[9], A[8]); A[9] = h_; A[8] = l_; \
    h_ = max(A[11], A[10]); l_ = min(A[11], A[10]); A[11] = h_; A[10] = l_; \
    h_ = max(A[13], A[12]); l_ = min(A[13], A[12]); A[13] = h_; A[12] = l_; \
    h_ = max(A[15], A[14]); l_ = min(A[15], A[14]); A[15] = h_; A[14] = l_; \
    h_ = max(A[0], A[8]); l_ = min(A[0], A[8]); A[0] = h_; A[8] = l_; \
    h_ = max(A[1], A[9]); l_ = min(A[1], A[9]); A[1] = h_; A[9] = l_; \
    h_ = max(A[2], A[10]); l_ = min(A[2], A[10]); A[2] = h_; A[10] = l_; \
    h_ = max(A[3], A[11]); l_ = min(A[3], A[11]); A[3] = h_; A[11] = l_; \
    h_ = max(A[4], A[12]); l_ = min(A[4], A[12]); A[4] = h_; A[12] = l_; \
    h_ = max(A[5], A[13]); l_ = min(A[5], A[13]); A[5] = h_; A[13] = l_; \
    h_ = max(A[6], A[14]); l_ = min(A[6], A[14]); A[6] = h_; A[14] = l_; \
    h_ = max(A[7], A[15]); l_ = min(A[7], A[15]); A[7] = h_; A[15] = l_; \
    h_ = max(A[0], A[4]); l_ = min(A[0], A[4]); A[0] = h_; A[4] = l_; \
    h_ = max(A[1], A[5]); l_ = min(A[1], A[5]); A[1] = h_; A[5] = l_; \
    h_ = max(A[2], A[6]); l_ = min(A[2], A[6]); A[2] = h_; A[6] = l_; \
    h_ = max(A[3], A[7]); l_ = min(A[3], A[7]); A[3] = h_; A[7] = l_; \
    h_ = max(A[8], A[12]); l_ = min(A[8], A[12]); A[8] = h_; A[12] = l_; \
    h_ = max(A[9], A[13]); l_ = min(A[9], A[13]); A[9] = h_; A[13] = l_; \
    h_ = max(A[10], A[14]); l_ = min(A[10], A[14]); A[10] = h_; A[14] = l_; \
    h_ = max(A[11], A[15]); l_ = min(A[11], A[15]); A[11] = h_; A[15] = l_; \
    h_ = max(A[0], A[2]); l_ = min(A[0], A[2]); A[0] = h_; A[2] = l_; \
    h_ = max(A[1], A[3]); l_ = min(A[1], A[3]); A[1] = h_; A[3] = l_; \
    h_ = max(A[4], A[6]); l_ = min(A[4], A[6]); A[4] = h_; A[6] = l_; \
    h_ = max(A[5], A[7]); l_ = min(A[5], A[7]); A[5] = h_; A[7] = l_; \
    h_ = max(A[8], A[10]); l_ = min(A[8], A[10]); A[8] = h_; A[10] = l_; \
    h_ = max(A[9], A[11]); l_ = min(A[9], A[11]); A[9] = h_; A[11] = l_; \
    h_ = max(A[12], A[14]); l_ = min(A[12], A[14]); A[12] = h_; A[14] = l_; \
    h_ = max(A[13], A[15]); l_ = min(A[13], A[15]); A[13] = h_; A[15] = l_; \
    h_ = max(A[0], A[1]); l_ = min(A[0], A[1]); A[0] = h_; A[1] = l_; \
    h_ = max(A[2], A[3]); l_ = min(A[2], A[3]); A[2] = h_; A[3] = l_; \
    h_ = max(A[4], A[5]); l_ = min(A[4], A[5]); A[4] = h_; A[5] = l_; \
    h_ = max(A[6], A[7]); l_ = min(A[6], A[7]); A[6] = h_; A[7] = l_; \
    h_ = max(A[8], A[9]); l_ = min(A[8], A[9]); A[8] = h_; A[9] = l_; \
    h_ = max(A[10], A[11]); l_ = min(A[10], A[11]); A[10] = h_; A[11] = l_; \
    h_ = max(A[12], A[13]); l_ = min(A[12], A[13]); A[12] = h_; A[13] = l_; \
    h_ = max(A[14], A[15]); l_ = min(A[14], A[15]); A[14] = h_; A[15] = l_; \
} while (0)
#define TK_MERGE16(A) do { int h_, l_; \
    h_ = max(A[0], A[8]); l_ = min(A[0], A[8]); A[0] = h_; A[8] = l_; \
    h_ = max(A[1], A[9]); l_ = min(A[1], A[9]); A[1] = h_; A[9] = l_; \
    h_ = max(A[2], A[10]); l_ = min(A[2], A[10]); A[2] = h_; A[10] = l_; \
    h_ = max(A[3], A[11]); l_ = min(A[3], A[11]); A[3] = h_; A[11] = l_; \
    h_ = max(A[4], A[12]); l_ = min(A[4], A[12]); A[4] = h_; A[12] = l_; \
    h_ = max(A[5], A[13]); l_ = min(A[5], A[13]); A[5] = h_; A[13] = l_; \
    h_ = max(A[6], A[14]); l_ = min(A[6], A[14]); A[6] = h_; A[14] = l_; \
    h_ = max(A[7], A[15]); l_ = min(A[7], A[15]); A[7] = h_; A[15] = l_; \
    h_ = max(A[0], A[4]); l_ = min(A[0], A[4]); A[0] = h_; A[4] = l_; \
    h_ = max(A[1], A[5]); l_ = min(A[1], A[5]); A[1] = h_; A[5] = l_; \
    h_ = max(A[2], A[6]); l_ = min(A[2], A[6]); A[2] = h_; A[6] = l_; \
    h_ = max(A[3], A[7]); l_ = min(A[3], A[7]); A[3] = h_; A[7] = l_; \
    h_ = max(A[8], A[12]); l_ = min(A[8], A[12]); A[8] = h_; A[12] = l_; \
    h_ = max(A[9], A[13]); l_ = min(A[9], A[13]); A[9] = h_; A[13] = l_; \
    h_ = max(A[10], A[14]); l_ = min(A[10], A[14]); A[10] = h_; A[14] = l_; \
    h_ = max(A[11], A[15]); l_ = min(A[11], A[15]); A[11] = h_; A[15] = l_; \
    h_ = max(A[0], A[2]); l_ = min(A[0], A[2]); A[0] = h_; A[2] = l_; \
    h_ = max(A[1], A[3]); l_ = min(A[1], A[3]); A[1] = h_; A[3] = l_; \
    h_ = max(A[4], A[6]); l_ = min(A[4], A[6]); A[4] = h_; A[6] = l_; \
    h_ = max(A[5], A[7]); l_ = min(A[5], A[7]); A[5] = h_; A[7] = l_; \
    h_ = max(A[8], A[10]); l_ = min(A[8], A[10]); A[8] = h_; A[10] = l_; \
    h_ = max(A[9], A[11]); l_ = min(A[9], A[11]); A[9] = h_; A[11] = l_; \
    h_ = max(A[12], A[14]); l_ = min(A[12], A[14]); A[12] = h_; A[14] = l_; \
    h_ = max(A[13], A[15]); l_ = min(A[13], A[15]); A[13] = h_; A[15] = l_; \
    h_ = max(A[0], A[1]); l_ = min(A[0], A[1]); A[0] = h_; A[1] = l_; \
    h_ = max(A[2], A[3]); l_ = min(A[2], A[3]); A[2] = h_; A[3] = l_; \
    h_ = max(A[4], A[5]); l_ = min(A[4], A[5]); A[4] = h_; A[5] = l_; \
    h_ = max(A[6], A[7]); l_ = min(A[6], A[7]); A[6] = h_; A[7] = l_; \
    h_ = max(A[8], A[9]); l_ = min(A[8], A[9]); A[8] = h_; A[9] = l_; \
    h_ = max(A[10], A[11]); l_ = min(A[10], A[11]); A[10] = h_; A[11] = l_; \
    h_ = max(A[12], A[13]); l_ = min(A[12], A[13]); A[12] = h_; A[13] = l_; \
    h_ = max(A[14], A[15]); l_ = min(A[14], A[15]); A[14] = h_; A[15] = l_; \
} while (0)

__device__ __forceinline__ int f2ord(float f) { const int b = (int)__float_as_uint(f); return b ^ (int)((unsigned)(b >> 31) >> 1); }
__device__ __forceinline__ float ord2f(int k) { return __uint_as_float((unsigned)(k ^ (int)((unsigned)(k >> 31) >> 1))); }
__device__ __forceinline__ void topk_phase(Frame& F) {
    LAS unsigned char* lds = (LAS unsigned char*)F.lds;
    const int tid = F.tid, lane = F.lane, r32 = lane & 31, hi = lane >> 5, w = F.wave;
    LAS unsigned* slots = (LAS unsigned*)(lds + SLOT_OFF + w * 8192);
    for (int u = F.bid; u < 256; u += F.G) {
        const int tile = u >> 1, hgp = u & 1;
        const int t = tile * 256 + w * 32 + r32;
        const float rl2 = row_rstd(F.PSQ, t) * 1.4426950408889634f;
        for (int hh = 0; hh < 4; ++hh) {
            const int h = hgp * 4 + hh;
            __syncthreads();
#pragma unroll
            for (int i = 0; i < 8; ++i) { const int p = tid + 512 * i, half = p >> 11, row = (p >> 4) & 127, ch = p & 15;
                const u32x4 v = *(const u32x4*)(F.SKb + ((size_t)(h * 2 + half) * 128 + row) * 128 + ch * 8);
                *(LAS u32x4*)(lds + half * 32768 + row * 256 + ((ch ^ (row & 15)) << 4)) = v; }
            __syncthreads();
            int topk[2][16];
#pragma unroll
            for (int half = 0; half < 2; ++half) {
                bf16x8 bq[8];
#pragma unroll
                for (int ks = 0; ks < 8; ++ks) bq[ks] = *(const bf16x8*)(F.QH + (size_t)t * 2048 + h * 256 + half * 128 + 16 * ks + 8 * hi);
                f32x16 s[4];
#pragma unroll
                for (int nb = 0; nb < 4; ++nb) {
#pragma unroll
                    for (int r = 0; r < 16; ++r) s[nb][r] = 0.f;
#pragma unroll
                    for (int ks = 0; ks < 8; ++ks) {
                        const bf16x8 a = *(const LAS bf16x8*)(lds + half * 32768 + (32 * nb + r32) * 256 + (((2 * ks + hi) ^ (r32 & 15)) << 4));
                        s[nb] = __builtin_amdgcn_mfma_f32_32x32x16_bf16(a, bq[ks], s[nb], 0, 0, 0);
                    }
                }
                int kk[4][16];
#pragma unroll
                for (int nb = 0; nb < 4; ++nb)
#pragma unroll
                    for (int r = 0; r < 16; ++r) { const float sv = s[nb][r]; kk[nb][r] = (f2ord(sv) & ~127) | (32 * nb + (r & 3) + 8 * (r >> 2) + 4 * hi); }
                TK_SORT16(kk[0]); TK_SORT16(kk[1]); TK_SORT16(kk[2]); TK_SORT16(kk[3]);
#pragma unroll
                for (int i = 0; i < 16; ++i) { kk[0][i] = max(kk[0][i], kk[1][15 - i]); kk[2][i] = max(kk[2][i], kk[3][15 - i]); }
                TK_MERGE16(kk[0]); TK_MERGE16(kk[2]);
#pragma unroll
                for (int i = 0; i < 16; ++i) kk[0][i] = max(kk[0][i], kk[2][15 - i]);
                TK_MERGE16(kk[0]);
#pragma unroll
                for (int i = 0; i < 16; ++i) { auto rr = __builtin_amdgcn_permlane32_swap((unsigned)kk[0][i], (unsigned)kk[0][i], false, false); kk[1][i] = (int)(hi ? rr[0] : rr[1]); }
#pragma unroll
                for (int i = 0; i < 16; ++i) kk[0][i] = max(kk[0][i], kk[1][15 - i]);
                TK_MERGE16(kk[0]);
#pragma unroll
                for (int i = 0; i < 16; ++i) topk[half][i] = kk[0][i];
            }
            float v1[16], v2[16]; unsigned i1[16], i2[16];
#pragma unroll
            for (int r = 0; r < 16; ++r) { v1[r] = ord2f(topk[0][r] & ~127); i1[r] = (unsigned)topk[0][r] & 127u; v2[r] = ord2f(topk[1][r] & ~127); i2[r] = (unsigned)topk[1][r] & 127u; }
            float cv[NC / 2]; unsigned cp[NC / 2];
#pragma unroll
            for (int c = 0; c < NC / 2; ++c) {
                const float va = v1[CI[2 * c]] + v2[CJ[2 * c]], vb = v1[CI[2 * c + 1]] + v2[CJ[2 * c + 1]];
                const unsigned pa = (i1[CI[2 * c]] << 7) | i2[CJ[2 * c]], pb = (i1[CI[2 * c + 1]] << 7) | i2[CJ[2 * c + 1]];
                cv[c] = hi ? vb : va; cp[c] = hi ? pb : pa;
            }
            float rv[16]; unsigned rp[16];
            {
                int kc[2][16];
#pragma unroll
                for (int c = 0; c < NC / 2; ++c) { kc[c >> 4][c & 15] = (f2ord(cv[c]) & ~63) | (hi << 5) | c; slots[((hi << 5) | c) * 32 + r32] = cp[c]; }
#pragma unroll
                for (int c = NC / 2; c < 32; ++c) kc[c >> 4][c & 15] = (int)0x80000000;
                TK_SORT16(kc[0]); TK_SORT16(kc[1]);
#pragma unroll
                for (int i = 0; i < 16; ++i) kc[0][i] = max(kc[0][i], kc[1][15 - i]);
                TK_MERGE16(kc[0]);
#pragma unroll
                for (int i = 0; i < 16; ++i) { auto rr = __builtin_amdgcn_permlane32_swap((unsigned)kc[0][i], (unsigned)kc[0][i], false, false); kc[1][i] = (int)(hi ? rr[0] : rr[1]); }
#pragma unroll
                for (int i = 0; i < 16; ++i) kc[0][i] = max(kc[0][i], kc[1][15 - i]);
                TK_MERGE16(kc[0]);
#pragma unroll
                for (int r = 0; r < 16; ++r) { rv[r] = ord2f(kc[0][r] & ~63); rp[r] = slots[(kc[0][r] & 63) * 32 + r32]; }
            }
            float sum = 0.f; const float mx0 = rv[0];
#pragma unroll
            for (int r = 0; r < 16; ++r) rv[r] = __builtin_amdgcn_exp2f((rv[r] - mx0) * rl2);
#pragma unroll
            for (int r = 0; r < 16; ++r) sum += rv[r];
            const float inv = 1.0f / sum;
            if (hi == 0) {
                int4* ip = (int4*)(F.IDX + (size_t)t * 128 + h * 16); float4* gp = (float4*)(F.GW + (size_t)t * 128 + h * 16);
#pragma unroll
                for (int q = 0; q < 4; ++q) { ip[q] = make_int4((int)rp[4 * q], (int)rp[4 * q + 1], (int)rp[4 * q + 2], (int)rp[4 * q + 3]);
                    gp[q] = make_float4(rv[4 * q] * inv, rv[4 * q + 1] * inv, rv[4 * q + 2] * inv, rv[4 * q + 3] * inv); }
            }
        }
    }
    __syncthreads();
}
}

namespace peer {
typedef __bf16 bf2 __attribute__((ext_vector_type(2)));
typedef unsigned u32x4 __attribute__((ext_vector_type(4)));
template <int CTRL, int RM> __device__ __forceinline__ float dpp_add(float v) {
    return v + __builtin_bit_cast(float, __builtin_amdgcn_update_dpp(0, __builtin_bit_cast(int, v), CTRL, RM, 0xF, false));
}
__device__ __forceinline__ float wave_total(float v) {
    v = dpp_add<0xB1, 0xF>(v); v = dpp_add<0x4E, 0xF>(v); v = dpp_add<0x141, 0xF>(v); v = dpp_add<0x140, 0xF>(v);
    v = dpp_add<0x142, 0xA>(v); v = dpp_add<0x143, 0xC>(v);
    return __builtin_bit_cast(float, __builtin_amdgcn_readlane(__builtin_bit_cast(int, v), 63));
}
__device__ __forceinline__ float dot2(unsigned a, unsigned b, float c) { return __builtin_amdgcn_fdot2_f32_bf16(__builtin_bit_cast(bf2, a), __builtin_bit_cast(bf2, b), c, false); }
__device__ __forceinline__ float dot8(const u32x4 a, const u32x4 b, float c) { c = dot2(a.x, b.x, c); c = dot2(a.y, b.y, c); c = dot2(a.z, b.z, c); return dot2(a.w, b.w, c); }

__device__ __forceinline__ int wave_isum(int v) {
    v += __builtin_amdgcn_update_dpp(0, v, 0xB1, 0xF, 0xF, false); v += __builtin_amdgcn_update_dpp(0, v, 0x4E, 0xF, 0xF, false);
    v += __builtin_amdgcn_update_dpp(0, v, 0x141, 0xF, 0xF, false); v += __builtin_amdgcn_update_dpp(0, v, 0x140, 0xF, 0xF, false);
    v += __builtin_amdgcn_update_dpp(0, v, 0x142, 0xA, 0xF, false); v += __builtin_amdgcn_update_dpp(0, v, 0x143, 0xC, 0xF, false);
    return __builtin_amdgcn_readlane(v, 63);
}
constexpr int TPW = 8, SLSH = 9;
constexpr int UGRP = 2;
constexpr int VGRP = 2;
constexpr int PW_BYTES = 17440, PW_LIST = 0, PW_XQ = 8192, PW_CNT = 16416;
static_assert(NWAVES * PW_BYTES <= MISC_OFF, "PEER LDS map");
template <int CTRL, int RM> __device__ __forceinline__ int dpp_iadd(int v) { return v + __builtin_amdgcn_update_dpp(0, v, CTRL, RM, 0xF, false); }
template <int CTRL, int RM> __device__ __forceinline__ unsigned dpp_umax(unsigned v) { const unsigned t = (unsigned)__builtin_amdgcn_update_dpp(0, (int)v, CTRL, RM, 0xF, false); return v > t ? v : t; }
__device__ __forceinline__ float wave_max_pos(float f) {
    unsigned v = __float_as_uint(f);
    v = dpp_umax<0xB1, 0xF>(v); v = dpp_umax<0x4E, 0xF>(v); v = dpp_umax<0x141, 0xF>(v); v = dpp_umax<0x140, 0xF>(v); v = dpp_umax<0x142, 0xA>(v); v = dpp_umax<0x143, 0xC>(v);
    return __uint_as_float((unsigned)__builtin_amdgcn_readlane((int)v, 63));
}
__device__ __forceinline__ unsigned long long read_entry(const LAS unsigned char* pw, int j, int p) {
    const int idx = p < 128 ? p : 127;
    return *(const LAS unsigned long long*)(pw + PW_LIST + (j * 128 + idx) * 8);
}
__device__ __forceinline__ int utok(int lane) { return ((lane >> 5) & 1) | (((lane >> 4) & 1) << 1) | (((lane >> 3) & 1) << 2); }
struct UGroup { u32x4 u[TPW]; unsigned long long ent; float us, vs; };
template <int EMASK> __device__ __forceinline__ void issue_ug(Frame& F, UGroup& G, const LAS unsigned char* pw, int p, int lane) {
    const int idx = p < 128 ? p : 127;
    G.ent = *(const LAS unsigned long long*)(pw + PW_LIST + (utok(lane) * 128 + idx) * 8);
    const unsigned ev = (unsigned)G.ent & (unsigned)EMASK;
    typedef float f32x2 __attribute__((ext_vector_type(2)));
    const f32x2 sc = *(const f32x2*)(F.US + 2 * (size_t)ev);
    G.us = sc.x; G.vs = sc.y;
#pragma unroll
    for (int j = 0; j < TPW; ++j) { const unsigned e = (unsigned)__builtin_amdgcn_readlane((int)ev, 32 * (j & 1) + 16 * ((j >> 1) & 1) + 8 * ((j >> 2) & 1)); G.u[j] = *(const u32x4*)(F.U8 + (size_t)e * D + 16 * lane); }
}
__device__ __forceinline__ void compute_ug(const UGroup& G, const u32x4 (&xq)[TPW], LAS unsigned char* pw, int p, int lane, float sxrv) {
    int d[TPW];
#pragma unroll
    for (int j = 0; j < TPW; ++j) {
        d[j] = __builtin_amdgcn_sdot4((int)G.u[j].x, (int)xq[j].x, 0, false); d[j] = __builtin_amdgcn_sdot4((int)G.u[j].y, (int)xq[j].y, d[j], false);
        d[j] = __builtin_amdgcn_sdot4((int)G.u[j].z, (int)xq[j].z, d[j], false); d[j] = __builtin_amdgcn_sdot4((int)G.u[j].w, (int)xq[j].w, d[j], false); }
    int m4[4], m2[2];
#pragma unroll
    for (int i = 0; i < 4; ++i) { auto rr = __builtin_amdgcn_permlane32_swap((unsigned)d[2 * i], (unsigned)d[2 * i + 1], false, false); m4[i] = (int)rr[0] + (int)rr[1]; }
#pragma unroll
    for (int i = 0; i < 2; ++i) { auto rr = __builtin_amdgcn_permlane16_swap((unsigned)m4[2 * i], (unsigned)m4[2 * i + 1], false, false); m2[i] = (int)rr[0] + (int)rr[1]; }
    const int ra = m2[0] + __builtin_amdgcn_update_dpp(0, m2[0], 0x128, 0xF, 0xF, false), rb = m2[1] + __builtin_amdgcn_update_dpp(0, m2[1], 0x128, 0xF, 0xF, false);
    int dv = (lane & 8) ? rb : ra;
    dv = dpp_iadd<0xB1, 0xF>(dv); dv = dpp_iadd<0x4E, 0xF>(dv); dv = dpp_iadd<0x141, 0xF>(dv);
    const float z = (float)dv * G.us * sxrv;
    const float y2 = -2.3022082f * (z + 0.044715f * z * z * z);
    const float cw = __uint_as_float((unsigned)(G.ent >> 32)) * G.vs * z * __builtin_amdgcn_rcpf(1.0f + __builtin_amdgcn_exp2f(y2));
    const int pp = p < 128 ? p : 127;
    if ((lane & 7) == 0) *(LAS float*)(pw + PW_LIST + (utok(lane) * 128 + pp) * 8 + 4) = cw;
}
#define PEER_ACC(A, cw, vv) do { \
    A[0] += cw * (float)(vv.x & 0xff); A[1] += cw * (float)((vv.x >> 8) & 0xff); A[2] += cw * (float)((vv.x >> 16) & 0xff); A[3] += cw * (float)(vv.x >> 24); \
    A[4] += cw * (float)(vv.y & 0xff); A[5] += cw * (float)((vv.y >> 8) & 0xff); A[6] += cw * (float)((vv.y >> 16) & 0xff); A[7] += cw * (float)(vv.y >> 24); \
    A[8] += cw * (float)(vv.z & 0xff); A[9] += cw * (float)((vv.z >> 8) & 0xff); A[10] += cw * (float)((vv.z >> 16) & 0xff); A[11] += cw * (float)(vv.z >> 24); \
    A[12] += cw * (float)(vv.w & 0xff); A[13] += cw * (float)((vv.w >> 8) & 0xff); A[14] += cw * (float)((vv.w >> 16) & 0xff); A[15] += cw * (float)(vv.w >> 24); } while (0)
template <int EMASK, int MODE> __device__ __forceinline__ void peer_phase_t(Frame& F, float* outp, const XcdBarrier& bar) {
    const int gw = F.bid * NWAVES + F.wave, NGW = F.G * NWAVES, lane = F.lane;
    LAS unsigned char* pw = (LAS unsigned char*)F.lds + F.wave * PW_BYTES;
    LAS unsigned* cnt = (LAS unsigned*)(pw + PW_CNT);
    const int rounds = (T / TPW + NGW - 1) / NGW;
    for (int rd = 0; rd < rounds; ++rd) {
        const int wt = gw + rd * NGW; const bool live = wt < T / TPW;
        if (rd) xcd_barrier_light(bar);
        const int t0 = (live ? wt : gw) * TPW;
        u32x4 xq[TPW]; float sxrv;
        {
            int lq = lane; asm volatile("" : "+v"(lq));
            uint4 hA[TPW], hB[TPW]; int id0[TPW], id1[TPW]; float g0[TPW], g1[TPW];
#pragma unroll
            for (int j = 0; j < TPW; ++j) { const size_t t = (size_t)(t0 + j);
                hA[j] = *(const uint4*)(F.HB + t * D + 16 * lq); hB[j] = *(const uint4*)(F.HB + t * D + 16 * lq + 8);
                id0[j] = F.IDX[t * 128 + lq]; id1[j] = F.IDX[t * 128 + 64 + lq]; g0[j] = F.GW[t * 128 + lq]; g1[j] = F.GW[t * 128 + 64 + lq]; }
            const float rstd = row_rstd(F.PSQ, t0 + utok(lq));
            *(LAS u32x4*)(pw + PW_CNT + 16 * lq) = u32x4{0u, 0u, 0u, 0u};
            float msel = 0.f;
#pragma unroll
            for (int j = 0; j < TPW; ++j) {
                float x[16];
                { float xa[8], xb[8]; unpack8(hA[j], xa); unpack8(hB[j], xb);
#pragma unroll
                  for (int i = 0; i < 8; ++i) { x[i] = xa[i]; x[8 + i] = xb[i]; } }
                float m = 0.f;
#pragma unroll
                for (int i = 0; i < 16; ++i) m = fmaxf(m, fabsf(x[i]));
                m = wave_max_pos(m);
                const float inv = m > 0.f ? 127.0f * __builtin_amdgcn_rcpf(m) : 0.f;
                int qi[16];
#pragma unroll
                for (int i = 0; i < 16; ++i) qi[i] = (int)rintf(x[i] * inv) & 0xff;
                xq[j].x = (unsigned)qi[0] | ((unsigned)qi[1] << 8) | ((unsigned)qi[2] << 16) | ((unsigned)qi[3] << 24); xq[j].y = (unsigned)qi[4] | ((unsigned)qi[5] << 8) | ((unsigned)qi[6] << 16) | ((unsigned)qi[7] << 24);
                xq[j].z = (unsigned)qi[8] | ((unsigned)qi[9] << 8) | ((unsigned)qi[10] << 16) | ((unsigned)qi[11] << 24); xq[j].w = (unsigned)qi[12] | ((unsigned)qi[13] << 8) | ((unsigned)qi[14] << 16) | ((unsigned)qi[15] << 24);
                msel = (utok(lq) == j) ? m : msel;
            }
            sxrv = msel * (1.0f / 127.0f) * rstd;
            asm volatile("s_waitcnt lgkmcnt(0)" ::: "memory");
            unsigned r0[TPW], r1[TPW];
#pragma unroll
            for (int j = 0; j < TPW; ++j) {
                r0[j] = __hip_atomic_fetch_add(cnt + j * 32 + (id0[j] >> SLSH), 1u, __ATOMIC_RELAXED, __HIP_MEMORY_SCOPE_WORKGROUP);
                r1[j] = __hip_atomic_fetch_add(cnt + j * 32 + (id1[j] >> SLSH), 1u, __ATOMIC_RELAXED, __HIP_MEMORY_SCOPE_WORKGROUP); }
            asm volatile("s_waitcnt lgkmcnt(0)" ::: "memory");
#pragma unroll
            for (int j = 0; j < TPW; ++j) {
                const int own = lq < 32 ? (int)cnt[j * 32 + lq] : 0; int c = own;
                c = dpp_iadd<0x111, 0xF>(c); c = dpp_iadd<0x112, 0xF>(c); c = dpp_iadd<0x114, 0xF>(c); c = dpp_iadd<0x118, 0xF>(c); c = dpp_iadd<0x142, 0xA>(c);
                if (lq < 32) cnt[j * 32 + lq] = (unsigned)(c - own); }
            asm volatile("s_waitcnt lgkmcnt(0)" ::: "memory");
#pragma unroll
            for (int j = 0; j < TPW; ++j) {
                const unsigned p0 = cnt[j * 32 + (id0[j] >> SLSH)] + r0[j], p1 = cnt[j * 32 + (id1[j] >> SLSH)] + r1[j];
                *(LAS unsigned long long*)(pw + PW_LIST + (j * 128 + p0) * 8) = (unsigned long long)(unsigned)id0[j] | ((unsigned long long)__float_as_uint(g0[j]) << 32);
                *(LAS unsigned long long*)(pw + PW_LIST + (j * 128 + p1) * 8) = (unsigned long long)(unsigned)id1[j] | ((unsigned long long)__float_as_uint(g1[j]) << 32); }
            asm volatile("s_waitcnt lgkmcnt(0)" ::: "memory");
        }
        {
            UGroup G[UGRP];
#pragma unroll
            for (int q = 0; q < UGRP; ++q) issue_ug<EMASK>(F, G[q], pw, q, lane);
            for (int p = 0; p < 128; p += UGRP) {
                if (p == 64) xcd_barrier_light(bar);
#pragma unroll
                for (int q = 0; q < UGRP; ++q) { compute_ug(G[q], xq, pw, p + q, lane, sxrv); issue_ug<EMASK>(F, G[q], pw, p + UGRP + q, lane); }
            }
        }
        asm volatile("s_waitcnt lgkmcnt(0)" ::: "memory");
        xcd_barrier_light(bar);
        float stok[TPW];
        int lc = lane; asm volatile("" : "+v"(lc));
#pragma unroll
        for (int j = 0; j < TPW; ++j) {
            const unsigned long long a0 = *(const LAS unsigned long long*)(pw + PW_LIST + (j * 128 + lc) * 8), a1 = *(const LAS unsigned long long*)(pw + PW_LIST + (j * 128 + 64 + lc) * 8);
            const float c0 = __uint_as_float((unsigned)(a0 >> 32)), c1 = __uint_as_float((unsigned)(a1 >> 32));
            const float m = wave_max_pos(fmaxf(fabsf(c0), fabsf(c1)));
            const float sc = m > 0.f ? 127.0f * __builtin_amdgcn_rcpf(m) : 0.f;
            stok[j] = m * (1.0f / 127.0f);
            *(LAS unsigned short*)(pw + PW_XQ + (j * 128 + lc) * 2) = (unsigned short)(unsigned)a0; *(LAS unsigned short*)(pw + PW_XQ + (j * 128 + 64 + lc) * 2) = (unsigned short)(unsigned)a1;
            *(LAS signed char*)(pw + PW_XQ + 2048 + j * 128 + lc) = (signed char)(int)rintf(c0 * sc); *(LAS signed char*)(pw + PW_XQ + 2048 + j * 128 + 64 + lc) = (signed char)(int)rintf(c1 * sc);
        }
        asm volatile("s_waitcnt lgkmcnt(0)" ::: "memory");
        int acc[TPW][16];
#pragma unroll
        for (int j = 0; j < TPW; ++j)
#pragma unroll
            for (int i = 0; i < 16; ++i) acc[j][i] = 0;
        {
            struct VG4 { u32x4 r[4]; int cw4; };
            VG4 S[VGRP];
#define PEER_VISSUE(S_, j_, gp_) do { const int g_ = (gp_) < 32 ? (gp_) : 31; \
                const unsigned long long ev_ = *(const LAS unsigned long long*)(pw + PW_XQ + ((j_) * 128 + 4 * g_) * 2); \
                const unsigned s0_ = (unsigned)__builtin_amdgcn_readfirstlane((int)(unsigned)ev_), s1_ = (unsigned)__builtin_amdgcn_readfirstlane((int)(unsigned)(ev_ >> 32)); \
                (S_).cw4 = __builtin_amdgcn_readfirstlane(*(const LAS int*)(pw + PW_XQ + 2048 + (j_) * 128 + 4 * g_)); \
                (S_).r[0] = *(const u32x4*)(F.V8 + (size_t)((s0_ & 0xffffu) & (unsigned)EMASK) * D + 16 * lane); (S_).r[1] = *(const u32x4*)(F.V8 + (size_t)((s0_ >> 16) & (unsigned)EMASK) * D + 16 * lane); \
                (S_).r[2] = *(const u32x4*)(F.V8 + (size_t)((s1_ & 0xffffu) & (unsigned)EMASK) * D + 16 * lane); (S_).r[3] = *(const u32x4*)(F.V8 + (size_t)((s1_ >> 16) & (unsigned)EMASK) * D + 16 * lane); } while (0)
#define PEER_VTR(A_, i_, a0_, a1_, a2_, a3_, cw_) do { \
                const unsigned x01l_ = __builtin_amdgcn_perm(a1_, a0_, 0x05010400u), x01h_ = __builtin_amdgcn_perm(a1_, a0_, 0x07030602u); \
                const unsigned x23l_ = __builtin_amdgcn_perm(a3_, a2_, 0x05010400u), x23h_ = __builtin_amdgcn_perm(a3_, a2_, 0x07030602u); \
                A_[4 * (i_) + 0] = __builtin_amdgcn_sdot4((int)__builtin_amdgcn_perm(x23l_, x01l_, 0x05040100u), cw_, A_[4 * (i_) + 0], false); \
                A_[4 * (i_) + 1] = __builtin_amdgcn_sdot4((int)__builtin_amdgcn_perm(x23l_, x01l_, 0x07060302u), cw_, A_[4 * (i_) + 1], false); \
                A_[4 * (i_) + 2] = __builtin_amdgcn_sdot4((int)__builtin_amdgcn_perm(x23h_, x01h_, 0x05040100u), cw_, A_[4 * (i_) + 2], false); \
                A_[4 * (i_) + 3] = __builtin_amdgcn_sdot4((int)__builtin_amdgcn_perm(x23h_, x01h_, 0x07060302u), cw_, A_[4 * (i_) + 3], false); } while (0)
#pragma unroll
            for (int n = 0; n < VGRP; ++n) PEER_VISSUE(S[n], n % TPW, n / TPW);
            for (int gp = 0; gp < 32; ++gp) {
                if (gp == 16) xcd_barrier_light(bar);
#pragma unroll
                for (int j = 0; j < TPW; ++j) {
                    VG4& G = S[j % VGRP];
                    PEER_VTR(acc[j], 0, G.r[0].x, G.r[1].x, G.r[2].x, G.r[3].x, G.cw4); PEER_VTR(acc[j], 1, G.r[0].y, G.r[1].y, G.r[2].y, G.r[3].y, G.cw4);
                    PEER_VTR(acc[j], 2, G.r[0].z, G.r[1].z, G.r[2].z, G.r[3].z, G.cw4); PEER_VTR(acc[j], 3, G.r[0].w, G.r[1].w, G.r[2].w, G.r[3].w, G.cw4);
                    PEER_VISSUE(G, (j + VGRP) % TPW, gp + (j + VGRP) / TPW);
                }
            }
#undef PEER_VISSUE
#undef PEER_VTR
        }
#pragma unroll
        for (int j = 0; j < TPW; ++j) {
            float* orow = outp + (size_t)(t0 + j) * D + 16 * lane;
            float y[16]; float ss = 0.f;
            { float ha[8], hb[8]; unpack8(*(const uint4*)(F.HB + (size_t)(t0 + j) * D + 16 * lane), ha); unpack8(*(const uint4*)(F.HB + (size_t)(t0 + j) * D + 16 * lane + 8), hb);
#pragma unroll
              for (int i = 0; i < 8; ++i) { y[i] = ha[i] + stok[j] * (float)acc[j][i]; y[8 + i] = hb[i] + stok[j] * (float)acc[j][8 + i]; } }
#pragma unroll
            for (int i = 0; i < 16; ++i) ss += y[i] * y[i];
            const float r = 1.0f / sqrtf(wave_total(ss) * (1.f / D) + RMS_EPS);
#pragma unroll
            for (int q = 0; q < 4; ++q) { const float4 wv = *(const float4*)(F.nfin + 16 * lane + 4 * q);
                *(float4*)(orow + 4 * q) = make_float4(y[4 * q] * r * wv.x, y[4 * q + 1] * r * wv.y, y[4 * q + 2] * r * wv.z, y[4 * q + 3] * r * wv.w); }
        }
        asm volatile("s_waitcnt lgkmcnt(0)" ::: "memory");
    }
}
}

constexpr int N_PHASES = 11;
__global__ void __launch_bounds__(NTHREADS, 2) mk_fwd(Args args) {
    extern __shared__ __attribute__((aligned(16))) unsigned char lds[];
    Frame F;
    F.lds = lds;
    F.tid = threadIdx.x; F.lane = F.tid & 63; F.wave = __builtin_amdgcn_readfirstlane(F.tid >> 6);
    F.G = gridDim.x; F.bid = blockIdx.x;
    F.x = args.in[0]; F.nmw = args.in[1]; F.w_in = args.in[2]; F.lbp = args.in[3]; F.hnw = args.in[4]; F.dlam = args.in[5]; F.dnw = args.in[6];
    F.w_out = args.in[7]; F.nfw = args.in[8]; F.wq = args.in[9]; F.sk = args.in[10]; F.u = args.in[11]; F.v = args.in[12]; F.nfin = args.in[13];
    F.out = args.out;
    unsigned char* ws = args.ws;
    F.WinT = (bf16*)(ws + WS_WIN); F.WoT = (bf16*)(ws + WS_WO); F.WqT = (bf16*)(ws + WS_WQ); F.SKb = (bf16*)(ws + WS_SK);
    F.XN = (bf16*)(ws + WS_XN); F.MIX = (bf16*)(ws + WS_MIX);
    F.PROJ = (bf16*)(ws + WS_PROJ); F.HB = (bf16*)(ws + WS_HB); F.QH = (bf16*)(ws + WS_QH);
    F.HA = (float*)(ws + WS_HA); F.HO = (float*)(ws + WS_HO); F.PSQ = (float*)(ws + WS_PSQ); F.GW = (float*)(ws + WS_G);
    F.IDX = (int*)(ws + WS_IDX); F.DECG = (float*)(ws + WS_DECG);
    F.U8 = ws + WS_U8; F.V8 = ws + WS_V8; F.US = (float*)(ws + WS_US);
    const int lo = args.ph_lo, hi = args.ph_hi;
    volatile LAS unsigned* MISC = (volatile LAS unsigned*)((LAS unsigned char*)lds + MISC_OFF);
    if (F.tid < 32) MISC[F.tid] = 0u;
    __syncthreads();
    XcdBarrier bar; bar.bar = (unsigned*)(ws + WS_CTL) + 4096; bar.x = 0; bar.st = nullptr;
    if (hi - lo > 1) bar = xcd_barrier_post((unsigned*)(ws + WS_CTL) + 4096, MISC + 8);
#define IN(k) (lo <= (k) && (k) < hi)
#define SEAM(k) do { if (IN(k) && IN((k) + 1)) xcd_barrier(bar); } while (0)
    if (IN(0)) { stage_prep(F, 1 | 4);
    }
    SEAM(0);
    if (IN(1)) { pg8::Gemm g{F.XN, F.WinT, T, DIN, D}; pg8::StaticOrder S; S.init(T, DIN, F.G, F.bid); EpiIn E{F.PROJ, F.HA, F.lbp};
        pg8::gemm_phase<EpiIn, pg8::StaticOrder, true, true>((PG8_LAS unsigned char*)lds, g, S, E); }
    if (IN(1) && IN(3)) xcd_barrier(bar);
    if (IN(3)) for (int task = F.bid; task < BATCH * 4 * 64; task += F.G) hg::hgrn_pre(F, task);
    if (IN(3) && IN(4)) xcd_barrier(bar);
    if (IN(4)) { for (int unit = F.bid; unit < 32; unit += F.G) hg::hgrn_scan(F, unit >> 2, unit & 3);
        da::attn_phase(F, (unsigned*)(ws + WS_CTL), MISC);
    }
    SEAM(5);
    if (IN(6)) { pg8::Gemm g{F.MIX, F.WoT, T, D, D}; pg8::StaticOrder S; S.init(T, D, F.G, F.bid); EpiOut E{F.x, F.HB, F.PSQ};
        pg8::gemm_phase<EpiOut, pg8::StaticOrder, true, true>((PG8_LAS unsigned char*)lds, g, S, E); }
    if (IN(6) && IN(8)) xcd_barrier(bar);
    if (IN(8)) { pg8::Gemm g{F.HB, F.WqT, T, 2048, D}; pg8::StaticOrder S; S.init(T, 2048, F.G, F.bid); EpiQ E{F.QH};
        pg8::gemm_phase<EpiQ, pg8::StaticOrder, true, true>((PG8_LAS unsigned char*)lds, g, S, E); }
    SEAM(8);
    if (IN(9)) tk::topk_phase(F);
    SEAM(9);
    if (IN(10)) { peer::peer_phase_t<0xffff, 0>(F, F.out, bar);
    }
#undef IN
#undef SEAM
}

extern "C" void kernel_launch(void* const* d_in, const int* in_sizes, int n_in, void* d_out, int out_size, void* d_ws, size_t ws_size, hipStream_t stream) {
    static int grid = 0;
    if (grid == 0) {
        if (n_in != 14 || in_sizes[0] != T * D || out_size != T * D || ws_size < WS_END) {
            fprintf(stderr, "kernel_launch: unexpected shapes: n_in %d in0 %d out %d ws %zu (need %zu)\n", n_in, n_in > 0 ? in_sizes[0] : -1, out_size, ws_size, (size_t)WS_END);
            grid = -1; return; }
        int dev = 0, cus = 0;
        if (hipGetDevice(&dev) != hipSuccess || hipDeviceGetAttribute(&cus, hipDeviceAttributeMultiprocessorCount, dev) != hipSuccess) { grid = -1; return; }
        if (hipFuncSetAttribute((const void*)mk_fwd, hipFuncAttributeMaxDynamicSharedMemorySize, LDS_BYTES) != hipSuccess) { fprintf(stderr, "kernel_launch: hipFuncSetAttribute failed\n"); grid = -1; return; }
        int per_cu = 0;
        if (hipOccupancyMaxActiveBlocksPerMultiprocessor(&per_cu, (const void*)mk_fwd, NTHREADS, LDS_BYTES) != hipSuccess || per_cu < 1) {
            fprintf(stderr, "kernel_launch: the occupancy query reports %d workgroups per CU for %d threads / %d B of LDS; nothing launched\n", per_cu, NTHREADS, LDS_BYTES); grid = -1; return; }
        (void)hipGetLastError();
        grid = cus;
    }
    if (grid < 0) return;
    Args a{};
    for (int i = 0; i < 14; ++i) a.in[i] = (const float*)d_in[i];
    a.out = (float*)d_out; a.ws = (unsigned char*)d_ws;
    if (hipMemsetAsync((char*)d_ws + WS_CTL, 0, 64 * 1024, stream) != hipSuccess) { fprintf(stderr, "kernel_launch: memset failed\n"); return; }
    a.ph_lo = 0; a.ph_hi = N_PHASES;
    hipLaunchKernelGGL(mk_fwd, dim3(grid), dim3(NTHREADS), LDS_BYTES, stream, a);
}
```

```cpp
#include <hip/hip_runtime.h>
#include <cstdio>
#include <cstdint>

constexpr int BATCH = 8, SEQ = 4096, T = BATCH * SEQ, D = 1024, DIN = 3584;
constexpr int NEXP = 16384;
constexpr float RMS_EPS = 1e-6f;
constexpr int NWAVES = 8, NTHREADS = NWAVES * 64;

constexpr int C_HQ = 0, C_HF = 512, C_HI = 1024, C_HG = 1536, C_AQ = 2048, C_AK = 2560, C_AV = 3072;

constexpr size_t MiB = 1u << 20;
constexpr size_t WS_CTL = 0;
constexpr size_t WS_WIN = 2 * MiB;
constexpr size_t WS_WO = 9 * MiB;
constexpr size_t WS_WQ = 11 * MiB;
constexpr size_t WS_SK = 15 * MiB;
constexpr size_t WS_U8 = 16 * MiB;
constexpr size_t WS_V8 = 32 * MiB;
constexpr size_t WS_US = 48 * MiB;
constexpr size_t WS_XN = 80 * MiB;
constexpr size_t WS_MIX = 80 * MiB;
constexpr size_t WS_PROJ = 144 * MiB;
constexpr size_t WS_HA = 368 * MiB;
constexpr size_t WS_HO = 432 * MiB;
constexpr size_t WS_PSQ = 496 * MiB;
constexpr size_t WS_HB = 144 * MiB;
constexpr size_t WS_QH = 208 * MiB;
constexpr size_t WS_IDX = 336 * MiB;
constexpr size_t WS_G = 352 * MiB;
constexpr size_t WS_DECG = 498 * MiB;
constexpr size_t WS_END = 499 * MiB;

constexpr int LDS_BYTES = 147456;
constexpr int MISC_OFF = 139520 + 64;

typedef unsigned short bf16;
#define LAS __attribute__((address_space(3)))

__device__ __forceinline__ unsigned f2bf(float f) { unsigned u = __builtin_bit_cast(unsigned, f); return (u + 0x7fffu + ((u >> 16) & 1u)) >> 16; }
__device__ __forceinline__ unsigned pk2(float lo, float hi) { return f2bf(lo) | (f2bf(hi) << 16); }
__device__ __forceinline__ float bf2f(unsigned b) { return __builtin_bit_cast(float, b << 16); }
__device__ __forceinline__ float bflo(unsigned w) { return __builtin_bit_cast(float, w << 16); }
__device__ __forceinline__ float bfhi(unsigned w) { return __builtin_bit_cast(float, w & 0xffff0000u); }
__device__ __forceinline__ float wave_sum(float v) {
#pragma unroll
    for (int o = 1; o < 64; o <<= 1) v += __shfl_xor(v, o);
    return v;
}


#define GAS __attribute__((address_space(1)))
typedef GAS unsigned gu32;
#define RLX_AGENT __ATOMIC_RELAXED, __HIP_MEMORY_SCOPE_AGENT
#define XB_TMO      128
#define XB_XCNT(j)  (256  + 64 * (j))
#define XB_XSUB(j)  (1280 + 64 * (j))
#define XB_XGEN(j)  (2304 + 64 * (j))
#define XB_TOP      3328
#define XB_TOPGEN   3392
#define XCD_BAR_WORDS 3456
#define XB_SPIN_CAP (1u << 22)
__device__ __forceinline__ unsigned xb_ld(unsigned* p)              { return __hip_atomic_load(p, __ATOMIC_RELAXED, __HIP_MEMORY_SCOPE_AGENT); }
__device__ __forceinline__ unsigned xb_add(unsigned* p, unsigned v) { return __hip_atomic_fetch_add(p, v, __ATOMIC_RELAXED, __HIP_MEMORY_SCOPE_AGENT); }
__device__ __forceinline__ unsigned xb_xcc_id() { return (unsigned)__builtin_amdgcn_s_getreg((3 << 11) | 20) & 0xFu; }
#define XB_SPIN(cond, bar) do { unsigned _sp = 0; while (cond) { __builtin_amdgcn_s_sleep(1); \
    if ((++_sp & 255u) == 0u) { if (xb_ld(&(bar)[XB_TMO])) break; if (_sp > XB_SPIN_CAP) { atomicAdd(&(bar)[XB_TMO], 1u); break; } } } } while (0)
struct XcdBarrier { unsigned* bar; unsigned x; volatile LAS unsigned* st; };
__device__ __forceinline__ XcdBarrier xcd_barrier_post(unsigned* bar, volatile LAS unsigned* st) {
    XcdBarrier b; b.bar = bar; b.x = xb_xcc_id(); b.st = st;
    if (threadIdx.x == 0) (void)xb_add(&bar[XB_XCNT(b.x)], 1u);
    return b;
}
__device__ __forceinline__ void xcd_barrier_complete(unsigned* bar, unsigned x, unsigned& nloc, unsigned& nx) {
    const unsigned G = gridDim.x * gridDim.y * gridDim.z;
    unsigned sum, cnt, mine, sp = 0u;
    for (;;) {
        sum = 0u; cnt = 0u; mine = 0u;
#pragma unroll
        for (unsigned j = 0; j < 16; ++j) { const unsigned c = xb_ld(&bar[XB_XCNT(j)]); sum += c; cnt += (c > 0u) ? 1u : 0u; mine = (j == x) ? c : mine; }
        if (sum == G) break;
        __builtin_amdgcn_s_sleep(1);
        if ((++sp & 255u) == 0u) { if (xb_ld(&bar[XB_TMO])) break; if (sp > XB_SPIN_CAP) { atomicAdd(&bar[XB_TMO], 1u); break; } }
    }
    nloc = mine > 0u ? mine : 1u; nx = cnt > 0u ? cnt : 1u;
}
__device__ __forceinline__ void xcd_barrier(const XcdBarrier& b) {
    asm volatile("s_waitcnt vmcnt(0)" ::: "memory");
    __syncthreads();
    if (threadIdx.x == 0) {
        unsigned* bar = b.bar;
        __builtin_amdgcn_s_waitcnt(0);
        unsigned nloc = b.st[0], nx = b.st[1];
        if (nloc == 0u) { xcd_barrier_complete(bar, b.x, nloc, nx); b.st[0] = nloc; b.st[1] = nx; }
        const unsigned old = xb_add(&bar[XB_XSUB(b.x)], 1u);
        const unsigned gen = old / nloc;
        if (old + 1u == (gen + 1u) * nloc) {
            __builtin_amdgcn_fence(__ATOMIC_RELEASE, "agent");
            asm volatile("s_waitcnt vmcnt(0)" ::: "memory");
            const unsigned og = xb_add(&bar[XB_TOP], 1u);
            const unsigned tg = og / nx;
            if (og + 1u == (tg + 1u) * nx) xb_add(&bar[XB_TOPGEN], 1u);
            else XB_SPIN(xb_ld(&bar[XB_TOPGEN]) == tg, bar);
            __builtin_amdgcn_fence(__ATOMIC_ACQUIRE, "agent");
            xb_add(&bar[XB_XGEN(b.x)], 1u);
            asm volatile("s_waitcnt vmcnt(0)" ::: "memory");
        } else {
            XB_SPIN(xb_ld(&bar[XB_XGEN(b.x)]) == gen, bar);
            __builtin_amdgcn_fence(__ATOMIC_ACQUIRE, "agent");
            asm volatile("s_waitcnt vmcnt(0)" ::: "memory");
        }
    }
    __syncthreads();
}

__device__ __forceinline__ void xcd_barrier_light(const XcdBarrier& b) {
    __syncthreads();
    if (threadIdx.x == 0) {
        unsigned* bar = b.bar;
        unsigned nloc = b.st[0], nx = b.st[1];
        if (nloc == 0u) { xcd_barrier_complete(bar, b.x, nloc, nx); b.st[0] = nloc; b.st[1] = nx; }
        const unsigned old = xb_add(&bar[XB_XSUB(b.x)], 1u);
        const unsigned gen = old / nloc;
        if (old + 1u == (gen + 1u) * nloc) {
            const unsigned og = xb_add(&bar[XB_TOP], 1u);
            const unsigned tg = og / nx;
            if (og + 1u == (tg + 1u) * nx) xb_add(&bar[XB_TOPGEN], 1u);
            else XB_SPIN(xb_ld(&bar[XB_TOPGEN]) == tg, bar);
            xb_add(&bar[XB_XGEN(b.x)], 1u);
        } else {
            XB_SPIN(xb_ld(&bar[XB_XGEN(b.x)]) == gen, bar);
        }
    }
    __syncthreads();
}

struct Args { const float* in[14]; float* out; unsigned char* ws; int ph_lo, ph_hi; };

struct Frame {
    unsigned char* lds;
    int tid, lane, wave, G, bid;
    const float *x, *nmw, *w_in, *lbp, *hnw, *dlam, *dnw, *w_out, *nfw, *wq, *sk, *u, *v, *nfin;
    float* out;
    bf16 *WinT, *WoT, *WqT, *SKb, *XN, *MIX, *PROJ, *HB, *QH;
    float *HA, *HO, *PSQ, *GW, *US, *DECG;
    int* IDX;
    unsigned char *U8, *V8;
};

__device__ __forceinline__ void transpose_item(const float* W, const float* scale, int K, int N, bf16* WT, float* scr, int item, int lane) {
    const int nblk = N / 32, kb = item / nblk, nb = item % nblk, k0 = 64 * kb, n0 = 32 * nb;
#pragma unroll 8
    for (int i = 0; i < 32; ++i) { const int kk = 2 * i + (lane >> 5); float s = scale ? scale[k0 + kk] : 1.0f; scr[kk * 33 + (lane & 31)] = W[(size_t)(k0 + kk) * N + n0 + (lane & 31)] * s; }
    __builtin_amdgcn_s_waitcnt(0xc07f); asm volatile("" ::: "memory");
    const int c = lane & 7;
#pragma unroll
    for (int j = 0; j < 4; ++j) { const int n = (lane >> 3) + 8 * j; const float* s = scr + (8 * c) * 33 + n;
        uint4 o; o.x = pk2(s[0 * 33], s[1 * 33]); o.y = pk2(s[2 * 33], s[3 * 33]); o.z = pk2(s[4 * 33], s[5 * 33]); o.w = pk2(s[6 * 33], s[7 * 33]);
        *(uint4*)(WT + (size_t)(n0 + n) * K + k0 + 8 * c) = o; }
    __builtin_amdgcn_s_waitcnt(0xc07f); asm volatile("" ::: "memory");
}

__device__ __forceinline__ void stage_prep(Frame& F, const int parts = 7) {
    float* scr = (float*)(F.lds + F.wave * 16384);
    const int gw = F.bid * NWAVES + F.wave, NGW = F.G * NWAVES;
    constexpr int I_IN = (D / 64) * (DIN / 32), I_O = (D / 64) * (D / 32), I_Q = (D / 64) * (2048 / 32);
    if (parts & 1) for (int it = gw; it < I_IN + I_O + I_Q; it += NGW) {
        int r = it;
        if (r < I_IN) { transpose_item(F.w_in, nullptr, D, DIN, F.WinT, scr, r, F.lane); continue; } r -= I_IN;
        if (r < I_O) { transpose_item(F.w_out, nullptr, D, D, F.WoT, scr, r, F.lane); continue; } r -= I_O;
        transpose_item(F.wq, F.nfw, D, 2048, F.WqT, scr, r, F.lane);
    }
    const size_t gt = (size_t)F.bid * NTHREADS + F.tid, NGT = (size_t)F.G * NTHREADS;
    if (parts & 2) for (int e = gw; e < NEXP; e += NGW) {
        const float4* ur = (const float4*)(F.u + (size_t)e * D) + F.lane; const float4* vr = (const float4*)(F.v + (size_t)e * D) + F.lane; const float4* wr = (const float4*)F.nfw + F.lane;
        float4 a[4], b[4]; float mu = 0.f, mv = 0.f;
#pragma unroll
        for (int j = 0; j < 4; ++j) { const float4 w = wr[64 * j]; a[j] = ur[64 * j]; b[j] = vr[64 * j]; a[j].x *= w.x; a[j].y *= w.y; a[j].z *= w.z; a[j].w *= w.w;
            mu = fmaxf(mu, fmaxf(fmaxf(fabsf(a[j].x), fabsf(a[j].y)), fmaxf(fabsf(a[j].z), fabsf(a[j].w))));
            mv = fmaxf(mv, fmaxf(fmaxf(fabsf(b[j].x), fabsf(b[j].y)), fmaxf(fabsf(b[j].z), fabsf(b[j].w)))); }
#pragma unroll
        for (int o = 1; o < 64; o <<= 1) { mu = fmaxf(mu, __shfl_xor(mu, o)); mv = fmaxf(mv, __shfl_xor(mv, o)); }
        const float iu = mu > 0.f ? 127.0f / mu : 0.f, iv = mv > 0.f ? 127.0f / mv : 0.f;
        unsigned* u8 = (unsigned*)(F.U8 + (size_t)e * D) + F.lane; unsigned* v8 = (unsigned*)(F.V8 + (size_t)e * D) + F.lane;
#pragma unroll
        for (int j = 0; j < 4; ++j) {
            const int q0 = (int)rintf(a[j].x * iu), q1 = (int)rintf(a[j].y * iu), q2 = (int)rintf(a[j].z * iu), q3 = (int)rintf(a[j].w * iu);
            u8[64 * j] = (unsigned)(q0 & 0xff) | ((unsigned)(q1 & 0xff) << 8) | ((unsigned)(q2 & 0xff) << 16) | ((unsigned)(q3 & 0xff) << 24);
            const int p0 = (int)rintf(b[j].x * iv), p1 = (int)rintf(b[j].y * iv), p2 = (int)rintf(b[j].z * iv), p3 = (int)rintf(b[j].w * iv);
            v8[64 * j] = (unsigned)(p0 & 0xff) | ((unsigned)(p1 & 0xff) << 8) | ((unsigned)(p2 & 0xff) << 16) | ((unsigned)(p3 & 0xff) << 24); }
        if (F.lane == 0) { F.US[2 * e] = mu * (1.0f / 127.0f); F.US[2 * e + 1] = mv * (1.0f / 127.0f); }
    }
    if (parts & 2) for (size_t i = gt; i < (size_t)8 * 2 * 128 * 128 / 8; i += NGT) {
        const float4 c = *(const float4*)(F.sk + i * 8), d = *(const float4*)(F.sk + i * 8 + 4);
        uint4 p; p.x = pk2(c.x, c.y); p.y = pk2(c.z, c.w); p.z = pk2(d.x, d.y); p.w = pk2(d.z, d.w);
        *(uint4*)(F.SKb + i * 8) = p;
    }
    if (parts & 4) {
        float4 wv[4];
#pragma unroll
        for (int j = 0; j < 4; ++j) wv[j] = ((const float4*)F.nmw)[F.lane + 64 * j];
        for (int m = gw; m < T; m += 2 * NGW) {
            const int m1 = m + NGW; const bool has1 = m1 < T;
            const float4* xr0 = (const float4*)(F.x + (size_t)m * D) + F.lane; const float4* xr1 = (const float4*)(F.x + (size_t)(has1 ? m1 : m) * D) + F.lane;
            float4 v0[4], v1[4]; float s0 = 0.f, s1 = 0.f;
#pragma unroll
            for (int j = 0; j < 4; ++j) { v0[j] = xr0[64 * j]; v1[j] = xr1[64 * j]; }
#pragma unroll
            for (int j = 0; j < 4; ++j) { s0 += (v0[j].x * v0[j].x + v0[j].y * v0[j].y) + (v0[j].z * v0[j].z + v0[j].w * v0[j].w); s1 += (v1[j].x * v1[j].x + v1[j].y * v1[j].y) + (v1[j].z * v1[j].z + v1[j].w * v1[j].w); }
#pragma unroll
            for (int o = 1; o < 64; o <<= 1) { s0 += __shfl_xor(s0, o); s1 += __shfl_xor(s1, o); }
            const float r0 = 1.0f / sqrtf(s0 * (1.f / D) + RMS_EPS), r1 = 1.0f / sqrtf(s1 * (1.f / D) + RMS_EPS);
            unsigned long long* o0 = (unsigned long long*)(F.XN + (size_t)m * D) + F.lane; unsigned long long* o1 = (unsigned long long*)(F.XN + (size_t)m1 * D) + F.lane;
#pragma unroll
            for (int j = 0; j < 4; ++j) {
                o0[64 * j] = (unsigned long long)pk2(v0[j].x * r0 * wv[j].x, v0[j].y * r0 * wv[j].y) | ((unsigned long long)pk2(v0[j].z * r0 * wv[j].z, v0[j].w * r0 * wv[j].w) << 32);
                if (has1) o1[64 * j] = (unsigned long long)pk2(v1[j].x * r1 * wv[j].x, v1[j].y * r1 * wv[j].y) | ((unsigned long long)pk2(v1[j].z * r1 * wv[j].z, v1[j].w * r1 * wv[j].w) << 32); }
        }
    }
}

namespace pg8 {
#define PG8_LAS __attribute__((address_space(3)))
typedef unsigned short bf16_t;
typedef short bf16x8 __attribute__((ext_vector_type(8)));
typedef float f32x4 __attribute__((ext_vector_type(4)));
typedef unsigned u32x4 __attribute__((ext_vector_type(4)));
constexpr int BM = 256, BK = 64, HALF = 128, HTB = HALF * BK * 2  , STAGE_BYTES = 8 * HTB, NXCD = 8, WGM = 8;

__host__ __device__ __forceinline__ int lds_byte(int r, int c) { const int st = (r >> 4) * 2 + (c >> 5), rr = r & 15, cc = c & 31, ob = rr * 64 + cc * 2; return st * 1024 + (ob ^ (((ob >> 9) & 1) << 5)); }
__host__ __device__ __forceinline__ void stage_rc(int b, int& R, int& C) { const int st = b / 1024, sb = b % 1024, swz = sb ^ (((sb >> 9) & 1) << 5); R = (st >> 1) * 16 + swz / 64; C = (st & 1) * 32 + (swz % 64) / 2; }
__host__ __device__ __forceinline__ int perm32(int rho) { const int n = rho >> 4, i = rho & 15; return 8 * (i >> 2) + 4 * n + (i & 3); }

struct Unit { int pm, pn; };
struct Gemm { const bf16_t* A; const bf16_t* Bt; int M, N, K; };

struct StaticOrder {
    int nM, nN, nwg, G, c;
    __host__ __device__ void init(int M, int N, int G_, int c_) { nM = M / BM; nN = N / BM; nwg = nM * nN; G = G_; c = c_; }
    __host__ __device__ bool next(int i, Unit& u) const {
        const long L = (long)i * G + c; if (L >= nwg) return false;
        int wgid = (int)L; { const int q = nwg / NXCD, r = nwg % NXCD, xcd = wgid % NXCD, off = wgid / NXCD; wgid = (xcd < r ? xcd * (q + 1) : r * (q + 1) + (xcd - r) * q) + off; }
        const int nig = WGM * nN, gid = wgid / nig, fm = gid * WGM, gsz = (nM - fm) < WGM ? (nM - fm) : WGM;
        u.pm = fm + ((wgid % nig) % gsz); u.pn = (wgid % nig) / gsz; return true;
    }
    __device__ __forceinline__ void a_ready(const Unit&) const {}
    __device__ __forceinline__ void done(const Unit&) const {}
};

__device__ __forceinline__ unsigned cvt_pk_bf16(float lo, float hi) { unsigned r; asm volatile("v_cvt_pk_bf16_f32 %0, %1, %2" : "=v"(r) : "v"(lo), "v"(hi)); return r; }
template <class Epi, class Sched, bool ALIGN_EPI = false, bool SP2 = false>
__device__ __forceinline__ void gemm_phase(PG8_LAS unsigned char* lds, const Gemm g, const Sched& S, const Epi& E) {
    const int tid = threadIdx.x, wid = __builtin_amdgcn_readfirstlane(tid >> 6), lane = tid & 63, wr = wid >> 2, wc = wid & 3, fr = lane & 15, fq = lane >> 4;
    const int K = g.K, nt = K / BK;
    unsigned voffA[2], voffB[2];
#pragma unroll
    for (int i = 0; i < 2; ++i) { int R, C; stage_rc(tid * 16 + i * 8192, R, C); const int Rb = Epi::PERM ? ((R & ~31) + perm32(R & 31)) : R;
        voffA[i] = (unsigned)(R * K + C) * 2u; voffB[i] = (unsigned)(Rb * K + C) * 2u; }
    const size_t kstep = (size_t)(BK * 2);
    const size_t hstep = (size_t)HALF * K * 2;
    const size_t tstep = 2 * hstep;
    const unsigned ldsw = (unsigned)wid * 1024u;
    const int aoff = lds_byte(wr * 64 + fr, fq * 8), boff = lds_byte(wc * 32 + fr, fq * 8);
#define PG8_SA(b, h) (((b) * 2 + (h)) * HTB)
#define PG8_SB(b, h) ((4 + (b) * 2 + (h)) * HTB)
#define PG8_STAGE(bufoff, gbase, voff) do { _Pragma("unroll") for (int _i = 0; _i < 2; ++_i) \
        __builtin_amdgcn_global_load_lds((const unsigned*)((const char*)(gbase) + (voff)[_i]), (PG8_LAS unsigned*)(lds + (bufoff) + ldsw + _i * 8192), 16, 0, 0); } while (0)
#define PG8_LDA(dst, b, h) do { _Pragma("unroll") for (int m = 0; m < 4; ++m) _Pragma("unroll") for (int k = 0; k < 2; ++k) dst[m][k] = *(const PG8_LAS bf16x8*)(lds + PG8_SA(b, h) + aoff + m * 2048 + k * 1024); } while (0)
#define PG8_LDB(dst, b, h) do { _Pragma("unroll") for (int n = 0; n < 2; ++n) _Pragma("unroll") for (int k = 0; k < 2; ++k) dst[n][k] = *(const PG8_LAS bf16x8*)(lds + PG8_SB(b, h) + boff + n * 2048 + k * 1024); } while (0)
#define PG8_MMA(ai, bj, At, Bt) do { __builtin_amdgcn_s_setprio(1); _Pragma("unroll") for (int m = 0; m < 4; ++m) _Pragma("unroll") for (int n = 0; n < 2; ++n) _Pragma("unroll") for (int k = 0; k < 2; ++k) \
        acc[ai][bj][m][n] = __builtin_amdgcn_mfma_f32_16x16x32_bf16(Bt[n][k], At[m][k], acc[ai][bj][m][n], 0, 0, 0); __builtin_amdgcn_s_setprio(0); } while (0)
#define PG8_WAIT_V(n) asm volatile("s_waitcnt vmcnt(" #n ")" ::: "memory")
#define PG8_WAIT_L(n) asm volatile("s_waitcnt lgkmcnt(" #n ")" ::: "memory")
#define PG8_BAR __builtin_amdgcn_s_barrier()
#define PG8_SCHED __builtin_amdgcn_sched_barrier(0)
    Unit cur, nxt; int ui = 0;
    if (!S.next(0, cur)) return;
    f32x4 acc[2][2][4][2];
#pragma unroll
    for (int a = 0; a < 2; ++a)
#pragma unroll
        for (int b = 0; b < 2; ++b)
#pragma unroll
            for (int m = 0; m < 4; ++m)
#pragma unroll
                for (int n = 0; n < 2; ++n) acc[a][b][m][n] = (f32x4){0.f, 0.f, 0.f, 0.f};
    bf16x8 At[4][2], B0[2][2], B1[2][2];
    const char* cA = (const char*)g.A + (size_t)cur.pm * tstep; const char* cB = (const char*)g.Bt + (size_t)cur.pn * tstep;
    S.a_ready(cur);
    if constexpr (SP2) {
        PG8_STAGE(PG8_SB(0, 0), cB, voffB); PG8_STAGE(PG8_SB(0, 1), cB + hstep, voffB); PG8_STAGE(PG8_SA(0, 0), cA, voffA); PG8_STAGE(PG8_SA(0, 1), cA + hstep, voffA);
        if (wr == 1) PG8_BAR;
        PG8_WAIT_V(2); PG8_BAR;
        PG8_STAGE(PG8_SB(1, 0), cB + kstep, voffB); PG8_STAGE(PG8_SA(1, 0), cA + kstep, voffA); PG8_STAGE(PG8_SB(1, 1), cB + hstep + kstep, voffB);
        PG8_WAIT_V(6); PG8_BAR;
    } else {
        PG8_STAGE(PG8_SB(0, 0), cB, voffB); PG8_STAGE(PG8_SA(0, 0), cA, voffA); PG8_STAGE(PG8_SB(0, 1), cB + hstep, voffB); PG8_STAGE(PG8_SA(0, 1), cA + hstep, voffA);
        if (wr == 1) PG8_BAR;
        PG8_WAIT_V(4); PG8_BAR;
        PG8_STAGE(PG8_SB(1, 0), cB + kstep, voffB); PG8_STAGE(PG8_SA(1, 0), cA + kstep, voffA); PG8_STAGE(PG8_SB(1, 1), cB + hstep + kstep, voffB);
        PG8_WAIT_V(6); PG8_BAR;
    }
    for (;;) {
        const bool has_next = S.next(ui + 1, nxt);
        const char* nA = has_next ? (const char*)g.A + (size_t)nxt.pm * tstep : cA; const char* nB = has_next ? (const char*)g.Bt + (size_t)nxt.pn * tstep : cB;
        for (int t = 0; t < nt; t += 2) {
            const bool last = (t == nt - 2);
            const char* a1 = cA + (size_t)(t + 1) * kstep;
            const char* a2 = last ? nA : cA + (size_t)(t + 2) * kstep; const char* b2 = last ? nB : cB + (size_t)(t + 2) * kstep;
            const char* a3 = a2 + kstep; const char* b3 = b2 + kstep;
            if (last && has_next) S.a_ready(nxt);
            if constexpr (SP2) {
            PG8_LDB(B0, 0, 0); PG8_LDB(B1, 0, 1); PG8_SCHED; PG8_LDA(At, 0, 0); PG8_STAGE(PG8_SA(1, 1), a1 + hstep, voffA);
            PG8_WAIT_V(8); PG8_WAIT_L(0); PG8_BAR; PG8_MMA(0, 0, At, B0); PG8_MMA(0, 1, At, B1); PG8_BAR; PG8_SCHED;
            PG8_LDA(At, 0, 1); PG8_STAGE(PG8_SB(0, 0), b2, voffB); PG8_STAGE(PG8_SB(0, 1), b2 + hstep, voffB); PG8_STAGE(PG8_SA(0, 0), a2, voffA);
            PG8_WAIT_V(8); PG8_WAIT_L(0); PG8_BAR; PG8_MMA(1, 0, At, B0); PG8_MMA(1, 1, At, B1); PG8_BAR; PG8_SCHED;
            PG8_LDB(B0, 1, 0); PG8_LDB(B1, 1, 1); PG8_SCHED; PG8_LDA(At, 1, 0); PG8_STAGE(PG8_SA(0, 1), a2 + hstep, voffA);
            PG8_WAIT_V(8); PG8_WAIT_L(0); PG8_BAR; PG8_MMA(0, 0, At, B0); PG8_MMA(0, 1, At, B1); PG8_BAR; PG8_SCHED;
            PG8_LDA(At, 1, 1); PG8_STAGE(PG8_SB(1, 0), b3, voffB); PG8_STAGE(PG8_SB(1, 1), b3 + hstep, voffB); PG8_STAGE(PG8_SA(1, 0), a3, voffA);
            PG8_WAIT_V(8); PG8_WAIT_L(0); PG8_BAR; PG8_MMA(1, 0, At, B0); PG8_MMA(1, 1, At, B1); PG8_BAR; PG8_SCHED;
            } else {
            PG8_LDB(B0, 0, 0); PG8_SCHED; PG8_LDA(At, 0, 0); PG8_STAGE(PG8_SA(1, 1), a1 + hstep, voffA);
            PG8_WAIT_L(8); PG8_BAR; PG8_WAIT_L(0); PG8_MMA(0, 0, At, B0); PG8_BAR; PG8_SCHED;
            PG8_LDB(B1, 0, 1); PG8_STAGE(PG8_SB(0, 0), b2, voffB);
            PG8_BAR; PG8_WAIT_L(0); PG8_MMA(0, 1, At, B1); PG8_BAR;
            PG8_LDA(At, 0, 1); PG8_STAGE(PG8_SA(0, 0), a2, voffA);
            PG8_BAR; PG8_WAIT_L(0); PG8_MMA(1, 0, At, B0); PG8_BAR; PG8_SCHED;
            PG8_STAGE(PG8_SB(0, 1), b2 + hstep, voffB);
            PG8_WAIT_V(6); PG8_BAR; PG8_MMA(1, 1, At, B1); PG8_BAR;
            PG8_LDB(B0, 1, 0); PG8_SCHED; PG8_LDA(At, 1, 0); PG8_STAGE(PG8_SA(0, 1), a2 + hstep, voffA);
            PG8_WAIT_L(8); PG8_BAR; PG8_WAIT_L(0); PG8_MMA(0, 0, At, B0); PG8_BAR; PG8_SCHED;
            PG8_LDB(B1, 1, 1); PG8_STAGE(PG8_SB(1, 0), b3, voffB);
            PG8_BAR; PG8_WAIT_L(0); PG8_MMA(0, 1, At, B1); PG8_BAR;
            PG8_LDA(At, 1, 1); PG8_STAGE(PG8_SA(1, 0), a3, voffA);
            PG8_BAR; PG8_WAIT_L(0); PG8_MMA(1, 0, At, B0); PG8_BAR; PG8_SCHED;
            PG8_STAGE(PG8_SB(1, 1), b3 + hstep, voffB);
            PG8_WAIT_V(6); PG8_BAR; PG8_MMA(1, 1, At, B1); PG8_BAR;
            }
        }
        if constexpr (ALIGN_EPI) { if (wr == 0) PG8_BAR; }
        if constexpr (!Epi::AFTER_DRAIN) { E(acc, cur, wr, wc, fr, fq); S.done(cur); }
        if (!has_next) break;
#pragma unroll
        for (int a = 0; a < 2; ++a)
#pragma unroll
            for (int b = 0; b < 2; ++b)
#pragma unroll
                for (int m = 0; m < 4; ++m)
#pragma unroll
                    for (int n = 0; n < 2; ++n) acc[a][b][m][n] = (f32x4){0.f, 0.f, 0.f, 0.f};
        cur = nxt; cA = nA; cB = nB; ++ui;
        if constexpr (ALIGN_EPI) { if (wr == 1) PG8_BAR; }
    }
    PG8_WAIT_V(0);
    if constexpr (!ALIGN_EPI) { if (wr == 0) PG8_BAR; }
    PG8_BAR;
    if constexpr (Epi::AFTER_DRAIN) { E.fused(acc, cur, wr, wc, fr, fq, lds, wid, lane); S.done(cur); }
#undef PG8_SA
#undef PG8_SB
#undef PG8_STAGE
#undef PG8_LDA
#undef PG8_LDB
#undef PG8_MMA
#undef PG8_WAIT_V
#undef PG8_WAIT_L
#undef PG8_BAR
#undef PG8_SCHED
}
}

__device__ __forceinline__ uint4 pack8(const float (&v)[8]) { uint4 w; w.x = pk2(v[0], v[1]); w.y = pk2(v[2], v[3]); w.z = pk2(v[4], v[5]); w.w = pk2(v[6], v[7]); return w; }
struct EpiIn {
    static constexpr bool PERM = true, AFTER_DRAIN = false;
    bf16* PROJ; float* HA; const float* lbp;
    template <int GRP> __device__ __forceinline__ void run(const pg8::f32x4 (&acc)[2][2][4][2], int row0, int col0, float sc) const {
#pragma unroll
        for (int bj = 0; bj < 2; ++bj) {
            float lb[8];
            if (GRP == 1) {
#pragma unroll
                for (int i = 0; i < 8; ++i) { const int j = col0 - C_HF + bj * 128 + i; lb[i] = 1.0f / (1.0f + __expf(lbp[512 + j] - lbp[j])); }
            }
#pragma unroll
            for (int ai = 0; ai < 2; ++ai)
#pragma unroll
                for (int m = 0; m < 4; ++m) { const size_t row = (size_t)(row0 + ai * 128 + m * 16);
                    float v[8];
#pragma unroll
                    for (int i = 0; i < 4; ++i) { v[i] = acc[ai][bj][m][0][i]; v[4 + i] = acc[ai][bj][m][1][i]; }
                    if (GRP == 0) {
#pragma unroll
                        for (int i = 0; i < 8; ++i) v[i] *= sc;
                    } else if (GRP == 1) {
                        float a[8];
#pragma unroll
                        for (int i = 0; i < 8; ++i) { const float ex = __expf(-fminf(fmaxf(v[i], -30.f), 30.f)); const float sig = 1.0f / (1.0f + ex), omsig = ex * sig;
                            const float f = lb[i] + (1.0f - lb[i]) * sig; a[i] = __log2f(f); v[i] = (1.0f - lb[i]) * omsig; }
                        float4* hp = (float4*)(HA + row * 512 + (col0 - C_HF) + bj * 128);
                        hp[0] = make_float4(a[0], a[1], a[2], a[3]); hp[1] = make_float4(a[4], a[5], a[6], a[7]);
                    } else if (GRP == 3) {
#pragma unroll
                        for (int i = 0; i < 8; ++i) v[i] = v[i] * __builtin_amdgcn_rcpf(1.0f + __expf(-v[i]));
                    }
                    *(uint4*)(PROJ + row * DIN + col0 + bj * 128) = pack8(v);
                    asm volatile("" ::: "memory");
                }
        }
    }
    __device__ __forceinline__ void operator()(const pg8::f32x4 (&acc)[2][2][4][2], const pg8::Unit& u, int wr, int wc, int fr, int fq) const {
        const int row0 = u.pm * 256 + wr * 64 + fr, col0 = u.pn * 256 + wc * 32 + 8 * fq, grp = u.pn >> 1;
        const float sc = (grp == 0) ? 0.08838834764831845f : ((grp == 4) ? 0.18033688011112042f : 1.0f);
        if (grp == 1) run<1>(acc, row0, col0, sc); else if (grp == 3) run<3>(acc, row0, col0, sc); else run<0>(acc, row0, col0, sc);
    }
};
struct EpiOut {
    static constexpr bool PERM = true, AFTER_DRAIN = false;
    const float* x; bf16* HB; float* PSQ;
    __device__ __forceinline__ void operator()(const pg8::f32x4 (&acc)[2][2][4][2], const pg8::Unit& u, int wr, int wc, int fr, int fq) const {
        const int row0 = u.pm * 256 + wr * 64 + fr, col0 = u.pn * 256 + wc * 32 + 8 * fq;
#pragma unroll
        for (int ai = 0; ai < 2; ++ai) {
            float4 xv[4][2][2];
#pragma unroll
            for (int m = 0; m < 4; ++m)
#pragma unroll
                for (int bj = 0; bj < 2; ++bj) { const size_t off = (size_t)(row0 + ai * 128 + m * 16) * D + col0 + bj * 128;
                    xv[m][bj][0] = *(const float4*)(x + off); xv[m][bj][1] = *(const float4*)(x + off + 4); }
#pragma unroll
            for (int m = 0; m < 4; ++m) { const size_t row = (size_t)(row0 + ai * 128 + m * 16); float ss = 0.f;
#pragma unroll
                for (int bj = 0; bj < 2; ++bj) { const size_t off = row * D + col0 + bj * 128;
                    const float4 x0 = xv[m][bj][0], x1 = xv[m][bj][1];
                    float h[8] = {x0.x + acc[ai][bj][m][0][0], x0.y + acc[ai][bj][m][0][1], x0.z + acc[ai][bj][m][0][2], x0.w + acc[ai][bj][m][0][3],
                                  x1.x + acc[ai][bj][m][1][0], x1.y + acc[ai][bj][m][1][1], x1.z + acc[ai][bj][m][1][2], x1.w + acc[ai][bj][m][1][3]};
                    *(uint4*)(HB + off) = pack8(h);
#pragma unroll
                    for (int i = 0; i < 8; ++i) ss += h[i] * h[i]; }
                ss += __shfl_xor(ss, 16); ss += __shfl_xor(ss, 32);
                if (fq == 0) PSQ[row * 16 + u.pn * 4 + wc] = ss; }
            asm volatile("" ::: "memory");
        }
    }
};
struct EpiQ {
    static constexpr bool PERM = true, AFTER_DRAIN = false;
    bf16* QH;
    __device__ __forceinline__ void operator()(const pg8::f32x4 (&acc)[2][2][4][2], const pg8::Unit& u, int wr, int wc, int fr, int fq) const {
        const int row0 = u.pm * 256 + wr * 64 + fr, col0 = u.pn * 256 + wc * 32 + 8 * fq;
#pragma unroll
        for (int ai = 0; ai < 2; ++ai)
#pragma unroll
            for (int m = 0; m < 4; ++m) { const size_t row = (size_t)(row0 + ai * 128 + m * 16);
#pragma unroll
                for (int bj = 0; bj < 2; ++bj) { float v[8];
#pragma unroll
                    for (int i = 0; i < 4; ++i) { v[i] = acc[ai][bj][m][0][i]; v[4 + i] = acc[ai][bj][m][1][i]; }
                    *(uint4*)(QH + row * 2048 + col0 + bj * 128) = pack8(v); } }
    }
};

__device__ __forceinline__ float compute_lambda(const float* dl, int lane) {
    const float sa = wave_sum(dl[lane] * dl[64 + lane]), sb = wave_sum(dl[128 + lane] * dl[192 + lane]);
    return __expf(sa) - __expf(sb) + 0.2f;
}
namespace hg {
typedef short bf16x8 __attribute__((ext_vector_type(8)));
typedef short s16x4 __attribute__((ext_vector_type(4)));
typedef float f32x4 __attribute__((ext_vector_type(4)));
typedef unsigned u32x4 __attribute__((ext_vector_type(4)));
typedef unsigned u32x2 __attribute__((ext_vector_type(2)));
typedef float f32x2 __attribute__((ext_vector_type(2)));
constexpr int QT = 0, KT = 16384, VT = 32768, AT = 49152, PT = 81920, OT = 90112, SEG = 122880, DEC = 126976;
__device__ __forceinline__ int swzA(int row) { return row & 15; }
__device__ __forceinline__ int swzB(int row) { return ((row & 3) << 1) | (((row >> 3) & 1) << 3); }
__device__ __forceinline__ int swzP(int row) { return (((row >> 1) & 1) << 1) | (((row >> 3) & 1) << 2); }
__device__ __forceinline__ s16x4 vtr(const LAS unsigned char* p) { return __builtin_bit_cast(s16x4, __builtin_amdgcn_ds_read_tr16_b64_v4i16((LAS s16x4*)p)); }
__device__ __forceinline__ bf16x8 cat(s16x4 a, s16x4 b) { return (bf16x8){a[0], a[1], a[2], a[3], b[0], b[1], b[2], b[3]}; }
__device__ __forceinline__ unsigned cvtpk(float lo, float hi) { typedef float f2 __attribute__((ext_vector_type(2))); typedef __bf16 b2 __attribute__((ext_vector_type(2))); f2 v = {lo, hi}; b2 b = __builtin_convertvector(v, b2); return __builtin_bit_cast(unsigned, b); }

__device__ __forceinline__ void hgrn_pre(Frame& F, int task) {
    LAS unsigned char* lds = (LAS unsigned char*)F.lds;
    const int tid = F.tid, lane = F.lane, w = F.wave, c16 = lane & 15, g = lane >> 4, q4 = c16 >> 2, p4 = c16 & 3;
    const int c = task & 63, h = (task >> 6) & 3, b = task >> 8;
    const size_t row0 = (size_t)b * SEQ + (size_t)c * 64;
    const int srow = tid >> 4, sch = tid & 15;
#pragma unroll
    for (int i = 0; i < 2; ++i) { const int row = srow + 32 * i; const bf16* rp = F.PROJ + (row0 + row) * DIN + h * 128 + sch * 8;
        *(LAS u32x4*)(lds + QT + row * 256 + ((sch ^ swzA(row)) << 4)) = *(const u32x4*)(rp + C_HQ);
        *(LAS u32x4*)(lds + KT + row * 256 + ((sch ^ swzB(row)) << 4)) = *(const u32x4*)(rp + C_HF);
        *(LAS u32x4*)(lds + VT + row * 256 + ((sch ^ swzB(row)) << 4)) = *(const u32x4*)(rp + C_HI); }
#pragma unroll
    for (int i = 0; i < 4; ++i) { const int p = tid + 512 * i; *(LAS u32x4*)(lds + AT + (p >> 5) * 512 + (p & 31) * 16) = *(const u32x4*)(F.HA + (row0 + (p >> 5)) * 512 + h * 128 + (p & 31) * 4); }
    __syncthreads();
    {
        const int dp = tid & 63, ts = tid >> 6, d = 2 * dp;
        const LAS float* at = (const LAS float*)(lds + AT);
        LAS float* seg = (LAS float*)(lds + SEG);
        float cs0[8], cs1[8]; float r0 = 0.f, r1 = 0.f;
#pragma unroll
        for (int tt = 0; tt < 8; ++tt) { const f32x2 a = *(const LAS f32x2*)(at + (8 * ts + tt) * 128 + d); r0 += a.x; r1 += a.y; cs0[tt] = r0; cs1[tt] = r1; }
        *(LAS f32x2*)(seg + ts * 128 + d) = (f32x2){r0, r1};
        __syncthreads();
        float off0 = 0.f, off1 = 0.f, bl0 = 0.f, bl1 = 0.f;
#pragma unroll
        for (int k = 0; k < 8; ++k) { const f32x2 s = *(const LAS f32x2*)(seg + k * 128 + d); if (k < ts) { off0 += s.x; off1 += s.y; } bl0 += s.x; bl1 += s.y; }
        if (ts == 0) *(f32x2*)(F.DECG + ((size_t)(b * 64 + c) * 4 + h) * 128 + d) = (f32x2){__builtin_amdgcn_exp2f(fmaxf(bl0, -120.f)), __builtin_amdgcn_exp2f(fmaxf(bl1, -120.f))};
#pragma unroll
        for (int tt = 0; tt < 8; ++tt) { const int t = 8 * ts + tt;
            const float x0 = (off0 + cs0[tt]) - bl0, x1 = (off1 + cs1[tt]) - bl1;
            const float eq0 = __builtin_amdgcn_exp2f(fminf(x0, 120.f)), eq1 = __builtin_amdgcn_exp2f(fminf(x1, 120.f));
            const float ek0 = __builtin_amdgcn_exp2f(fmaxf(-x0, -120.f)), ek1 = __builtin_amdgcn_exp2f(fmaxf(-x1, -120.f));
            LAS unsigned* pq = (LAS unsigned*)(lds + QT + t * 256 + (((d >> 3) ^ swzA(t)) << 4) + (d & 7) * 2);
            LAS unsigned* pk = (LAS unsigned*)(lds + KT + t * 256 + (((d >> 3) ^ swzB(t)) << 4) + (d & 7) * 2);
            const unsigned qv = *pq, kv = *pk;
            *pq = cvtpk(bflo(qv) * eq0, bfhi(qv) * eq1); *pk = cvtpk(bflo(kv) * ek0, bfhi(kv) * ek1); }
    }
    __syncthreads();
#pragma unroll
    for (int i = 0; i < 2; ++i) { const int row = srow + 32 * i; bf16* rp = F.PROJ + (row0 + row) * DIN + h * 128 + sch * 8;
        *(u32x4*)(rp + C_HQ) = *(const LAS u32x4*)(lds + QT + row * 256 + ((sch ^ swzA(row)) << 4));
        *(u32x4*)(rp + C_HF) = *(const LAS u32x4*)(lds + KT + row * 256 + ((sch ^ swzB(row)) << 4)); }
#pragma unroll
    for (int rep = 0; rep < 2; ++rep) {
        const int idx = w + 8 * rep;
        if (idx < 12) {
            int tb, sb; bool zero = false;
            if (idx == 10) { tb = 0; sb = 1; zero = true; } else if (idx == 11) { tb = 2; sb = 3; zero = true; }
            else { tb = (idx >= 6) ? 3 : (idx >= 3) ? 2 : (idx >= 1) ? 1 : 0; sb = idx - (tb * (tb + 1)) / 2; }
            f32x4 acc = (f32x4){0.f, 0.f, 0.f, 0.f};
            if (!zero) {
                const int tr = 16 * tb + c16, sr = 16 * sb + c16;
#pragma unroll
                for (int ks = 0; ks < 4; ++ks) {
                    const bf16x8 a = *(const LAS bf16x8*)(lds + QT + tr * 256 + (((4 * ks + g) ^ swzA(tr)) << 4));
                    const bf16x8 bb = *(const LAS bf16x8*)(lds + KT + sr * 256 + (((4 * ks + g) ^ swzB(sr)) << 4));
                    acc = __builtin_amdgcn_mfma_f32_16x16x32_bf16(a, bb, acc, 0, 0, 0);
                }
                if (tb == sb) {
#pragma unroll
                    for (int r = 0; r < 4; ++r) if (c16 > 4 * g + r) acc[r] = 0.f;
                }
            }
            const int s = 16 * sb + c16;
            u32x2 pk; pk.x = cvtpk(acc[0], acc[1]); pk.y = cvtpk(acc[2], acc[3]);
            *(LAS u32x2*)(lds + PT + s * 128 + (((2 * tb + (g >> 1)) ^ swzP(s)) << 4) + (g & 1) * 8) = pk;
        }
    }
    __syncthreads();
    bf16x8 Vf[2];
#pragma unroll
    for (int ks2 = 0; ks2 < 2; ++ks2) {
        const int r0 = 32 * ks2 + 8 * g + q4, r1 = r0 + 4;
        Vf[ks2] = cat(vtr(lds + VT + r0 * 256 + (((2 * w + (p4 >> 1)) ^ swzB(r0)) << 4) + (p4 & 1) * 8), vtr(lds + VT + r1 * 256 + (((2 * w + (p4 >> 1)) ^ swzB(r1)) << 4) + (p4 & 1) * 8));
    }
    LAS float* ot = (LAS float*)(lds + OT);
#pragma unroll
    for (int tb = 0; tb < 4; ++tb) {
        f32x4 O = (f32x4){0.f, 0.f, 0.f, 0.f};
#pragma unroll
        for (int ks2 = 0; ks2 < 2; ++ks2) {
            if (ks2 <= (tb >> 1)) {
                const int r0 = 32 * ks2 + 8 * g + q4, r1 = r0 + 4;
                const s16x4 lo = vtr(lds + PT + r0 * 128 + (((2 * tb + (p4 >> 1)) ^ swzP(r0)) << 4) + (p4 & 1) * 8);
                const s16x4 hh = vtr(lds + PT + r1 * 128 + (((2 * tb + (p4 >> 1)) ^ swzP(r1)) << 4) + (p4 & 1) * 8);
                O = __builtin_amdgcn_mfma_f32_16x16x32_bf16(cat(lo, hh), Vf[ks2], O, 0, 0, 0);
            }
        }
#pragma unroll
        for (int r = 0; r < 4; ++r) ot[(16 * tb + 4 * g + r) * 128 + 16 * w + c16] = O[r];
    }
    __syncthreads();
#pragma unroll
    for (int i = 0; i < 4; ++i) { const int p = tid + 512 * i; *(u32x4*)(F.HO + (row0 + (p >> 5)) * 512 + h * 128 + (p & 31) * 4) = *(const LAS u32x4*)(lds + OT + (p >> 5) * 512 + (p & 31) * 16); }
    __syncthreads();
}

__device__ __forceinline__ void hgrn_scan(Frame& F, int b, int h) {
    LAS unsigned char* lds = (LAS unsigned char*)F.lds;
    const int tid = F.tid, lane = F.lane, w = F.wave;
    const size_t row0 = (size_t)b * SEQ;
    f32x4 S[8];
#pragma unroll
    for (int i = 0; i < 8; ++i) S[i] = (f32x4){0.f, 0.f, 0.f, 0.f};
    u32x4 sq[2], sk[2], sv[2], so[4], sgn[2]; float sdec = 0.f;
    const int srow = tid >> 4, sch = tid & 15;
    float hw[8];
    { const float4 a = *(const float4*)(F.hnw + sch * 8), bq = *(const float4*)(F.hnw + sch * 8 + 4); hw[0] = a.x; hw[1] = a.y; hw[2] = a.z; hw[3] = a.w; hw[4] = bq.x; hw[5] = bq.y; hw[6] = bq.z; hw[7] = bq.w; }
#define HG_LOAD(c) do { _Pragma("unroll") for (int i = 0; i < 2; ++i) { const bf16* rp = F.PROJ + (row0 + (size_t)(c) * 64 + srow + 32 * i) * DIN + h * 128 + sch * 8; \
        sq[i] = *(const u32x4*)(rp + C_HQ); sk[i] = *(const u32x4*)(rp + C_HF); sv[i] = *(const u32x4*)(rp + C_HI); sgn[i] = *(const u32x4*)(rp + C_HG); } \
    _Pragma("unroll") for (int i = 0; i < 4; ++i) { const int p = tid + 512 * i; so[i] = *(const u32x4*)(F.HO + (row0 + (size_t)(c) * 64 + (p >> 5)) * 512 + h * 128 + (p & 31) * 4); } \
    if (tid < 128) sdec = F.DECG[((size_t)(b * 64 + (c)) * 4 + h) * 128 + tid]; } while (0)
    HG_LOAD(0);
    for (int c = 0; c < SEQ / 64; ++c) {
        int lz = lane; asm volatile("" : "+v"(lz));
        const int c16 = lz & 15, g = lz >> 4, q4 = c16 >> 2, p4 = c16 & 3;
        u32x4 sgt[2]; sgt[0] = sgn[0]; sgt[1] = sgn[1];
#pragma unroll
        for (int i = 0; i < 2; ++i) { const int row = srow + 32 * i;
            *(LAS u32x4*)(lds + QT + row * 256 + ((sch ^ swzA(row)) << 4)) = sq[i];
            *(LAS u32x4*)(lds + KT + row * 256 + ((sch ^ swzB(row)) << 4)) = sk[i];
            *(LAS u32x4*)(lds + VT + row * 256 + ((sch ^ swzB(row)) << 4)) = sv[i]; }
#pragma unroll
        for (int i = 0; i < 4; ++i) { const int p = tid + 512 * i; *(LAS u32x4*)(lds + OT + (p >> 5) * 512 + (p & 31) * 16) = so[i]; }
        if (tid < 128) ((LAS float*)(lds + DEC))[tid] = sdec;
        __syncthreads();
        if (c + 1 < SEQ / 64) HG_LOAD(c + 1);
        bf16x8 Bf[4];
        {
            const LAS float* dec = (const LAS float*)(lds + DEC);
#pragma unroll
            for (int db = 0; db < 8; ++db) { const f32x4 dv = *(const LAS f32x4*)(dec + 16 * db + 4 * g); S[db] = S[db] * dv; }
#pragma unroll
            for (int ks = 0; ks < 4; ++ks) { u32x4 t; t.x = cvtpk(S[2 * ks][0], S[2 * ks][1]); t.y = cvtpk(S[2 * ks][2], S[2 * ks][3]); t.z = cvtpk(S[2 * ks + 1][0], S[2 * ks + 1][1]); t.w = cvtpk(S[2 * ks + 1][2], S[2 * ks + 1][3]);
                Bf[ks] = __builtin_bit_cast(bf16x8, t); }
        }
        LAS float* ot = (LAS float*)(lds + OT);
#pragma unroll
        for (int tb = 0; tb < 4; ++tb) {
            f32x4 O;
#pragma unroll
            for (int r = 0; r < 4; ++r) O[r] = ot[(16 * tb + 4 * g + r) * 128 + 16 * w + c16];
            const int tr = 16 * tb + c16;
#pragma unroll
            for (int ks = 0; ks < 4; ++ks) {
                const s16x4 lo = *(const LAS s16x4*)(lds + QT + tr * 256 + (((4 * ks + (g >> 1)) ^ swzA(tr)) << 4) + (g & 1) * 8);
                const s16x4 hh = *(const LAS s16x4*)(lds + QT + tr * 256 + (((4 * ks + 2 + (g >> 1)) ^ swzA(tr)) << 4) + (g & 1) * 8);
                O = __builtin_amdgcn_mfma_f32_16x16x32_bf16(cat(lo, hh), Bf[ks], O, 0, 0, 0);
            }
#pragma unroll
            for (int r = 0; r < 4; ++r) ot[(16 * tb + 4 * g + r) * 128 + 16 * w + c16] = O[r];
        }
        bf16x8 Vf[2];
#pragma unroll
        for (int ks2 = 0; ks2 < 2; ++ks2) {
            const int r0 = 32 * ks2 + 8 * g + q4, r1 = r0 + 4;
            Vf[ks2] = cat(vtr(lds + VT + r0 * 256 + (((2 * w + (p4 >> 1)) ^ swzB(r0)) << 4) + (p4 & 1) * 8), vtr(lds + VT + r1 * 256 + (((2 * w + (p4 >> 1)) ^ swzB(r1)) << 4) + (p4 & 1) * 8));
        }
#pragma unroll
        for (int db = 0; db < 8; ++db)
#pragma unroll
            for (int ks2 = 0; ks2 < 2; ++ks2) {
                const int r0 = 32 * ks2 + 8 * g + q4, r1 = r0 + 4;
                const s16x4 lo = vtr(lds + KT + r0 * 256 + (((2 * db + (p4 >> 1)) ^ swzB(r0)) << 4) + (p4 & 1) * 8);
                const s16x4 hh = vtr(lds + KT + r1 * 256 + (((2 * db + (p4 >> 1)) ^ swzB(r1)) << 4) + (p4 & 1) * 8);
                S[db] = __builtin_amdgcn_mfma_f32_16x16x32_bf16(cat(lo, hh), Vf[ks2], S[db], 0, 0, 0);
            }
        __syncthreads();
#pragma unroll
        for (int i = 0; i < 2; ++i) { const int t = srow + 32 * i; const size_t row = row0 + (size_t)c * 64 + t;
            const f32x4 xa = *(const LAS f32x4*)(ot + t * 128 + sch * 8), xb = *(const LAS f32x4*)(ot + t * 128 + sch * 8 + 4);
            float ss = (xa[0] * xa[0] + xa[1] * xa[1]) + (xa[2] * xa[2] + xa[3] * xa[3]) + (xb[0] * xb[0] + xb[1] * xb[1]) + (xb[2] * xb[2] + xb[3] * xb[3]);
            ss += __builtin_bit_cast(float, __builtin_amdgcn_update_dpp(0, __builtin_bit_cast(int, ss), 0xB1, 0xF, 0xF, false));
            ss += __builtin_bit_cast(float, __builtin_amdgcn_update_dpp(0, __builtin_bit_cast(int, ss), 0x4E, 0xF, 0xF, false));
            ss += __builtin_bit_cast(float, __builtin_amdgcn_update_dpp(0, __builtin_bit_cast(int, ss), 0x141, 0xF, 0xF, false));
            ss += __builtin_bit_cast(float, __builtin_amdgcn_update_dpp(0, __builtin_bit_cast(int, ss), 0x140, 0xF, 0xF, false));
            const float r = 1.0f / sqrtf(ss * (1.f / 128.f) + RMS_EPS);
            const u32x4 gt = sgt[i];
            u32x4 o;
            o.x = cvtpk(xa[0] * r * hw[0] * bflo(gt.x), xa[1] * r * hw[1] * bfhi(gt.x)); o.y = cvtpk(xa[2] * r * hw[2] * bflo(gt.y), xa[3] * r * hw[3] * bfhi(gt.y));
            o.z = cvtpk(xb[0] * r * hw[4] * bflo(gt.z), xb[1] * r * hw[5] * bfhi(gt.z)); o.w = cvtpk(xb[2] * r * hw[6] * bflo(gt.w), xb[3] * r * hw[7] * bfhi(gt.w));
            *(u32x4*)(F.MIX + row * D + h * 128 + sch * 8) = o; }
        __syncthreads();
    }
#undef HG_LOAD
}
}

namespace da {
typedef short bf16x8 __attribute__((ext_vector_type(8)));
typedef short s16x4 __attribute__((ext_vector_type(4)));
typedef float f32x16 __attribute__((ext_vector_type(16)));
constexpr int V_OFF = 16384, BUF_BYTES = 32768;
__device__ __forceinline__ s16x4 vtr(const LAS unsigned char* p) { return __builtin_bit_cast(s16x4, __builtin_amdgcn_ds_read_tr16_b64_v4i16((LAS s16x4*)p)); }
__device__ __forceinline__ unsigned cvtpk(float lo, float hi) { typedef float f2 __attribute__((ext_vector_type(2))); typedef __bf16 b2 __attribute__((ext_vector_type(2))); f2 v = {lo, hi}; b2 b = __builtin_convertvector(v, b2); return __builtin_bit_cast(unsigned, b); }

__device__ __forceinline__ float max3f(float a, float b, float c) { float r; asm("v_max3_f32 %0, %1, %2, %3" : "=v"(r) : "v"(a), "v"(b), "v"(c)); return r; }
__device__ __forceinline__ float exp2_pin(float x) { float y; asm volatile("v_exp_f32_e32 %0, %1" : "=v"(y) : "v"(x)); return y; }
__device__ __forceinline__ float max2f(float a, float b) { float r; asm("v_max_f32_e32 %0, %1, %2" : "=v"(r) : "v"(a), "v"(b)); return r; }
constexpr float RESC_THR = 8.0f;
__device__ __forceinline__ void attn_unit(Frame& F, int b, int h, int qblk, float lam) {
    LAS unsigned char* lds = (LAS unsigned char*)F.lds;
    const int lane = F.lane, r32 = lane & 31, hi = lane >> 5, w = F.wave, rg = w >> 1, map = w & 1;
    const int t0 = qblk * 128 + rg * 32;
    const int ntile_blk = 2 * qblk + 2, ntile_w = 2 * qblk + (rg >> 1) + 1;
    const bf16* base = F.PROJ + (size_t)b * SEQ * DIN;
    const bf16* gk = base + (size_t)(8 * w + (lane >> 3)) * DIN + C_AK + h * 128 + (((lane & 7) ^ ((4 * w + (lane >> 4)) & 7)) * 8);
    const bf16* gv = base + (size_t)(4 * w + (lane >> 4)) * DIN + C_AV + h * 128 + (((lane & 15) ^ ((lane >> 4) << 2)) * 8);
#define DA_DMA(tile, buf) do { const size_t to_ = (size_t)(tile) * 64 * DIN; LAS unsigned char* lb_ = lds + (buf) * BUF_BYTES + w * 1024; \
        __builtin_amdgcn_global_load_lds((const unsigned*)(gk + to_), (LAS unsigned*)(lb_), 16, 0, 0); \
        __builtin_amdgcn_global_load_lds((const unsigned*)(gk + to_ + 64), (LAS unsigned*)(lb_ + 8192), 16, 0, 0); \
        __builtin_amdgcn_global_load_lds((const unsigned*)(gv + to_), (LAS unsigned*)(lb_ + V_OFF), 16, 0, 0); \
        __builtin_amdgcn_global_load_lds((const unsigned*)(gv + to_ + (size_t)32 * DIN), (LAS unsigned*)(lb_ + V_OFF + 8192), 16, 0, 0); } while (0)
    DA_DMA(0, 0); DA_DMA(1, 1);
    if (ntile_blk > 2) DA_DMA(2, 2);
    bf16x8 qr[4];
#pragma unroll
    for (int d0 = 0; d0 < 4; ++d0) qr[d0] = *(const bf16x8*)(base + (size_t)(t0 + r32) * DIN + C_AQ + h * 128 + map * 64 + 16 * d0 + 8 * hi);
    asm volatile("s_waitcnt vmcnt(0)" : "+v"(qr[0]), "+v"(qr[1]), "+v"(qr[2]), "+v"(qr[3]) :: "memory");
    f32x16 o[4], negm;
#pragma unroll
    for (int eb = 0; eb < 4; ++eb)
#pragma unroll
        for (int r = 0; r < 16; ++r) o[eb][r] = 0.f;
#pragma unroll
    for (int r = 0; r < 16; ++r) negm[r] = 0.f;
    float mref = 0.f, l = 0.f;
    const int koff = map * 8192 + r32 * 128;
    const int q4 = (lane & 15) >> 2, p4 = lane & 3, eh = (lane >> 4) & 1;
    int voff[4];
#pragma unroll
    for (int eb = 0; eb < 4; ++eb) voff[eb] = V_OFF + (4 * hi + q4) * 256 + (p4 & 1) * 8 + (((((eb ^ q4) << 2) + 2 * eh + (p4 >> 1))) << 4);
#define DA_KFRAG(slot_, d0_, half_) (*(const LAS bf16x8*)(lds + (slot_) * BUF_BYTES + koff + (half_) * (32 * 128) + ((((2 * (d0_) + hi) ^ ((r32 >> 1) & 7))) << 4)))
#define DA_ROWMAX(c0_, c1_) ({ float a_ = fmaxf(fmaxf(c0_[0], c0_[1]), c1_[0]), b_ = fmaxf(fmaxf(c0_[2], c0_[3]), c1_[1]); a_ = fmaxf(fmaxf(a_, c1_[2]), c1_[3]); \
        _Pragma("unroll") for (int r = 4; r < 16; r += 4) { a_ = fmaxf(fmaxf(a_, c0_[r]), c0_[r + 1]); b_ = fmaxf(fmaxf(b_, c0_[r + 2]), c0_[r + 3]); a_ = fmaxf(fmaxf(a_, c1_[r]), c1_[r + 1]); b_ = fmaxf(fmaxf(b_, c1_[r + 2]), c1_[r + 3]); } \
        float m_ = fmaxf(a_, b_); auto rr_ = __builtin_amdgcn_permlane32_swap(__float_as_uint(m_), __float_as_uint(m_), false, false); fmaxf(__uint_as_float(rr_[0]), __uint_as_float(rr_[1])); })
    __builtin_amdgcn_s_barrier(); asm volatile("" ::: "memory");
    f32x16 pp0 = negm, pp1 = negm;
#pragma unroll
    for (int d0 = 0; d0 < 4; ++d0) { pp0 = __builtin_amdgcn_mfma_f32_32x32x16_bf16(DA_KFRAG(0, d0, 0), qr[d0], pp0, 0, 0, 0); pp1 = __builtin_amdgcn_mfma_f32_32x32x16_bf16(DA_KFRAG(0, d0, 1), qr[d0], pp1, 0, 0, 0); }
    { const float mx = DA_ROWMAX(pp0, pp1); mref = mx;
#pragma unroll
      for (int r = 0; r < 16; ++r) { negm[r] = -mref; pp0[r] = __builtin_amdgcn_exp2f(pp0[r] - mx); pp1[r] = __builtin_amdgcn_exp2f(pp1[r] - mx); } }
    asm volatile("s_waitcnt lgkmcnt(0)" ::: "memory");
    __builtin_amdgcn_s_barrier(); asm volatile("" ::: "memory");
    for (int t = 1; t <= ntile_blk; ++t) {
        if (t + 2 < ntile_blk) DA_DMA(t + 2, (t + 2) & 3);
        const int sc = t & 3, sp = (t - 1) & 3;
        if (t <= ntile_w) {
            const bool cur = t < ntile_w;
            f32x16 c0 = negm, c1 = negm;
            bf16x8 kf[8];
#pragma unroll
            for (int d0 = 0; d0 < 4; ++d0) { kf[2 * d0] = DA_KFRAG(sc, d0, 0); kf[2 * d0 + 1] = DA_KFRAG(sc, d0, 1); }
            unsigned pw[2][2][4]; float rs = 0.f;
#pragma unroll
            for (int r = 0; r < 16; ++r) rs += pp0[r] + pp1[r];
#pragma unroll
            for (int s = 0; s < 2; ++s)
#pragma unroll
                for (int j = 0; j < 4; ++j) { pw[0][s][j] = cvtpk(pp0[8 * s + 2 * j], pp0[8 * s + 2 * j + 1]); pw[1][s][j] = cvtpk(pp1[8 * s + 2 * j], pp1[8 * s + 2 * j + 1]); }
#pragma unroll
            for (int d0 = 0; d0 < 4; ++d0) { c0 = __builtin_amdgcn_mfma_f32_32x32x16_bf16(kf[2 * d0], qr[d0], c0, 0, 0, 0); c1 = __builtin_amdgcn_mfma_f32_32x32x16_bf16(kf[2 * d0 + 1], qr[d0], c1, 0, 0, 0); }
            __builtin_amdgcn_sched_group_barrier(0x100, 8, 0); __builtin_amdgcn_sched_group_barrier(0x2, 10, 0);
#pragma unroll
            for (int i = 0; i < 8; ++i) { __builtin_amdgcn_sched_group_barrier(0x8, 1, 0); __builtin_amdgcn_sched_group_barrier(0x2, 4, 0); }
            l += rs;
            bool resc = false; float f = 1.0f;
            if (cur) {
                const float mx = DA_ROWMAX(c0, c1);
                if (__any(mx > RESC_THR)) {
                    const float dl = fmaxf(mx, 0.f); f = __builtin_amdgcn_exp2f(-dl); mref += dl; l *= f; resc = true;
#pragma unroll
                    for (int r = 0; r < 16; ++r) { c0[r] -= dl; c1[r] -= dl; negm[r] = -mref; }
                }
            }
            {
                typedef unsigned u4 __attribute__((ext_vector_type(4)));
                const LAS unsigned char* vb_ = lds + sp * BUF_BYTES;
#define DA_VA(k_) (vb_ + voff[(k_) >> 2] + (16 * ((k_) & 3)) * 256)
                s16x4 lo_a = vtr(DA_VA(0)), hh_a = vtr(DA_VA(0) + 8 * 256), lo_b = vtr(DA_VA(1)), hh_b = vtr(DA_VA(1) + 8 * 256);
#pragma unroll
                for (int k = 0; k < 16; ++k) {
                    const s16x4 lo = lo_a, hh = hh_a;
                    lo_a = lo_b; hh_a = hh_b;
                    if (k < 14) { lo_b = vtr(DA_VA(k + 2)); hh_b = vtr(DA_VA(k + 2) + 8 * 256); }
                    const bf16x8 av = {lo[0], lo[1], lo[2], lo[3], hh[0], hh[1], hh[2], hh[3]};
                    const u4 pv = {pw[(k >> 1) & 1][k & 1][0], pw[(k >> 1) & 1][k & 1][1], pw[(k >> 1) & 1][k & 1][2], pw[(k >> 1) & 1][k & 1][3]};
                    o[k >> 2] = __builtin_amdgcn_mfma_f32_32x32x16_bf16(av, __builtin_bit_cast(bf16x8, pv), o[k >> 2], 0, 0, 0);
                    if (k < 8) { c0[2 * k] = exp2_pin(c0[2 * k]); c0[2 * k + 1] = exp2_pin(c0[2 * k + 1]); }
                    else { c1[2 * (k - 8)] = exp2_pin(c1[2 * (k - 8)]); c1[2 * (k - 8) + 1] = exp2_pin(c1[2 * (k - 8) + 1]); }
                }
#undef DA_VA
            }
            if (resc) {
#pragma unroll
                for (int eb = 0; eb < 4; ++eb)
#pragma unroll
                    for (int r = 0; r < 16; ++r) o[eb][r] *= f;
            }
            pp0 = c0; pp1 = c1;
        }
        if (t + 2 < ntile_blk) asm volatile("s_waitcnt vmcnt(4)" ::: "memory"); else asm volatile("s_waitcnt vmcnt(0)" ::: "memory");
        asm volatile("s_waitcnt lgkmcnt(0)" ::: "memory");
        __builtin_amdgcn_s_barrier(); asm volatile("" ::: "memory");
    }
#undef DA_KFRAG
#undef DA_ROWMAX
#undef DA_DMA
    l += __shfl_xor(l, 32);
    const float inv = 1.0f / l;
    LAS float* X = (LAS float*)lds + rg * 4096;
    if (map == 1) {
#pragma unroll
        for (int eb = 0; eb < 4; ++eb)
#pragma unroll
            for (int r = 0; r < 16; ++r) X[(eb * 16 + r) * 64 + lane] = o[eb][r] * inv;
    }
    __syncthreads();
    if (map == 0) {
        float ss = 0.f;
#pragma unroll
        for (int eb = 0; eb < 4; ++eb)
#pragma unroll
            for (int r = 0; r < 16; ++r) { const float d = o[eb][r] * inv - lam * X[(eb * 16 + r) * 64 + lane]; o[eb][r] = d; ss += d * d; }
        ss += __shfl_xor(ss, 32);
        const float rstd = 0.8f / sqrtf(ss * (1.f / 128.f) + RMS_EPS);
        bf16* orow = F.MIX + (size_t)(b * SEQ + t0 + r32) * D + 512 + h * 128;
#pragma unroll
        for (int eb = 0; eb < 4; ++eb)
#pragma unroll
            for (int r4 = 0; r4 < 4; ++r4) { const int e0 = 32 * eb + 8 * r4 + 4 * hi; const float4 wv = *(const float4*)(F.dnw + e0);
                uint2 pk; pk.x = pk2(o[eb][4 * r4 + 0] * rstd * wv.x, o[eb][4 * r4 + 1] * rstd * wv.y); pk.y = pk2(o[eb][4 * r4 + 2] * rstd * wv.z, o[eb][4 * r4 + 3] * rstd * wv.w);
                *(uint2*)(orow + e0) = pk; }
    }
    __syncthreads();
}
__device__ __forceinline__ void attn_phase(Frame& F, unsigned* ctl, volatile LAS unsigned* MISC, int cbase = 1024) {
    const float lam = compute_lambda(F.dlam, F.lane);
    const int x = F.bid & 7;
    if (F.tid == 0) MISC[16] = atomicAdd(&ctl[cbase + 64 * x], 1u);
    __syncthreads();
    for (;;) {
        const unsigned u = MISC[16];
        __syncthreads();
        if (u >= 128u) break;
        unsigned nxt = 0u;
        if (F.tid == 0) nxt = atomicAdd(&ctl[cbase + 64 * x], 1u);
        attn_unit(F, (4 * x + (int)(u & 3)) >> 2, (int)(u & 3), 31 - (int)(u >> 2), lam);
        if (F.tid == 0) MISC[16] = nxt;
        __syncthreads();
    }
}
}

__device__ __forceinline__ float row_rstd(const float* PSQ, int t) {
    const float4* p = (const float4*)(PSQ + (size_t)t * 16);
    const float4 a = p[0], b = p[1], c = p[2], d = p[3];
    const float s = ((a.x + a.y) + (a.z + a.w)) + ((b.x + b.y) + (b.z + b.w)) + ((c.x + c.y) + (c.z + c.w)) + ((d.x + d.y) + (d.z + d.w));
    return 1.0f / sqrtf(s * (1.f / D) + RMS_EPS);
}

__device__ __forceinline__ float gelu_tanh(float z) {
    const float y = 0.7978845608028654f * (z + 0.044715f * z * z * z);
    const float th = 1.0f - 2.0f / (1.0f + __expf(2.0f * y));
    return 0.5f * z * (1.0f + th);
}
__device__ __forceinline__ void unpack8(const uint4 v, float (&f)[8]) {
    f[0] = bflo(v.x); f[1] = bfhi(v.x); f[2] = bflo(v.y); f[3] = bfhi(v.y); f[4] = bflo(v.z); f[5] = bfhi(v.z); f[6] = bflo(v.w); f[7] = bfhi(v.w);
}
namespace tk {
typedef short bf16x8 __attribute__((ext_vector_type(8)));
typedef float f32x16 __attribute__((ext_vector_type(16)));
typedef unsigned u32x4 __attribute__((ext_vector_type(4)));
constexpr int NC = 50;
constexpr int CI[NC] = {0, 0, 0, 0, 0, 0, 0, 0, 0, 0, 0, 0, 0, 0, 0, 0, 1, 1, 1, 1, 1, 1, 1, 1, 2, 2, 2, 2, 2, 3, 3, 3, 3, 4, 4, 4, 5, 5, 6, 6, 7, 7, 8, 9, 10, 11, 12, 13, 14, 15};
constexpr int CJ[NC] = {0, 1, 2, 3, 4, 5, 6, 7, 8, 9, 10, 11, 12, 13, 14, 15, 0, 1, 2, 3, 4, 5, 6, 7, 0, 1, 2, 3, 4, 0, 1, 2, 3, 0, 1, 2, 0, 1, 0, 1, 0, 1, 0, 0, 0, 0, 0, 0, 0, 0};
constexpr int SLOT_OFF = 65536;
#define TK_SORT16(A) do { int h_, l_; \
    h_ = max(A[0], A[1]); l_ = min(A[0], A[1]); A[0] = h_; A[1] = l_; \
    h_ = max(A[3], A[2]); l_ = min(A[3], A[2]); A[3] = h_; A[2] = l_; \
    h_ = max(A[4], A[5]); l_ = min(A[4], A[5]); A[4] = h_; A[5] = l_; \
    h_ = max(A[7], A[6]); l_ = min(A[7], A[6]); A[7] = h_; A[6] = l_; \
    h_ = max(A[8], A[9]); l_ = min(A[8], A[9]); A[8] = h_; A[9] = l_; \
    h_ = max(A[11], A[10]); l_ = min(A[11], A[10]); A[11] = h_; A[10] = l_; \
    h_ = max(A[12], A[13]); l_ = min(A[12], A[13]); A[12] = h_; A[13] = l_; \
    h_ = max(A[15], A[14]); l_ = min(A[15], A[14]); A[15] = h_; A[14] = l_; \
    h_ = max(A[0], A[2]); l_ = min(A[0], A[2]); A[0] = h_; A[2] = l_; \
    h_ = max(A[1], A[3]); l_ = min(A[1], A[3]); A[1] = h_; A[3] = l_; \
    h_ = max(A[6], A[4]); l_ = min(A[6], A[4]); A[6] = h_; A[4] = l_; \
    h_ = max(A[7], A[5]); l_ = min(A[7], A[5]); A[7] = h_; A[5] = l_; \
    h_ = max(A[8], A[10]); l_ = min(A[8], A[10]); A[8] = h_; A[10] = l_; \
    h_ = max(A[9], A[11]); l_ = min(A[9], A[11]); A[9] = h_; A[11] = l_; \
    h_ = max(A[14], A[12]); l_ = min(A[14], A[12]); A[14] = h_; A[12] = l_; \
    h_ = max(A[15], A[13]); l_ = min(A[15], A[13]); A[15] = h_; A[13] = l_; \
    h_ = max(A[0], A[1]); l_ = min(A[0], A[1]); A[0] = h_; A[1] = l_; \
    h_ = max(A[2], A[3]); l_ = min(A[2], A[3]); A[2] = h_; A[3] = l_; \
    h_ = max(A[5], A[4]); l_ = min(A[5], A[4]); A[5] = h_; A[4] = l_; \
    h_ = max(A[7], A[6]); l_ = min(A[7], A[6]); A[7] = h_; A[6] = l_; \
    h_ = max(A[8], A[9]); l_ = min(A[8], A[9]); A[8] = h_; A[9] = l_; \
    h_ = max(A[10], A[11]); l_ = min(A[10], A[11]); A[10] = h_; A[11] = l_; \
    h_ = max(A[13], A[12]); l_ = min(A[13], A[12]); A[13] = h_; A[12] = l_; \
    h_ = max(A[15], A[14]); l_ = min(A[15], A[14]); A[15] = h_; A[14] = l_; \
    h_ = max(A[0], A[4]); l_ = min(A[0], A[4]); A[0] = h_; A[4] = l_; \
    h_ = max(A[1], A[5]); l_ = min(A[1], A[5]); A[1] = h_; A[5] = l_; \
    h_ = max(A[2], A[6]); l_ = min(A[2], A[6]); A[2] = h_; A[6] = l_; \
    h_ = max(A[3], A[7]); l_ = min(A[3], A[7]); A[3] = h_; A[7] = l_; \
    h_ = max(A[12], A[8]); l_ = min(A[12], A[8]); A[12] = h_; A[8] = l_; \
    h_ = max(A[13], A[9]); l_ = min(A[13], A[9]); A[13] = h_; A[9] = l_; \
    h_ = max(A[14], A[10]); l_ = min(A[14], A[10]); A[14] = h_; A[10] = l_; \
    h_ = max(A[15], A[11]); l_ = min(A[15], A[11]); A[15] = h_; A[11] = l_; \
    h_ = max(A[0], A[2]); l_ = min(A[0], A[2]); A[0] = h_; A[2] = l_; \
    h_ = max(A[1], A[3]); l_ = min(A[1], A[3]); A[1] = h_; A[3] = l_; \
    h_ = max(A[4], A[6]); l_ = min(A[4], A[6]); A[4] = h_; A[6] = l_; \
    h_ = max(A[5], A[7]); l_ = min(A[5], A[7]); A[5] = h_; A[7] = l_; \
    h_ = max(A[10], A[8]); l_ = min(A[10], A[8]); A[10] = h_; A[8] = l_; \
    h_ = max(A[11], A[9]); l_ = min(A[11], A[9]); A[11] = h_; A[9] = l_; \
    h_ = max(A[14], A[12]); l_ = min(A[14], A[12]); A[14] = h_; A[12] = l_; \
    h_ = max(A[15], A[13]); l_ = min(A[15], A[13]); A[15] = h_; A[13] = l_; \
    h_ = max(A[0], A[1]); l_ = min(A[0], A[1]); A[0] = h_; A[1] = l_; \
    h_ = max(A[2], A[3]); l_ = min(A[2], A[3]); A[2] = h_; A[3] = l_; \
    h_ = max(A[4], A[5]); l_ = min(A[4], A[5]); A[4] = h_; A[5] = l_; \
    h_ = max(A[6], A[7]); l_ = min(A[6], A[7]); A[6] = h_; A[7] = l_; \
    h_ = max(A[9], A[8]); l_ = min(A[9], A[8]); A[9] = h_; A[8] = l_; \
    h_ = max(A[11], A[10]); l_ = min(A[11], A[10]); A[11] = h_; A[10] = l_; \
    h_ = max(A[13], A[12]); l_ = min(A[13], A[12]); A[13] = h_; A[12] = l_; \
    h_ = max(A[15], A[14]); l_ = min(A[15], A[14]); A[15] = h_; A[14] = l_; \
    h_ = max(A[0], A[8]); l_ = min(A[0], A[8]); A[0] = h_; A[8] = l_; \
    h_ = max(A[1], A[9]); l_ = min(A[1], A[9]); A[1] = h_; A[9] = l_; \
    h_ = max(A[2], A[10]); l_ = min(A[2], A[10]); A[2] = h_; A[10] = l_; \
    h_ = max(A[3], A[11]); l_ = min(A[3], A[11]); A[3] = h_; A[11] = l_; \
    h_ = max(A[4], A[12]); l_ = min(A[4], A[12]); A[4] = h_; A[12] = l_; \
    h_ = max(A[5], A[13]); l_ = min(A[5], A[13]); A[5] = h_; A[13] = l_; \
    h_ = max(A[6], A[14]); l_ = min(A[6], A[14]); A[6] = h_; A[14] = l_; \
    h_ = max(A[7], A[15]); l_ = min(A[7], A[15]); A[7] = h_; A[15] = l_; \
    h_ = max(A[0], A[4]); l_ = min(A[0], A[4]); A[0] = h_; A[4] = l_; \
    h_ = max(A[1], A[5]); l_ = min(A[1], A[5]); A[1] = h_; A[5] = l_; \
    h_ = max(A[2], A[6]); l_ = min(A[2], A[6]); A[2] = h_; A[6] = l_; \
    h_ = max(A[3], A[7]); l_ = min(A[3], A[7]); A[3] = h_; A[7] = l_; \
    h_ = max(A[8], A[12]); l_ = min(A[8], A[12]); A[8] = h_; A[12] = l_; \
    h_ = max(A[9], A[13]); l_ = min(A[9], A[13]); A[9] = h_; A[13] = l_; \
    h_ = max(A[10], A[14]); l_ = min(A[10], A[14]); A[10] = h_; A[14] = l_; \
    h_ = max(A[11], A[15]); l_ = min(A[11], A[15]); A[11] = h_; A[15] = l_; \
    h_ = max(A[0], A[2]); l_ = min(A[0], A[2]); A[0] = h_; A[2] = l_; \
    h_ = max(A[1], A[3]); l_ = min(A[1], A[3]); A[1] = h_; A[3] = l_; \
    h_ = max(A[4], A[6]); l_ = min(A[4], A[6]); A[4] = h_; A[6] = l_; \
    h_ = max(A[5], A[7]); l_ = min(A[5], A[7]); A[5] = h_; A[7] = l_; \
    h_ = max(A[8], A[10]); l_ = min(A[8], A[10]); A[8] = h_; A[10] = l_; \
    h_ = max(A[9], A[11]); l_ = min(A[9], A[11]); A[9] = h_; A[11] = l_; \
    h_ = max(A[12], A[14]); l_ = min(A[12], A[14]); A[12] = h_; A[14] = l_; \
    h_ = max(A[13], A[15]); l_ = min(A[13], A[15]); A[13] = h_; A[15] = l_; \
    h_ = max(A[0], A[1]); l_ = min(A[0], A[1]); A[0] = h_; A[1] = l_; \
    h_ = max(A[2], A[3]); l_ = min(A[2], A[3]); A[2] = h_; A[3] = l_; \
    h_ = max(A[4], A[5]); l_ = min(A[4], A[5]); A[4] = h_; A[5] = l_; \
    h_ = max(A[6], A[7]); l_ = min(A[6], A[7]); A[6] = h_; A[7] = l_; \
    h_ = max(A[8], A[9]); l_ = min(A[8], A[9]); A[8] = h_; A[9] = l_; \
    h_ = max(A[10], A[11]); l_ = min(A[10], A[11]); A[10] = h_; A[11] = l_; \
    h_ = max(A[12], A[13]); l_ = min(A[12], A[13]); A[12] = h_; A[13] = l_; \
    h_ = max(A[14], A[15]); l_ = min(A[14], A[15]); A[14] = h_; A[15] = l_; \
} while (0)
#define TK_MERGE16(A) do { int h_, l_; \
    h_ = max(A[0], A[8]); l_ = min(A[0], A[8]); A[0] = h_; A[8] = l_; \
    h_ = max(A[1], A[9]); l_ = min(A[1], A[9]); A[1] = h_; A[9] = l_; \
    h_ = max(A[2], A[10]); l_ = min(A[2], A[10]); A[2] = h_; A[10] = l_; \
    h_ = max(A[3], A[11]); l_ = min(A[3], A[11]); A[3] = h_; A[11] = l_; \
    h_ = max(A[4], A[12]); l_ = min(A[4], A[12]); A[4] = h_; A[12] = l_; \
    h_ = max(A[5], A[13]); l_ = min(A[5], A[13]); A[5] = h_; A[13] = l_; \
    h_ = max(A[6], A[14]); l_ = min(A[6], A[14]); A[6] = h_; A[14] = l_; \
    h_ = max(A[7], A[15]); l_ = min(A[7], A[15]); A[7] = h_; A[15] = l_; \
    h_ = max(A[0], A[4]); l_ = min(A[0], A[4]); A[0] = h_; A[4] = l_; \
    h_ = max(A[1], A[5]); l_ = min(A[1], A[5]); A[1] = h_; A[5] = l_; \
    h_ = max(A[2], A[6]); l_ = min(A[2], A[6]); A[2] = h_; A[6] = l_; \
    h_ = max(A[3], A[7]); l_ = min(A[3], A[7]); A[3] = h_; A[7] = l_; \
    h_ = max(A[8], A[12]); l_ = min(A[8], A[12]); A[8] = h_; A[12] = l_; \
    h_ = max(A[9], A[13]); l_ = min(A[9], A[13]); A[9] = h_; A[13] = l_; \
    h_ = max(A[10], A[14]); l_ = min(A[10], A[14]); A[10] = h_; A[14] = l_; \
    h_ = max(A[11], A[15]); l_ = min(A[11], A[15]); A[11] = h_; A[15] = l_; \
    h_ = max(A[0], A[2]); l_ = min(A[0], A[2]); A[0] = h_; A[2] = l_; \
    h_ = max(A[1], A[3]); l_ = min(A[1], A[3]); A[1] = h_; A[3] = l_; \
    h_ = max(A[4], A[6]); l_ = min(A[4], A[6]); A[4] = h_; A[6] = l_; \
    h_ = max(A[5], A[7]); l_ = min(A[5], A[7]); A[5] = h_; A[7] = l_; \
    h_ = max(A[8], A[10]); l_ = min(A[8], A[10]); A[8] = h_; A[10] = l_; \
    h_ = max(A[9], A[11]); l_ = min(A[9], A[11]); A[9] = h_; A[11] = l_; \
    h_ = max(A[12], A[14]); l_ = min(A[12], A[14]); A[12] = h_; A[14] = l_; \
    h_ = max(A[13], A[15]); l_ = min(A[13], A[15]); A[13] = h_; A[15] = l_; \
    h_ = max(A[0], A[1]); l_ = min(A[0], A[1]); A[0] = h_; A[1] = l_; \
    h_ = max(A[2], A[3]); l_ = min(A[2], A[3]); A[2] = h_; A[3] = l_; \
    h_ = max(A[4], A[5]); l_ = min(A[4], A[5]); A[4] = h_; A[5] = l_; \
    h_ = max(A[6], A[7]); l_ = min(A[6], A[7]); A[6] = h_; A[7] = l_; \
    h_ = max(A[8], A[9]); l_ = min(A[8], A[9]); A[8] = h_; A[9] = l_; \
    h_ = max(A[10], A[11]); l_ = min(A[10], A[11]); A[10] = h_; A[11] = l_; \
    h_ = max(A[12], A[13]); l_ = min(A[12], A[13]); A[12] = h_; A[13] = l_; \
    h_ = max(A[14], A[15]); l_ = min(A[14], A[15]); A[14] = h_; A[15] = l_; \
} while (0)

__device__ __forceinline__ int f2ord(float f) { const int b = (int)__float_as_uint(f); return b ^ (int)((unsigned)(b >> 31) >> 1); }
__device__ __forceinline__ float ord2f(int k) { return __uint_as_float((unsigned)(k ^ (int)((unsigned)(k >> 31) >> 1))); }
__device__ __forceinline__ void topk_phase(Frame& F) {
    LAS unsigned char* lds = (LAS unsigned char*)F.lds;
    const int tid = F.tid, lane = F.lane, r32 = lane & 31, hi = lane >> 5, w = F.wave;
    LAS unsigned* slots = (LAS unsigned*)(lds + SLOT_OFF + w * 8192);
    for (int u = F.bid; u < 256; u += F.G) {
        const int tile = u >> 1, hgp = u & 1;
        const int t = tile * 256 + w * 32 + r32;
        const float rl2 = row_rstd(F.PSQ, t) * 1.4426950408889634f;
        for (int hh = 0; hh < 4; ++hh) {
            const int h = hgp * 4 + hh;
            __syncthreads();
#pragma unroll
            for (int i = 0; i < 8; ++i) { const int p = tid + 512 * i, half = p >> 11, row = (p >> 4) & 127, ch = p & 15;
                const u32x4 v = *(const u32x4*)(F.SKb + ((size_t)(h * 2 + half) * 128 + row) * 128 + ch * 8);
                *(LAS u32x4*)(lds + half * 32768 + row * 256 + ((ch ^ (row & 15)) << 4)) = v; }
            __syncthreads();
            int topk[2][16];
#pragma unroll
            for (int half = 0; half < 2; ++half) {
                bf16x8 bq[8];
#pragma unroll
                for (int ks = 0; ks < 8; ++ks) bq[ks] = *(const bf16x8*)(F.QH + (size_t)t * 2048 + h * 256 + half * 128 + 16 * ks + 8 * hi);
                f32x16 s[4];
#pragma unroll
                for (int nb = 0; nb < 4; ++nb) {
#pragma unroll
                    for (int r = 0; r < 16; ++r) s[nb][r] = 0.f;
#pragma unroll
                    for (int ks = 0; ks < 8; ++ks) {
                        const bf16x8 a = *(const LAS bf16x8*)(lds + half * 32768 + (32 * nb + r32) * 256 + (((2 * ks + hi) ^ (r32 & 15)) << 4));
                        s[nb] = __builtin_amdgcn_mfma_f32_32x32x16_bf16(a, bq[ks], s[nb], 0, 0, 0);
                    }
                }
                int kk[4][16];
#pragma unroll
                for (int nb = 0; nb < 4; ++nb)
#pragma unroll
                    for (int r = 0; r < 16; ++r) { const float sv = s[nb][r]; kk[nb][r] = (f2ord(sv) & ~127) | (32 * nb + (r & 3) + 8 * (r >> 2) + 4 * hi); }
                TK_SORT16(kk[0]); TK_SORT16(kk[1]); TK_SORT16(kk[2]); TK_SORT16(kk[3]);
#pragma unroll
                for (int i = 0; i < 16; ++i) { kk[0][i] = max(kk[0][i], kk[1][15 - i]); kk[2][i] = max(kk[2][i], kk[3][15 - i]); }
                TK_MERGE16(kk[0]); TK_MERGE16(kk[2]);
#pragma unroll
                for (int i = 0; i < 16; ++i) kk[0][i] = max(kk[0][i], kk[2][15 - i]);
                TK_MERGE16(kk[0]);
#pragma unroll
                for (int i = 0; i < 16; ++i) { auto rr = __builtin_amdgcn_permlane32_swap((unsigned)kk[0][i], (unsigned)kk[0][i], false, false); kk[1][i] = (int)(hi ? rr[0] : rr[1]); }
#pragma unroll
                for (int i = 0; i < 16; ++i) kk[0][i] = max(kk[0][i], kk[1][15 - i]);
                TK_MERGE16(kk[0]);
#pragma unroll
                for (int i = 0; i < 16; ++i) topk[half][i] = kk[0][i];
            }
            float v1[16], v2[16]; unsigned i1[16], i2[16];
#pragma unroll
            for (int r = 0; r < 16; ++r) { v1[r] = ord2f(topk[0][r] & ~127); i1[r] = (unsigned)topk[0][r] & 127u; v2[r] = ord2f(topk[1][r] & ~127); i2[r] = (unsigned)topk[1][r] & 127u; }
            float cv[NC / 2]; unsigned cp[NC / 2];
#pragma unroll
            for (int c = 0; c < NC / 2; ++c) {
                const float va = v1[CI[2 * c]] + v2[CJ[2 * c]], vb = v1[CI[2 * c + 1]] + v2[CJ[2 * c + 1]];
                const unsigned pa = (i1[CI[2 * c]] << 7) | i2[CJ[2 * c]], pb = (i1[CI[2 * c + 1]] << 7) | i2[CJ[2 * c + 1]];
                cv[c] = hi ? vb : va; cp[c] = hi ? pb : pa;
            }
            float rv[16]; unsigned rp[16];
            {
                int kc[2][16];
#pragma unroll
                for (int c = 0; c < NC / 2; ++c) { kc[c >> 4][c & 15] = (f2ord(cv[c]) & ~63) | (hi << 5) | c; slots[((hi << 5) | c) * 32 + r32] = cp[c]; }
#pragma unroll
                for (int c = NC / 2; c < 32; ++c) kc[c >> 4][c & 15] = (int)0x80000000;
                TK_SORT16(kc[0]); TK_SORT16(kc[1]);
#pragma unroll
                for (int i = 0; i < 16; ++i) kc[0][i] = max(kc[0][i], kc[1][15 - i]);
                TK_MERGE16(kc[0]);
#pragma unroll
                for (int i = 0; i < 16; ++i) { auto rr = __builtin_amdgcn_permlane32_swap((unsigned)kc[0][i], (unsigned)kc[0][i], false, false); kc[1][i] = (int)(hi ? rr[0] : rr[1]); }
#pragma unroll
                for (int i = 0; i < 16; ++i) kc[0][i] = max(kc[0][i], kc[1][15 - i]);
                TK_MERGE16(kc[0]);
#pragma unroll
                for (int r = 0; r < 16; ++r) { rv[r] = ord2f(kc[0][r] & ~63); rp[r] = slots[(kc[0][r] & 63) * 32 + r32]; }
            }
            float sum = 0.f; const float mx0 = rv[0];
#pragma unroll
            for (int r = 0; r < 16; ++r) rv[r] = __builtin_amdgcn_exp2f((rv[r] - mx0) * rl2);
#pragma unroll
            for (int r = 0; r < 16; ++r) sum += rv[r];
            const float inv = 1.0f / sum;
            if (hi == 0) {
                int4* ip = (int4*)(F.IDX + (size_t)t * 128 + h * 16); float4* gp = (float4*)(F.GW + (size_t)t * 128 + h * 16);
#pragma unroll
                for (int q = 0; q < 4; ++q) { ip[q] = make_int4((int)rp[4 * q], (int)rp[4 * q + 1], (int)rp[4 * q + 2], (int)rp[4 * q + 3]);
                    gp[q] = make_float4(rv[4 * q] * inv, rv[4 * q + 1] * inv, rv[4 * q + 2] * inv, rv[4 * q + 3] * inv); }
            }
        }
    }
    __syncthreads();
}
}

namespace peer {
typedef __bf16 bf2 __attribute__((ext_vector_type(2)));
typedef unsigned u32x4 __attribute__((ext_vector_type(4)));
template <int CTRL, int RM> __device__ __forceinline__ float dpp_add(float v) {
    return v + __builtin_bit_cast(float, __builtin_amdgcn_update_dpp(0, __builtin_bit_cast(int, v), CTRL, RM, 0xF, false));
}
__device__ __forceinline__ float wave_total(float v) {
    v = dpp_add<0xB1, 0xF>(v); v = dpp_add<0x4E, 0xF>(v); v = dpp_add<0x141, 0xF>(v); v = dpp_add<0x140, 0xF>(v);
    v = dpp_add<0x142, 0xA>(v); v = dpp_add<0x143, 0xC>(v);
    return __builtin_bit_cast(float, __builtin_amdgcn_readlane(__builtin_bit_cast(int, v), 63));
}
__device__ __forceinline__ float dot2(unsigned a, unsigned b, float c) { return __builtin_amdgcn_fdot2_f32_bf16(__builtin_bit_cast(bf2, a), __builtin_bit_cast(bf2, b), c, false); }
__device__ __forceinline__ float dot8(const u32x4 a, const u32x4 b, float c) { c = dot2(a.x, b.x, c); c = dot2(a.y, b.y, c); c = dot2(a.z, b.z, c); return dot2(a.w, b.w, c); }

__device__ __forceinline__ int wave_isum(int v) {
    v += __builtin_amdgcn_update_dpp(0, v, 0xB1, 0xF, 0xF, false); v += __builtin_amdgcn_update_dpp(0, v, 0x4E, 0xF, 0xF, false);
    v += __builtin_amdgcn_update_dpp(0, v, 0x141, 0xF, 0xF, false); v += __builtin_amdgcn_update_dpp(0, v, 0x140, 0xF, 0xF, false);
    v += __builtin_amdgcn_update_dpp(0, v, 0x142, 0xA, 0xF, false); v += __builtin_amdgcn_update_dpp(0, v, 0x143, 0xC, 0xF, false);
    return __builtin_amdgcn_readlane(v, 63);
}
constexpr int TPW = 8, SLSH = 9;
constexpr int UGRP = 1;
constexpr int VGRP = 2;
constexpr int PW_BYTES = 17440, PW_LIST = 0, PW_XQ = 8192, PW_CNT = 16416;
static_assert(NWAVES * PW_BYTES <= MISC_OFF, "PEER LDS map");
template <int CTRL, int RM> __device__ __forceinline__ int dpp_iadd(int v) { return v + __builtin_amdgcn_update_dpp(0, v, CTRL, RM, 0xF, false); }
template <int CTRL, int RM> __device__ __forceinline__ unsigned dpp_umax(unsigned v) { const unsigned t = (unsigned)__builtin_amdgcn_update_dpp(0, (int)v, CTRL, RM, 0xF, false); return v > t ? v : t; }
__device__ __forceinline__ float wave_max_pos(float f) {
    unsigned v = __float_as_uint(f);
    v = dpp_umax<0xB1, 0xF>(v); v = dpp_umax<0x4E, 0xF>(v); v = dpp_umax<0x141, 0xF>(v); v = dpp_umax<0x140, 0xF>(v); v = dpp_umax<0x142, 0xA>(v); v = dpp_umax<0x143, 0xC>(v);
    return __uint_as_float((unsigned)__builtin_amdgcn_readlane((int)v, 63));
}
__device__ __forceinline__ unsigned long long read_entry(const LAS unsigned char* pw, int j, int p) {
    const int idx = p < 128 ? p : 127;
    return *(const LAS unsigned long long*)(pw + PW_LIST + (j * 128 + idx) * 8);
}
__device__ __forceinline__ int utok(int lane) { return ((lane >> 5) & 1) | (((lane >> 4) & 1) << 1) | (((lane >> 3) & 1) << 2); }
struct UGroup { u32x4 u[TPW]; unsigned long long ent; float us, vs; };
template <int EMASK> __device__ __forceinline__ void issue_ug(Frame& F, UGroup& G, const LAS unsigned char* pw, int p, int lane) {
    const int idx = p < 128 ? p : 127;
    G.ent = *(const LAS unsigned long long*)(pw + PW_LIST + (utok(lane) * 128 + idx) * 8);
    const unsigned ev = (unsigned)G.ent & (unsigned)EMASK;
    typedef float f32x2 __attribute__((ext_vector_type(2)));
    const f32x2 sc = *(const f32x2*)(F.US + 2 * (size_t)ev);
    G.us = sc.x; G.vs = sc.y;
#pragma unroll
    for (int j = 0; j < TPW; ++j) { const unsigned e = (unsigned)__builtin_amdgcn_readlane((int)ev, 32 * (j & 1) + 16 * ((j >> 1) & 1) + 8 * ((j >> 2) & 1)); G.u[j] = *(const u32x4*)(F.U8 + (size_t)e * D + 16 * lane); }
}
__device__ __forceinline__ void compute_ug(const UGroup& G, const u32x4 (&xq)[TPW], LAS unsigned char* pw, int p, int lane, float sxrv) {
    int d[TPW];
#pragma unroll
    for (int j = 0; j < TPW; ++j) {
        d[j] = __builtin_amdgcn_sdot4((int)G.u[j].x, (int)xq[j].x, 0, false); d[j] = __builtin_amdgcn_sdot4((int)G.u[j].y, (int)xq[j].y, d[j], false);
        d[j] = __builtin_amdgcn_sdot4((int)G.u[j].z, (int)xq[j].z, d[j], false); d[j] = __builtin_amdgcn_sdot4((int)G.u[j].w, (int)xq[j].w, d[j], false); }
    int m4[4], m2[2];
#pragma unroll
    for (int i = 0; i < 4; ++i) { auto rr = __builtin_amdgcn_permlane32_swap((unsigned)d[2 * i], (unsigned)d[2 * i + 1], false, false); m4[i] = (int)rr[0] + (int)rr[1]; }
#pragma unroll
    for (int i = 0; i < 2; ++i) { auto rr = __builtin_amdgcn_permlane16_swap((unsigned)m4[2 * i], (unsigned)m4[2 * i + 1], false, false); m2[i] = (int)rr[0] + (int)rr[1]; }
    const int ra = m2[0] + __builtin_amdgcn_update_dpp(0, m2[0], 0x128, 0xF, 0xF, false), rb = m2[1] + __builtin_amdgcn_update_dpp(0, m2[1], 0x128, 0xF, 0xF, false);
    int dv = (lane & 8) ? rb : ra;
    dv = dpp_iadd<0xB1, 0xF>(dv); dv = dpp_iadd<0x4E, 0xF>(dv); dv = dpp_iadd<0x141, 0xF>(dv);
    const float z = (float)dv * G.us * sxrv;
    const float y2 = -2.3022082f * (z + 0.044715f * z * z * z);
    const float cw = __uint_as_float((unsigned)(G.ent >> 32)) * G.vs * z * __builtin_amdgcn_rcpf(1.0f + __builtin_amdgcn_exp2f(y2));
    const int pp = p < 128 ? p : 127;
    if ((lane & 7) == 0) *(LAS float*)(pw + PW_LIST + (utok(lane) * 128 + pp) * 8 + 4) = cw;
}
#define PEER_ACC(A, cw, vv) do { \
    A[0] += cw * (float)(vv.x & 0xff); A[1] += cw * (float)((vv.x >> 8) & 0xff); A[2] += cw * (float)((vv.x >> 16) & 0xff); A[3] += cw * (float)(vv.x >> 24); \
    A[4] += cw * (float)(vv.y & 0xff); A[5] += cw * (float)((vv.y >> 8) & 0xff); A[6] += cw * (float)((vv.y >> 16) & 0xff); A[7] += cw * (float)(vv.y >> 24); \
    A[8] += cw * (float)(vv.z & 0xff); A[9] += cw * (float)((vv.z >> 8) & 0xff); A[10] += cw * (float)((vv.z >> 16) & 0xff); A[11] += cw * (float)(vv.z >> 24); \
    A[12] += cw * (float)(vv.w & 0xff); A[13] += cw * (float)((vv.w >> 8) & 0xff); A[14] += cw * (float)((vv.w >> 16) & 0xff); A[15] += cw * (float)(vv.w >> 24); } while (0)
template <int EMASK, int MODE> __device__ __forceinline__ void peer_phase_t(Frame& F, float* outp, const XcdBarrier& bar) {
    const int gw = F.bid * NWAVES + F.wave, NGW = F.G * NWAVES, lane = F.lane;
    LAS unsigned char* pw = (LAS unsigned char*)F.lds + F.wave * PW_BYTES;
    LAS unsigned* cnt = (LAS unsigned*)(pw + PW_CNT);
    const int rounds = (T / TPW + NGW - 1) / NGW;
    for (int rd = 0; rd < rounds; ++rd) {
        const int wt = gw + rd * NGW; const bool live = wt < T / TPW;
        if (rd) xcd_barrier_light(bar);
        const int t0 = (live ? wt : gw) * TPW;
        u32x4 xq[TPW]; float sxrv;
        {
            int lq = lane; asm volatile("" : "+v"(lq));
            uint4 hA[TPW], hB[TPW]; int id0[TPW], id1[TPW]; float g0[TPW], g1[TPW];
#pragma unroll
            for (int j = 0; j < TPW; ++j) { const size_t t = (size_t)(t0 + j);
                hA[j] = *(const uint4*)(F.HB + t * D + 16 * lq); hB[j] = *(const uint4*)(F.HB + t * D + 16 * lq + 8);
                id0[j] = F.IDX[t * 128 + lq]; id1[j] = F.IDX[t * 128 + 64 + lq]; g0[j] = F.GW[t * 128 + lq]; g1[j] = F.GW[t * 128 + 64 + lq]; }
            const float rstd = row_rstd(F.PSQ, t0 + utok(lq));
            *(LAS u32x4*)(pw + PW_CNT + 16 * lq) = u32x4{0u, 0u, 0u, 0u};
            float msel = 0.f;
#pragma unroll
            for (int j = 0; j < TPW; ++j) {
                float x[16];
                { float xa[8], xb[8]; unpack8(hA[j], xa); unpack8(hB[j], xb);
#pragma unroll
                  for (int i = 0; i < 8; ++i) { x[i] = xa[i]; x[8 + i] = xb[i]; } }
                float m = 0.f;
#pragma unroll
                for (int i = 0; i < 16; ++i) m = fmaxf(m, fabsf(x[i]));
                m = wave_max_pos(m);
                const float inv = m > 0.f ? 127.0f * __builtin_amdgcn_rcpf(m) : 0.f;
                int qi[16];
#pragma unroll
                for (int i = 0; i < 16; ++i) qi[i] = (int)rintf(x[i] * inv) & 0xff;
                xq[j].x = (unsigned)qi[0] | ((unsigned)qi[1] << 8) | ((unsigned)qi[2] << 16) | ((unsigned)qi[3] << 24); xq[j].y = (unsigned)qi[4] | ((unsigned)qi[5] << 8) | ((unsigned)qi[6] << 16) | ((unsigned)qi[7] << 24);
                xq[j].z = (unsigned)qi[8] | ((unsigned)qi[9] << 8) | ((unsigned)qi[10] << 16) | ((unsigned)qi[11] << 24); xq[j].w = (unsigned)qi[12] | ((unsigned)qi[13] << 8) | ((unsigned)qi[14] << 16) | ((unsigned)qi[15] << 24);
                msel = (utok(lq) == j) ? m : msel;
            }
            sxrv = msel * (1.0f / 127.0f) * rstd;
            asm volatile("s_waitcnt lgkmcnt(0)" ::: "memory");
            unsigned r0[TPW], r1[TPW];
#pragma unroll
            for (int j = 0; j < TPW; ++j) {
                r0[j] = __hip_atomic_fetch_add(cnt + j * 32 + (id0[j] >> SLSH), 1u, __ATOMIC_RELAXED, __HIP_MEMORY_SCOPE_WORKGROUP);
                r1[j] = __hip_atomic_fetch_add(cnt + j * 32 + (id1[j] >> SLSH), 1u, __ATOMIC_RELAXED, __HIP_MEMORY_SCOPE_WORKGROUP); }
            asm volatile("s_waitcnt lgkmcnt(0)" ::: "memory");
#pragma unroll
            for (int j = 0; j < TPW; ++j) {
                const int own = lq < 32 ? (int)cnt[j * 32 + lq] : 0; int c = own;
                c = dpp_iadd<0x111, 0xF>(c); c = dpp_iadd<0x112, 0xF>(c); c = dpp_iadd<0x114, 0xF>(c); c = dpp_iadd<0x118, 0xF>(c); c = dpp_iadd<0x142, 0xA>(c);
                if (lq < 32) cnt[j * 32 + lq] = (unsigned)(c - own); }
            asm volatile("s_waitcnt lgkmcnt(0)" ::: "memory");
#pragma unroll
            for (int j = 0; j < TPW; ++j) {
                const unsigned p0 = cnt[j * 32 + (id0[j] >> SLSH)] + r0[j], p1 = cnt[j * 32 + (id1[j] >> SLSH)] + r1[j];
                *(LAS unsigned long long*)(pw + PW_LIST + (j * 128 + p0) * 8) = (unsigned long long)(unsigned)id0[j] | ((unsigned long long)__float_as_uint(g0[j]) << 32);
                *(LAS unsigned long long*)(pw + PW_LIST + (j * 128 + p1) * 8) = (unsigned long long)(unsigned)id1[j] | ((unsigned long long)__float_as_uint(g1[j]) << 32); }
            asm volatile("s_waitcnt lgkmcnt(0)" ::: "memory");
        }
        {
            UGroup G[UGRP];
#pragma unroll
            for (int q = 0; q < UGRP; ++q) issue_ug<EMASK>(F, G[q], pw, q, lane);
            for (int p = 0; p < 128; p += UGRP) {
                if (p == 64) xcd_barrier_light(bar);
#pragma unroll
                for (int q = 0; q < UGRP; ++q) { compute_ug(G[q], xq, pw, p + q, lane, sxrv); issue_ug<EMASK>(F, G[q], pw, p + UGRP + q, lane); }
            }
        }
        asm volatile("s_waitcnt lgkmcnt(0)" ::: "memory");
        xcd_barrier_light(bar);
        float stok[TPW];
        int lc = lane; asm volatile("" : "+v"(lc));
#pragma unroll
        for (int j = 0; j < TPW; ++j) {
            const unsigned long long a0 = *(const LAS unsigned long long*)(pw + PW_LIST + (j * 128 + lc) * 8), a1 = *(const LAS unsigned long long*)(pw + PW_LIST + (j * 128 + 64 + lc) * 8);
            const float c0 = __uint_as_float((unsigned)(a0 >> 32)), c1 = __uint_as_float((unsigned)(a1 >> 32));
            const float m = wave_max_pos(fmaxf(fabsf(c0), fabsf(c1)));
            const float sc = m > 0.f ? 127.0f * __builtin_amdgcn_rcpf(m) : 0.f;
            stok[j] = m * (1.0f / 127.0f);
            *(LAS unsigned short*)(pw + PW_XQ + (j * 128 + lc) * 2) = (unsigned short)(unsigned)a0; *(LAS unsigned short*)(pw + PW_XQ + (j * 128 + 64 + lc) * 2) = (unsigned short)(unsigned)a1;
            *(LAS signed char*)(pw + PW_XQ + 2048 + j * 128 + lc) = (signed char)(int)rintf(c0 * sc); *(LAS signed char*)(pw + PW_XQ + 2048 + j * 128 + 64 + lc) = (signed char)(int)rintf(c1 * sc);
        }
        asm volatile("s_waitcnt lgkmcnt(0)" ::: "memory");
        int acc[TPW][16];
#pragma unroll
        for (int j = 0; j < TPW; ++j)
#pragma unroll
            for (int i = 0; i < 16; ++i) acc[j][i] = 0;
        {
            struct VG4 { u32x4 r[4]; int cw4; };
            VG4 S[VGRP];
#define PEER_VISSUE(S_, j_, gp_) do { const int g_ = (gp_) < 32 ? (gp_) : 31; \
                const unsigned long long ev_ = *(const LAS unsigned long long*)(pw + PW_XQ + ((j_) * 128 + 4 * g_) * 2); \
                const unsigned s0_ = (unsigned)__builtin_amdgcn_readfirstlane((int)(unsigned)ev_), s1_ = (unsigned)__builtin_amdgcn_readfirstlane((int)(unsigned)(ev_ >> 32)); \
                (S_).cw4 = __builtin_amdgcn_readfirstlane(*(const LAS int*)(pw + PW_XQ + 2048 + (j_) * 128 + 4 * g_)); \
                (S_).r[0] = *(const u32x4*)(F.V8 + (size_t)((s0_ & 0xffffu) & (unsigned)EMASK) * D + 16 * lane); (S_).r[1] = *(const u32x4*)(F.V8 + (size_t)((s0_ >> 16) & (unsigned)EMASK) * D + 16 * lane); \
                (S_).r[2] = *(const u32x4*)(F.V8 + (size_t)((s1_ & 0xffffu) & (unsigned)EMASK) * D + 16 * lane); (S_).r[3] = *(const u32x4*)(F.V8 + (size_t)((s1_ >> 16) & (unsigned)EMASK) * D + 16 * lane); } while (0)
#define PEER_VTR(A_, i_, a0_, a1_, a2_, a3_, cw_) do { \
                const unsigned x01l_ = __builtin_amdgcn_perm(a1_, a0_, 0x05010400u), x01h_ = __builtin_amdgcn_perm(a1_, a0_, 0x07030602u); \
                const unsigned x23l_ = __builtin_amdgcn_perm(a3_, a2_, 0x05010400u), x23h_ = __builtin_amdgcn_perm(a3_, a2_, 0x07030602u); \
                A_[4 * (i_) + 0] = __builtin_amdgcn_sdot4((int)__builtin_amdgcn_perm(x23l_, x01l_, 0x05040100u), cw_, A_[4 * (i_) + 0], false); \
                A_[4 * (i_) + 1] = __builtin_amdgcn_sdot4((int)__builtin_amdgcn_perm(x23l_, x01l_, 0x07060302u), cw_, A_[4 * (i_) + 1], false); \
                A_[4 * (i_) + 2] = __builtin_amdgcn_sdot4((int)__builtin_amdgcn_perm(x23h_, x01h_, 0x05040100u), cw_, A_[4 * (i_) + 2], false); \
                A_[4 * (i_) + 3] = __builtin_amdgcn_sdot4((int)__builtin_amdgcn_perm(x23h_, x01h_, 0x07060302u), cw_, A_[4 * (i_) + 3], false); } while (0)
#pragma unroll
            for (int n = 0; n < VGRP; ++n) PEER_VISSUE(S[n], n % TPW, n / TPW);
            for (int gp = 0; gp < 32; ++gp) {
                if (gp == 16) xcd_barrier_light(bar);
#pragma unroll
                for (int j = 0; j < TPW; ++j) {
                    VG4& G = S[j % VGRP];
                    PEER_VTR(acc[j], 0, G.r[0].x, G.r[1].x, G.r[2].x, G.r[3].x, G.cw4); PEER_VTR(acc[j], 1, G.r[0].y, G.r[1].y, G.r[2].y, G.r[3].y, G.cw4);
                    PEER_VTR(acc[j], 2, G.r[0].z, G.r[1].z, G.r[2].z, G.r[3].z, G.cw4); PEER_VTR(acc[j], 3, G.r[0].w, G.r[1].w, G.r[2].w, G.r[3].w, G.cw4);
                    PEER_VISSUE(G, (j + VGRP) % TPW, gp + (j + VGRP) / TPW);
                }
            }
#undef PEER_VISSUE
#undef PEER_VTR
        }
#pragma unroll
        for (int j = 0; j < TPW; ++j) {
            float* orow = outp + (size_t)(t0 + j) * D + 16 * lane;
            float y[16]; float ss = 0.f;
            { float ha[8], hb[8]; unpack8(*(const uint4*)(F.HB + (size_t)(t0 + j) * D + 16 * lane), ha); unpack8(*(const uint4*)(F.HB + (size_t)(t0 + j) * D + 16 * lane + 8), hb);
#pragma unroll
              for (int i = 0; i < 8; ++i) { y[i] = ha[i] + stok[j] * (float)acc[j][i]; y[8 + i] = hb[i] + stok[j] * (float)acc[j][8 + i]; } }
#pragma unroll
            for (int i = 0; i < 16; ++i) ss += y[i] * y[i];
            const float r = 1.0f / sqrtf(wave_total(ss) * (1.f / D) + RMS_EPS);
#pragma unroll
            for (int q = 0; q < 4; ++q) { const float4 wv = *(const float4*)(F.nfin + 16 * lane + 4 * q);
                *(float4*)(orow + 4 * q) = make_float4(y[4 * q] * r * wv.x, y[4 * q + 1] * r * wv.y, y[4 * q + 2] * r * wv.z, y[4 * q + 3] * r * wv.w); }
        }
        asm volatile("s_waitcnt lgkmcnt(0)" ::: "memory");
    }
}
}

constexpr int N_PHASES = 11;
__global__ void __launch_bounds__(NTHREADS, 2) mk_fwd(Args args) {
    extern __shared__ __attribute__((aligned(16))) unsigned char lds[];
    Frame F;
    F.lds = lds;
    F.tid = threadIdx.x; F.lane = F.tid & 63; F.wave = __builtin_amdgcn_readfirstlane(F.tid >> 6);
    F.G = gridDim.x; F.bid = blockIdx.x;
    F.x = args.in[0]; F.nmw = args.in[1]; F.w_in = args.in[2]; F.lbp = args.in[3]; F.hnw = args.in[4]; F.dlam = args.in[5]; F.dnw = args.in[6];
    F.w_out = args.in[7]; F.nfw = args.in[8]; F.wq = args.in[9]; F.sk = args.in[10]; F.u = args.in[11]; F.v = args.in[12]; F.nfin = args.in[13];
    F.out = args.out;
    unsigned char* ws = args.ws;
    F.WinT = (bf16*)(ws + WS_WIN); F.WoT = (bf16*)(ws + WS_WO); F.WqT = (bf16*)(ws + WS_WQ); F.SKb = (bf16*)(ws + WS_SK);
    F.XN = (bf16*)(ws + WS_XN); F.MIX = (bf16*)(ws + WS_MIX);
    F.PROJ = (bf16*)(ws + WS_PROJ); F.HB = (bf16*)(ws + WS_HB); F.QH = (bf16*)(ws + WS_QH);
    F.HA = (float*)(ws + WS_HA); F.HO = (float*)(ws + WS_HO); F.PSQ = (float*)(ws + WS_PSQ); F.GW = (float*)(ws + WS_G);
    F.IDX = (int*)(ws + WS_IDX); F.DECG = (float*)(ws + WS_DECG);
    F.U8 = ws + WS_U8; F.V8 = ws + WS_V8; F.US = (float*)(ws + WS_US);
    const int lo = args.ph_lo, hi = args.ph_hi;
    volatile LAS unsigned* MISC = (volatile LAS unsigned*)((LAS unsigned char*)lds + MISC_OFF);
    if (F.tid < 32) MISC[F.tid] = 0u;
    __syncthreads();
    XcdBarrier bar; bar.bar = (unsigned*)(ws + WS_CTL) + 4096; bar.x = 0; bar.st = nullptr;
    if (hi - lo > 1) bar = xcd_barrier_post((unsigned*)(ws + WS_CTL) + 4096, MISC + 8);
#define IN(k) (lo <= (k) && (k) < hi)
#define SEAM(k) do { if (IN(k) && IN((k) + 1)) xcd_barrier(bar); } while (0)
    if (IN(0)) { stage_prep(F);
    }
    SEAM(0);
    if (IN(1)) { pg8::Gemm g{F.XN, F.WinT, T, DIN, D}; pg8::StaticOrder S; S.init(T, DIN, F.G, F.bid); EpiIn E{F.PROJ, F.HA, F.lbp};
        pg8::gemm_phase<EpiIn, pg8::StaticOrder, true, true>((PG8_LAS unsigned char*)lds, g, S, E); }
    if (IN(1) && IN(3)) xcd_barrier(bar);
    if (IN(3)) for (int task = F.bid; task < BATCH * 4 * 64; task += F.G) hg::hgrn_pre(F, task);
    if (IN(3) && IN(4)) xcd_barrier(bar);
    if (IN(4)) { for (int unit = F.bid; unit < 32; unit += F.G) hg::hgrn_scan(F, unit >> 2, unit & 3);
        da::attn_phase(F, (unsigned*)(ws + WS_CTL), MISC);
    }
    SEAM(5);
    if (IN(6)) { pg8::Gemm g{F.MIX, F.WoT, T, D, D}; pg8::StaticOrder S; S.init(T, D, F.G, F.bid); EpiOut E{F.x, F.HB, F.PSQ};
        pg8::gemm_phase<EpiOut, pg8::StaticOrder, true, true>((PG8_LAS unsigned char*)lds, g, S, E); }
    if (IN(6) && IN(8)) xcd_barrier(bar);
    if (IN(8)) { pg8::Gemm g{F.HB, F.WqT, T, 2048, D}; pg8::StaticOrder S; S.init(T, 2048, F.G, F.bid); EpiQ E{F.QH};
        pg8::gemm_phase<EpiQ, pg8::StaticOrder, true, true>((PG8_LAS unsigned char*)lds, g, S, E); }
    SEAM(8);
    if (IN(9)) tk::topk_phase(F);
    SEAM(9);
    if (IN(10)) { peer::peer_phase_t<0xffff, 0>(F, F.out, bar);
    }
#undef IN
#undef SEAM
}

extern "C" void kernel_launch(void* const* d_in, const int* in_sizes, int n_in, void* d_out, int out_size, void* d_ws, size_t ws_size, hipStream_t stream) {
    static int grid = 0;
    if (grid == 0) {
        if (n_in != 14 || in_sizes[0] != T * D || out_size != T * D || ws_size < WS_END) {
            fprintf(stderr, "kernel_launch: unexpected shapes: n_in %d in0 %d out %d ws %zu (need %zu)\n", n_in, n_in > 0 ? in_sizes[0] : -1, out_size, ws_size, (size_t)WS_END);
            grid = -1; return; }
        int dev = 0, cus = 0;
        if (hipGetDevice(&dev) != hipSuccess || hipDeviceGetAttribute(&cus, hipDeviceAttributeMultiprocessorCount, dev) != hipSuccess) { grid = -1; return; }
        if (hipFuncSetAttribute((const void*)mk_fwd, hipFuncAttributeMaxDynamicSharedMemorySize, LDS_BYTES) != hipSuccess) { fprintf(stderr, "kernel_launch: hipFuncSetAttribute failed\n"); grid = -1; return; }
        int per_cu = 0;
        if (hipOccupancyMaxActiveBlocksPerMultiprocessor(&per_cu, (const void*)mk_fwd, NTHREADS, LDS_BYTES) != hipSuccess || per_cu < 1) {
            fprintf(stderr, "kernel_launch: the occupancy query reports %d workgroups per CU for %d threads / %d B of LDS; nothing launched\n", per_cu, NTHREADS, LDS_BYTES); grid = -1; return; }
        (void)hipGetLastError();
        grid = cus;
    }
    if (grid < 0) return;
    Args a{};
    for (int i = 0; i < 14; ++i) a.in[i] = (const float*)d_in[i];
    a.out = (float*)d_out; a.ws = (unsigned char*)d_ws;
    if (hipMemsetAsync((char*)d_ws + WS_CTL, 0, 64 * 1024, stream) != hipSuccess) { fprintf(stderr, "kernel_launch: memset failed\n"); return; }
    a.ph_lo = 0; a.ph_hi = N_PHASES;
    hipLaunchKernelGGL(mk_fwd, dim3(grid), dim3(NTHREADS), LDS_BYTES, stream, a);
}
```

```cpp
#include <hip/hip_runtime.h>
#include <cstdio>
#include <cstdint>

constexpr int BATCH = 8, SEQ = 4096, T = BATCH * SEQ, D = 1024, DIN = 3584;
constexpr int NEXP = 16384;
constexpr float RMS_EPS = 1e-6f;
constexpr int NWAVES = 8, NTHREADS = NWAVES * 64;

constexpr int C_HQ = 0, C_HF = 512, C_HI = 1024, C_HG = 1536, C_AQ = 2048, C_AK = 2560, C_AV = 3072;

constexpr size_t MiB = 1u << 20;
constexpr size_t WS_CTL = 0;
constexpr size_t WS_WIN = 2 * MiB;
constexpr size_t WS_WO = 9 * MiB;
constexpr size_t WS_WQ = 11 * MiB;
constexpr size_t WS_SK = 15 * MiB;
constexpr size_t WS_U8 = 16 * MiB;
constexpr size_t WS_V8 = 32 * MiB;
constexpr size_t WS_US = 48 * MiB;
constexpr size_t WS_XN = 80 * MiB;
constexpr size_t WS_MIX = 80 * MiB;
constexpr size_t WS_PROJ = 144 * MiB;
constexpr size_t WS_HA = 368 * MiB;
constexpr size_t WS_HO = 432 * MiB;
constexpr size_t WS_PSQ = 496 * MiB;
constexpr size_t WS_HB = 144 * MiB;
constexpr size_t WS_QH = 208 * MiB;
constexpr size_t WS_IDX = 336 * MiB;
constexpr size_t WS_G = 352 * MiB;
constexpr size_t WS_DECG = 498 * MiB;
constexpr size_t WS_END = 499 * MiB;

constexpr int LDS_BYTES = 147456;
constexpr int MISC_OFF = 139520 + 64;

typedef unsigned short bf16;
#define LAS __attribute__((address_space(3)))

__device__ __forceinline__ unsigned f2bf(float f) { unsigned u = __builtin_bit_cast(unsigned, f); return (u + 0x7fffu + ((u >> 16) & 1u)) >> 16; }
__device__ __forceinline__ unsigned pk2(float lo, float hi) { return f2bf(lo) | (f2bf(hi) << 16); }
__device__ __forceinline__ float bf2f(unsigned b) { return __builtin_bit_cast(float, b << 16); }
__device__ __forceinline__ float bflo(unsigned w) { return __builtin_bit_cast(float, w << 16); }
__device__ __forceinline__ float bfhi(unsigned w) { return __builtin_bit_cast(float, w & 0xffff0000u); }
__device__ __forceinline__ float wave_sum(float v) {
#pragma unroll
    for (int o = 1; o < 64; o <<= 1) v += __shfl_xor(v, o);
    return v;
}


#define GAS __attribute__((address_space(1)))
typedef GAS unsigned gu32;
#define RLX_AGENT __ATOMIC_RELAXED, __HIP_MEMORY_SCOPE_AGENT
#define XB_TMO      128
#define XB_XCNT(j)  (256  + 64 * (j))
#define XB_XSUB(j)  (1280 + 64 * (j))
#define XB_XGEN(j)  (2304 + 64 * (j))
#define XB_TOP      3328
#define XB_TOPGEN   3392
#define XCD_BAR_WORDS 3456
#define XB_SPIN_CAP (1u << 22)
__device__ __forceinline__ unsigned xb_ld(unsigned* p)              { return __hip_atomic_load(p, __ATOMIC_RELAXED, __HIP_MEMORY_SCOPE_AGENT); }
__device__ __forceinline__ unsigned xb_add(unsigned* p, unsigned v) { return __hip_atomic_fetch_add(p, v, __ATOMIC_RELAXED, __HIP_MEMORY_SCOPE_AGENT); }
__device__ __forceinline__ unsigned xb_xcc_id() { return (unsigned)__builtin_amdgcn_s_getreg((3 << 11) | 20) & 0xFu; }
#define XB_SPIN(cond, bar) do { unsigned _sp = 0; while (cond) { __builtin_amdgcn_s_sleep(1); \
    if ((++_sp & 255u) == 0u) { if (xb_ld(&(bar)[XB_TMO])) break; if (_sp > XB_SPIN_CAP) { atomicAdd(&(bar)[XB_TMO], 1u); break; } } } } while (0)
struct XcdBarrier { unsigned* bar; unsigned x; volatile LAS unsigned* st; };
__device__ __forceinline__ XcdBarrier xcd_barrier_post(unsigned* bar, volatile LAS unsigned* st) {
    XcdBarrier b; b.bar = bar; b.x = xb_xcc_id(); b.st = st;
    if (threadIdx.x == 0) (void)xb_add(&bar[XB_XCNT(b.x)], 1u);
    return b;
}
__device__ __forceinline__ void xcd_barrier_complete(unsigned* bar, unsigned x, unsigned& nloc, unsigned& nx) {
    const unsigned G = gridDim.x * gridDim.y * gridDim.z;
    unsigned sum, cnt, mine, sp = 0u;
    for (;;) {
        sum = 0u; cnt = 0u; mine = 0u;
#pragma unroll
        for (unsigned j = 0; j < 16; ++j) { const unsigned c = xb_ld(&bar[XB_XCNT(j)]); sum += c; cnt += (c > 0u) ? 1u : 0u; mine = (j == x) ? c : mine; }
        if (sum == G) break;
        __builtin_amdgcn_s_sleep(1);
        if ((++sp & 255u) == 0u) { if (xb_ld(&bar[XB_TMO])) break; if (sp > XB_SPIN_CAP) { atomicAdd(&bar[XB_TMO], 1u); break; } }
    }
    nloc = mine > 0u ? mine : 1u; nx = cnt > 0u ? cnt : 1u;
}
__device__ __forceinline__ void xcd_barrier(const XcdBarrier& b) {
    asm volatile("s_waitcnt vmcnt(0)" ::: "memory");
    __syncthreads();
    if (threadIdx.x == 0) {
        unsigned* bar = b.bar;
        __builtin_amdgcn_s_waitcnt(0);
        unsigned nloc = b.st[0], nx = b.st[1];
        if (nloc == 0u) { xcd_barrier_complete(bar, b.x, nloc, nx); b.st[0] = nloc; b.st[1] = nx; }
        const unsigned old = xb_add(&bar[XB_XSUB(b.x)], 1u);
        const unsigned gen = old / nloc;
        if (old + 1u == (gen + 1u) * nloc) {
            __builtin_amdgcn_fence(__ATOMIC_RELEASE, "agent");
            asm volatile("s_waitcnt vmcnt(0)" ::: "memory");
            const unsigned og = xb_add(&bar[XB_TOP], 1u);
            const unsigned tg = og / nx;
            if (og + 1u == (tg + 1u) * nx) xb_add(&bar[XB_TOPGEN], 1u);
            else XB_SPIN(xb_ld(&bar[XB_TOPGEN]) == tg, bar);
            __builtin_amdgcn_fence(__ATOMIC_ACQUIRE, "agent");
            xb_add(&bar[XB_XGEN(b.x)], 1u);
            asm volatile("s_waitcnt vmcnt(0)" ::: "memory");
        } else {
            XB_SPIN(xb_ld(&bar[XB_XGEN(b.x)]) == gen, bar);
            __builtin_amdgcn_fence(__ATOMIC_ACQUIRE, "agent");
            asm volatile("s_waitcnt vmcnt(0)" ::: "memory");
        }
    }
    __syncthreads();
}

__device__ __forceinline__ void xcd_barrier_light(const XcdBarrier& b) {
    __syncthreads();
    if (threadIdx.x == 0) {
        unsigned* bar = b.bar;
        unsigned nloc = b.st[0], nx = b.st[1];
        if (nloc == 0u) { xcd_barrier_complete(bar, b.x, nloc, nx); b.st[0] = nloc; b.st[1] = nx; }
        const unsigned old = xb_add(&bar[XB_XSUB(b.x)], 1u);
        const unsigned gen = old / nloc;
        if (old + 1u == (gen + 1u) * nloc) {
            const unsigned og = xb_add(&bar[XB_TOP], 1u);
            const unsigned tg = og / nx;
            if (og + 1u == (tg + 1u) * nx) xb_add(&bar[XB_TOPGEN], 1u);
            else XB_SPIN(xb_ld(&bar[XB_TOPGEN]) == tg, bar);
            xb_add(&bar[XB_XGEN(b.x)], 1u);
        } else {
            XB_SPIN(xb_ld(&bar[XB_XGEN(b.x)]) == gen, bar);
        }
    }
    __syncthreads();
}

struct Args { const float* in[14]; float* out; unsigned char* ws; int ph_lo, ph_hi; };

struct Frame {
    unsigned char* lds;
    int tid, lane, wave, G, bid;
    const float *x, *nmw, *w_in, *lbp, *hnw, *dlam, *dnw, *w_out, *nfw, *wq, *sk, *u, *v, *nfin;
    float* out;
    bf16 *WinT, *WoT, *WqT, *SKb, *XN, *MIX, *PROJ, *HB, *QH;
    float *HA, *HO, *PSQ, *GW, *US, *DECG;
    int* IDX;
    unsigned char *U8, *V8;
};

__device__ __forceinline__ void transpose_item(const float* W, const float* scale, int K, int N, bf16* WT, float* scr, int item, int lane) {
    const int nblk = N / 32, kb = item / nblk, nb = item % nblk, k0 = 64 * kb, n0 = 32 * nb;
#pragma unroll 8
    for (int i = 0; i < 32; ++i) { const int kk = 2 * i + (lane >> 5); float s = scale ? scale[k0 + kk] : 1.0f; scr[kk * 33 + (lane & 31)] = W[(size_t)(k0 + kk) * N + n0 + (lane & 31)] * s; }
    __builtin_amdgcn_s_waitcnt(0xc07f); asm volatile("" ::: "memory");
    const int c = lane & 7;
#pragma unroll
    for (int j = 0; j < 4; ++j) { const int n = (lane >> 3) + 8 * j; const float* s = scr + (8 * c) * 33 + n;
        uint4 o; o.x = pk2(s[0 * 33], s[1 * 33]); o.y = pk2(s[2 * 33], s[3 * 33]); o.z = pk2(s[4 * 33], s[5 * 33]); o.w = pk2(s[6 * 33], s[7 * 33]);
        *(uint4*)(WT + (size_t)(n0 + n) * K + k0 + 8 * c) = o; }
    __builtin_amdgcn_s_waitcnt(0xc07f); asm volatile("" ::: "memory");
}

__device__ __forceinline__ void stage_prep(Frame& F, const int parts = 7) {
    float* scr = (float*)(F.lds + F.wave * 16384);
    const int gw = F.bid * NWAVES + F.wave, NGW = F.G * NWAVES;
    constexpr int I_IN = (D / 64) * (DIN / 32), I_O = (D / 64) * (D / 32), I_Q = (D / 64) * (2048 / 32);
    if (parts & 1) for (int it = gw; it < I_IN + I_O + I_Q; it += NGW) {
        int r = it;
        if (r < I_IN) { transpose_item(F.w_in, nullptr, D, DIN, F.WinT, scr, r, F.lane); continue; } r -= I_IN;
        if (r < I_O) { transpose_item(F.w_out, nullptr, D, D, F.WoT, scr, r, F.lane); continue; } r -= I_O;
        transpose_item(F.wq, F.nfw, D, 2048, F.WqT, scr, r, F.lane);
    }
    const size_t gt = (size_t)F.bid * NTHREADS + F.tid, NGT = (size_t)F.G * NTHREADS;
    if (parts & 2) for (int e = gw; e < NEXP; e += NGW) {
        const float4* ur = (const float4*)(F.u + (size_t)e * D) + F.lane; const float4* vr = (const float4*)(F.v + (size_t)e * D) + F.lane; const float4* wr = (const float4*)F.nfw + F.lane;
        float4 a[4], b[4]; float mu = 0.f, mv = 0.f;
#pragma unroll
        for (int j = 0; j < 4; ++j) { const float4 w = wr[64 * j]; a[j] = ur[64 * j]; b[j] = vr[64 * j]; a[j].x *= w.x; a[j].y *= w.y; a[j].z *= w.z; a[j].w *= w.w;
            mu = fmaxf(mu, fmaxf(fmaxf(fabsf(a[j].x), fabsf(a[j].y)), fmaxf(fabsf(a[j].z), fabsf(a[j].w))));
            mv = fmaxf(mv, fmaxf(fmaxf(fabsf(b[j].x), fabsf(b[j].y)), fmaxf(fabsf(b[j].z), fabsf(b[j].w)))); }
#pragma unroll
        for (int o = 1; o < 64; o <<= 1) { mu = fmaxf(mu, __shfl_xor(mu, o)); mv = fmaxf(mv, __shfl_xor(mv, o)); }
        const float iu = mu > 0.f ? 127.0f / mu : 0.f, iv = mv > 0.f ? 127.0f / mv : 0.f;
        unsigned* u8 = (unsigned*)(F.U8 + (size_t)e * D) + F.lane; unsigned* v8 = (unsigned*)(F.V8 + (size_t)e * D) + F.lane;
#pragma unroll
        for (int j = 0; j < 4; ++j) {
            const int q0 = (int)rintf(a[j].x * iu), q1 = (int)rintf(a[j].y * iu), q2 = (int)rintf(a[j].z * iu), q3 = (int)rintf(a[j].w * iu);
            u8[64 * j] = (unsigned)(q0 & 0xff) | ((unsigned)(q1 & 0xff) << 8) | ((unsigned)(q2 & 0xff) << 16) | ((unsigned)(q3 & 0xff) << 24);
            const int p0 = (int)rintf(b[j].x * iv), p1 = (int)rintf(b[j].y * iv), p2 = (int)rintf(b[j].z * iv), p3 = (int)rintf(b[j].w * iv);
            v8[64 * j] = (unsigned)(p0 & 0xff) | ((unsigned)(p1 & 0xff) << 8) | ((unsigned)(p2 & 0xff) << 16) | ((unsigned)(p3 & 0xff) << 24); }
        if (F.lane == 0) { F.US[2 * e] = mu * (1.0f / 127.0f); F.US[2 * e + 1] = mv * (1.0f / 127.0f); }
    }
    if (parts & 2) for (size_t i = gt; i < (size_t)8 * 2 * 128 * 128 / 8; i += NGT) {
        const float4 c = *(const float4*)(F.sk + i * 8), d = *(const float4*)(F.sk + i * 8 + 4);
        uint4 p; p.x = pk2(c.x, c.y); p.y = pk2(c.z, c.w); p.z = pk2(d.x, d.y); p.w = pk2(d.z, d.w);
        *(uint4*)(F.SKb + i * 8) = p;
    }
    if (parts & 4) {
        float4 wv[4];
#pragma unroll
        for (int j = 0; j < 4; ++j) wv[j] = ((const float4*)F.nmw)[F.lane + 64 * j];
        for (int m = gw; m < T; m += 2 * NGW) {
            const int m1 = m + NGW; const bool has1 = m1 < T;
            const float4* xr0 = (const float4*)(F.x + (size_t)m * D) + F.lane; const float4* xr1 = (const float4*)(F.x + (size_t)(has1 ? m1 : m) * D) + F.lane;
            float4 v0[4], v1[4]; float s0 = 0.f, s1 = 0.f;
#pragma unroll
            for (int j = 0; j < 4; ++j) { v0[j] = xr0[64 * j]; v1[j] = xr1[64 * j]; }
#pragma unroll
            for (int j = 0; j < 4; ++j) { s0 += (v0[j].x * v0[j].x + v0[j].y * v0[j].y) + (v0[j].z * v0[j].z + v0[j].w * v0[j].w); s1 += (v1[j].x * v1[j].x + v1[j].y * v1[j].y) + (v1[j].z * v1[j].z + v1[j].w * v1[j].w); }
#pragma unroll
            for (int o = 1; o < 64; o <<= 1) { s0 += __shfl_xor(s0, o); s1 += __shfl_xor(s1, o); }
            const float r0 = 1.0f / sqrtf(s0 * (1.f / D) + RMS_EPS), r1 = 1.0f / sqrtf(s1 * (1.f / D) + RMS_EPS);
            unsigned long long* o0 = (unsigned long long*)(F.XN + (size_t)m * D) + F.lane; unsigned long long* o1 = (unsigned long long*)(F.XN + (size_t)m1 * D) + F.lane;
#pragma unroll
            for (int j = 0; j < 4; ++j) {
                o0[64 * j] = (unsigned long long)pk2(v0[j].x * r0 * wv[j].x, v0[j].y * r0 * wv[j].y) | ((unsigned long long)pk2(v0[j].z * r0 * wv[j].z, v0[j].w * r0 * wv[j].w) << 32);
                if (has1) o1[64 * j] = (unsigned long long)pk2(v1[j].x * r1 * wv[j].x, v1[j].y * r1 * wv[j].y) | ((unsigned long long)pk2(v1[j].z * r1 * wv[j].z, v1[j].w * r1 * wv[j].w) << 32); }
        }
    }
}

namespace pg8 {
#define PG8_LAS __attribute__((address_space(3)))
typedef unsigned short bf16_t;
typedef short bf16x8 __attribute__((ext_vector_type(8)));
typedef float f32x4 __attribute__((ext_vector_type(4)));
typedef unsigned u32x4 __attribute__((ext_vector_type(4)));
constexpr int BM = 256, BK = 64, HALF = 128, HTB = HALF * BK * 2  , STAGE_BYTES = 8 * HTB, NXCD = 8, WGM = 4;

__host__ __device__ __forceinline__ int lds_byte(int r, int c) { const int st = (r >> 4) * 2 + (c >> 5), rr = r & 15, cc = c & 31, ob = rr * 64 + cc * 2; return st * 1024 + (ob ^ (((ob >> 9) & 1) << 5)); }
__host__ __device__ __forceinline__ void stage_rc(int b, int& R, int& C) { const int st = b / 1024, sb = b % 1024, swz = sb ^ (((sb >> 9) & 1) << 5); R = (st >> 1) * 16 + swz / 64; C = (st & 1) * 32 + (swz % 64) / 2; }
__host__ __device__ __forceinline__ int perm32(int rho) { const int n = rho >> 4, i = rho & 15; return 8 * (i >> 2) + 4 * n + (i & 3); }

struct Unit { int pm, pn; };
struct Gemm { const bf16_t* A; const bf16_t* Bt; int M, N, K; };

struct StaticOrder {
    int nM, nN, nwg, G, c;
    __host__ __device__ void init(int M, int N, int G_, int c_) { nM = M / BM; nN = N / BM; nwg = nM * nN; G = G_; c = c_; }
    __host__ __device__ bool next(int i, Unit& u) const {
        const long L = (long)i * G + c; if (L >= nwg) return false;
        int wgid = (int)L; { const int q = nwg / NXCD, r = nwg % NXCD, xcd = wgid % NXCD, off = wgid / NXCD; wgid = (xcd < r ? xcd * (q + 1) : r * (q + 1) + (xcd - r) * q) + off; }
        const int nig = WGM * nN, gid = wgid / nig, fm = gid * WGM, gsz = (nM - fm) < WGM ? (nM - fm) : WGM;
        u.pm = fm + ((wgid % nig) % gsz); u.pn = (wgid % nig) / gsz; return true;
    }
    __device__ __forceinline__ void a_ready(const Unit&) const {}
    __device__ __forceinline__ void done(const Unit&) const {}
};

__device__ __forceinline__ unsigned cvt_pk_bf16(float lo, float hi) { unsigned r; asm volatile("v_cvt_pk_bf16_f32 %0, %1, %2" : "=v"(r) : "v"(lo), "v"(hi)); return r; }
template <class Epi, class Sched, bool ALIGN_EPI = false, bool SP2 = false>
__device__ __forceinline__ void gemm_phase(PG8_LAS unsigned char* lds, const Gemm g, const Sched& S, const Epi& E) {
    const int tid = threadIdx.x, wid = __builtin_amdgcn_readfirstlane(tid >> 6), lane = tid & 63, wr = wid >> 2, wc = wid & 3, fr = lane & 15, fq = lane >> 4;
    const int K = g.K, nt = K / BK;
    unsigned voffA[2], voffB[2];
#pragma unroll
    for (int i = 0; i < 2; ++i) { int R, C; stage_rc(tid * 16 + i * 8192, R, C); const int Rb = Epi::PERM ? ((R & ~31) + perm32(R & 31)) : R;
        voffA[i] = (unsigned)(R * K + C) * 2u; voffB[i] = (unsigned)(Rb * K + C) * 2u; }
    const size_t kstep = (size_t)(BK * 2);
    const size_t hstep = (size_t)HALF * K * 2;
    const size_t tstep = 2 * hstep;
    const unsigned ldsw = (unsigned)wid * 1024u;
    const int aoff = lds_byte(wr * 64 + fr, fq * 8), boff = lds_byte(wc * 32 + fr, fq * 8);
#define PG8_SA(b, h) (((b) * 2 + (h)) * HTB)
#define PG8_SB(b, h) ((4 + (b) * 2 + (h)) * HTB)
#define PG8_STAGE(bufoff, gbase, voff) do { _Pragma("unroll") for (int _i = 0; _i < 2; ++_i) \
        __builtin_amdgcn_global_load_lds((const unsigned*)((const char*)(gbase) + (voff)[_i]), (PG8_LAS unsigned*)(lds + (bufoff) + ldsw + _i * 8192), 16, 0, 0); } while (0)
#define PG8_LDA(dst, b, h) do { _Pragma("unroll") for (int m = 0; m < 4; ++m) _Pragma("unroll") for (int k = 0; k < 2; ++k) dst[m][k] = *(const PG8_LAS bf16x8*)(lds + PG8_SA(b, h) + aoff + m * 2048 + k * 1024); } while (0)
#define PG8_LDB(dst, b, h) do { _Pragma("unroll") for (int n = 0; n < 2; ++n) _Pragma("unroll") for (int k = 0; k < 2; ++k) dst[n][k] = *(const PG8_LAS bf16x8*)(lds + PG8_SB(b, h) + boff + n * 2048 + k * 1024); } while (0)
#define PG8_MMA(ai, bj, At, Bt) do { __builtin_amdgcn_s_setprio(1); _Pragma("unroll") for (int m = 0; m < 4; ++m) _Pragma("unroll") for (int n = 0; n < 2; ++n) _Pragma("unroll") for (int k = 0; k < 2; ++k) \
        acc[ai][bj][m][n] = __builtin_amdgcn_mfma_f32_16x16x32_bf16(Bt[n][k], At[m][k], acc[ai][bj][m][n], 0, 0, 0); __builtin_amdgcn_s_setprio(0); } while (0)
#define PG8_WAIT_V(n) asm volatile("s_waitcnt vmcnt(" #n ")" ::: "memory")
#define PG8_WAIT_L(n) asm volatile("s_waitcnt lgkmcnt(" #n ")" ::: "memory")
#define PG8_BAR __builtin_amdgcn_s_barrier()
#define PG8_SCHED __builtin_amdgcn_sched_barrier(0)
    Unit cur, nxt; int ui = 0;
    if (!S.next(0, cur)) return;
    f32x4 acc[2][2][4][2];
#pragma unroll
    for (int a = 0; a < 2; ++a)
#pragma unroll
        for (int b = 0; b < 2; ++b)
#pragma unroll
            for (int m = 0; m < 4; ++m)
#pragma unroll
                for (int n = 0; n < 2; ++n) acc[a][b][m][n] = (f32x4){0.f, 0.f, 0.f, 0.f};
    bf16x8 At[4][2], B0[2][2], B1[2][2];
    const char* cA = (const char*)g.A + (size_t)cur.pm * tstep; const char* cB = (const char*)g.Bt + (size_t)cur.pn * tstep;
    S.a_ready(cur);
    if constexpr (SP2) {
        PG8_STAGE(PG8_SB(0, 0), cB, voffB); PG8_STAGE(PG8_SB(0, 1), cB + hstep, voffB); PG8_STAGE(PG8_SA(0, 0), cA, voffA); PG8_STAGE(PG8_SA(0, 1), cA + hstep, voffA);
        if (wr == 1) PG8_BAR;
        PG8_WAIT_V(2); PG8_BAR;
        PG8_STAGE(PG8_SB(1, 0), cB + kstep, voffB); PG8_STAGE(PG8_SA(1, 0), cA + kstep, voffA); PG8_STAGE(PG8_SB(1, 1), cB + hstep + kstep, voffB);
        PG8_WAIT_V(6); PG8_BAR;
    } else {
        PG8_STAGE(PG8_SB(0, 0), cB, voffB); PG8_STAGE(PG8_SA(0, 0), cA, voffA); PG8_STAGE(PG8_SB(0, 1), cB + hstep, voffB); PG8_STAGE(PG8_SA(0, 1), cA + hstep, voffA);
        if (wr == 1) PG8_BAR;
        PG8_WAIT_V(4); PG8_BAR;
        PG8_STAGE(PG8_SB(1, 0), cB + kstep, voffB); PG8_STAGE(PG8_SA(1, 0), cA + kstep, voffA); PG8_STAGE(PG8_SB(1, 1), cB + hstep + kstep, voffB);
        PG8_WAIT_V(6); PG8_BAR;
    }
    for (;;) {
        const bool has_next = S.next(ui + 1, nxt);
        const char* nA = has_next ? (const char*)g.A + (size_t)nxt.pm * tstep : cA; const char* nB = has_next ? (const char*)g.Bt + (size_t)nxt.pn * tstep : cB;
        for (int t = 0; t < nt; t += 2) {
            const bool last = (t == nt - 2);
            const char* a1 = cA + (size_t)(t + 1) * kstep;
            const char* a2 = last ? nA : cA + (size_t)(t + 2) * kstep; const char* b2 = last ? nB : cB + (size_t)(t + 2) * kstep;
            const char* a3 = a2 + kstep; const char* b3 = b2 + kstep;
            if (last && has_next) S.a_ready(nxt);
            if constexpr (SP2) {
            PG8_LDB(B0, 0, 0); PG8_LDB(B1, 0, 1); PG8_SCHED; PG8_LDA(At, 0, 0); PG8_STAGE(PG8_SA(1, 1), a1 + hstep, voffA);
            PG8_WAIT_V(8); PG8_WAIT_L(0); PG8_BAR; PG8_MMA(0, 0, At, B0); PG8_MMA(0, 1, At, B1); PG8_BAR; PG8_SCHED;
            PG8_LDA(At, 0, 1); PG8_STAGE(PG8_SB(0, 0), b2, voffB); PG8_STAGE(PG8_SB(0, 1), b2 + hstep, voffB); PG8_STAGE(PG8_SA(0, 0), a2, voffA);
            PG8_WAIT_V(8); PG8_WAIT_L(0); PG8_BAR; PG8_MMA(1, 0, At, B0); PG8_MMA(1, 1, At, B1); PG8_BAR; PG8_SCHED;
            PG8_LDB(B0, 1, 0); PG8_LDB(B1, 1, 1); PG8_SCHED; PG8_LDA(At, 1, 0); PG8_STAGE(PG8_SA(0, 1), a2 + hstep, voffA);
            PG8_WAIT_V(8); PG8_WAIT_L(0); PG8_BAR; PG8_MMA(0, 0, At, B0); PG8_MMA(0, 1, At, B1); PG8_BAR; PG8_SCHED;
            PG8_LDA(At, 1, 1); PG8_STAGE(PG8_SB(1, 0), b3, voffB); PG8_STAGE(PG8_SB(1, 1), b3 + hstep, voffB); PG8_STAGE(PG8_SA(1, 0), a3, voffA);
            PG8_WAIT_V(8); PG8_WAIT_L(0); PG8_BAR; PG8_MMA(1, 0, At, B0); PG8_MMA(1, 1, At, B1); PG8_BAR; PG8_SCHED;
            } else {
            PG8_LDB(B0, 0, 0); PG8_SCHED; PG8_LDA(At, 0, 0); PG8_STAGE(PG8_SA(1, 1), a1 + hstep, voffA);
            PG8_WAIT_L(8); PG8_BAR; PG8_WAIT_L(0); PG8_MMA(0, 0, At, B0); PG8_BAR; PG8_SCHED;
            PG8_LDB(B1, 0, 1); PG8_STAGE(PG8_SB(0, 0), b2, voffB);
            PG8_BAR; PG8_WAIT_L(0); PG8_MMA(0, 1, At, B1); PG8_BAR;
            PG8_LDA(At, 0, 1); PG8_STAGE(PG8_SA(0, 0), a2, voffA);
            PG8_BAR; PG8_WAIT_L(0); PG8_MMA(1, 0, At, B0); PG8_BAR; PG8_SCHED;
            PG8_STAGE(PG8_SB(0, 1), b2 + hstep, voffB);
            PG8_WAIT_V(6); PG8_BAR; PG8_MMA(1, 1, At, B1); PG8_BAR;
            PG8_LDB(B0, 1, 0); PG8_SCHED; PG8_LDA(At, 1, 0); PG8_STAGE(PG8_SA(0, 1), a2 + hstep, voffA);
            PG8_WAIT_L(8); PG8_BAR; PG8_WAIT_L(0); PG8_MMA(0, 0, At, B0); PG8_BAR; PG8_SCHED;
            PG8_LDB(B1, 1, 1); PG8_STAGE(PG8_SB(1, 0), b3, voffB);
            PG8_BAR; PG8_WAIT_L(0); PG8_MMA(0, 1, At, B1); PG8_BAR;
            PG8_LDA(At, 1, 1); PG8_STAGE(PG8_SA(1, 0), a3, voffA);
            PG8_BAR; PG8_WAIT_L(0); PG8_MMA(1, 0, At, B0); PG8_BAR; PG8_SCHED;
            PG8_STAGE(PG8_SB(1, 1), b3 + hstep, voffB);
            PG8_WAIT_V(6); PG8_BAR; PG8_MMA(1, 1, At, B1); PG8_BAR;
            }
        }
        if constexpr (ALIGN_EPI) { if (wr == 0) PG8_BAR; }
        if constexpr (!Epi::AFTER_DRAIN) { E(acc, cur, wr, wc, fr, fq); S.done(cur); }
        if (!has_next) break;
#pragma unroll
        for (int a = 0; a < 2; ++a)
#pragma unroll
            for (int b = 0; b < 2; ++b)
#pragma unroll
                for (int m = 0; m < 4; ++m)
#pragma unroll
                    for (int n = 0; n < 2; ++n) acc[a][b][m][n] = (f32x4){0.f, 0.f, 0.f, 0.f};
        cur = nxt; cA = nA; cB = nB; ++ui;
        if constexpr (ALIGN_EPI) { if (wr == 1) PG8_BAR; }
    }
    PG8_WAIT_V(0);
    if constexpr (!ALIGN_EPI) { if (wr == 0) PG8_BAR; }
    PG8_BAR;
    if constexpr (Epi::AFTER_DRAIN) { E.fused(acc, cur, wr, wc, fr, fq, lds, wid, lane); S.done(cur); }
#undef PG8_SA
#undef PG8_SB
#undef PG8_STAGE
#undef PG8_LDA
#undef PG8_LDB
#undef PG8_MMA
#undef PG8_WAIT_V
#undef PG8_WAIT_L
#undef PG8_BAR
#undef PG8_SCHED
}
}

__device__ __forceinline__ uint4 pack8(const float (&v)[8]) { uint4 w; w.x = pk2(v[0], v[1]); w.y = pk2(v[2], v[3]); w.z = pk2(v[4], v[5]); w.w = pk2(v[6], v[7]); return w; }
struct EpiIn {
    static constexpr bool PERM = true, AFTER_DRAIN = false;
    bf16* PROJ; float* HA; const float* lbp;
    template <int GRP> __device__ __forceinline__ void run(const pg8::f32x4 (&acc)[2][2][4][2], int row0, int col0, float sc) const {
#pragma unroll
        for (int bj = 0; bj < 2; ++bj) {
            float lb[8];
            if (GRP == 1) {
#pragma unroll
                for (int i = 0; i < 8; ++i) { const int j = col0 - C_HF + bj * 128 + i; lb[i] = 1.0f / (1.0f + __expf(lbp[512 + j] - lbp[j])); }
            }
#pragma unroll
            for (int ai = 0; ai < 2; ++ai)
#pragma unroll
                for (int m = 0; m < 4; ++m) { const size_t row = (size_t)(row0 + ai * 128 + m * 16);
                    float v[8];
#pragma unroll
                    for (int i = 0; i < 4; ++i) { v[i] = acc[ai][bj][m][0][i]; v[4 + i] = acc[ai][bj][m][1][i]; }
                    if (GRP == 0) {
#pragma unroll
                        for (int i = 0; i < 8; ++i) v[i] *= sc;
                    } else if (GRP == 1) {
                        float a[8];
#pragma unroll
                        for (int i = 0; i < 8; ++i) { const float ex = __expf(-fminf(fmaxf(v[i], -30.f), 30.f)); const float sig = 1.0f / (1.0f + ex), omsig = ex * sig;
                            const float f = lb[i] + (1.0f - lb[i]) * sig; a[i] = __log2f(f); v[i] = (1.0f - lb[i]) * omsig; }
                        float4* hp = (float4*)(HA + row * 512 + (col0 - C_HF) + bj * 128);
                        hp[0] = make_float4(a[0], a[1], a[2], a[3]); hp[1] = make_float4(a[4], a[5], a[6], a[7]);
                    } else if (GRP == 3) {
#pragma unroll
                        for (int i = 0; i < 8; ++i) v[i] = v[i] * __builtin_amdgcn_rcpf(1.0f + __expf(-v[i]));
                    }
                    *(uint4*)(PROJ + row * DIN + col0 + bj * 128) = pack8(v);
                    asm volatile("" ::: "memory");
                }
        }
    }
    __device__ __forceinline__ void operator()(const pg8::f32x4 (&acc)[2][2][4][2], const pg8::Unit& u, int wr, int wc, int fr, int fq) const {
        const int row0 = u.pm * 256 + wr * 64 + fr, col0 = u.pn * 256 + wc * 32 + 8 * fq, grp = u.pn >> 1;
        const float sc = (grp == 0) ? 0.08838834764831845f : ((grp == 4) ? 0.18033688011112042f : 1.0f);
        if (grp == 1) run<1>(acc, row0, col0, sc); else if (grp == 3) run<3>(acc, row0, col0, sc); else run<0>(acc, row0, col0, sc);
    }
};
struct EpiOut {
    static constexpr bool PERM = true, AFTER_DRAIN = false;
    const float* x; bf16* HB; float* PSQ;
    __device__ __forceinline__ void operator()(const pg8::f32x4 (&acc)[2][2][4][2], const pg8::Unit& u, int wr, int wc, int fr, int fq) const {
        const int row0 = u.pm * 256 + wr * 64 + fr, col0 = u.pn * 256 + wc * 32 + 8 * fq;
#pragma unroll
        for (int ai = 0; ai < 2; ++ai) {
            float4 xv[4][2][2];
#pragma unroll
            for (int m = 0; m < 4; ++m)
#pragma unroll
                for (int bj = 0; bj < 2; ++bj) { const size_t off = (size_t)(row0 + ai * 128 + m * 16) * D + col0 + bj * 128;
                    xv[m][bj][0] = *(const float4*)(x + off); xv[m][bj][1] = *(const float4*)(x + off + 4); }
#pragma unroll
            for (int m = 0; m < 4; ++m) { const size_t row = (size_t)(row0 + ai * 128 + m * 16); float ss = 0.f;
#pragma unroll
                for (int bj = 0; bj < 2; ++bj) { const size_t off = row * D + col0 + bj * 128;
                    const float4 x0 = xv[m][bj][0], x1 = xv[m][bj][1];
                    float h[8] = {x0.x + acc[ai][bj][m][0][0], x0.y + acc[ai][bj][m][0][1], x0.z + acc[ai][bj][m][0][2], x0.w + acc[ai][bj][m][0][3],
                                  x1.x + acc[ai][bj][m][1][0], x1.y + acc[ai][bj][m][1][1], x1.z + acc[ai][bj][m][1][2], x1.w + acc[ai][bj][m][1][3]};
                    *(uint4*)(HB + off) = pack8(h);
#pragma unroll
                    for (int i = 0; i < 8; ++i) ss += h[i] * h[i]; }
                ss += __shfl_xor(ss, 16); ss += __shfl_xor(ss, 32);
                if (fq == 0) PSQ[row * 16 + u.pn * 4 + wc] = ss; }
            asm volatile("" ::: "memory");
        }
    }
};
struct EpiQ {
    static constexpr bool PERM = true, AFTER_DRAIN = false;
    bf16* QH;
    __device__ __forceinline__ void operator()(const pg8::f32x4 (&acc)[2][2][4][2], const pg8::Unit& u, int wr, int wc, int fr, int fq) const {
        const int row0 = u.pm * 256 + wr * 64 + fr, col0 = u.pn * 256 + wc * 32 + 8 * fq;
#pragma unroll
        for (int ai = 0; ai < 2; ++ai)
#pragma unroll
            for (int m = 0; m < 4; ++m) { const size_t row = (size_t)(row0 + ai * 128 + m * 16);
#pragma unroll
                for (int bj = 0; bj < 2; ++bj) { float v[8];
#pragma unroll
                    for (int i = 0; i < 4; ++i) { v[i] = acc[ai][bj][m][0][i]; v[4 + i] = acc[ai][bj][m][1][i]; }
                    *(uint4*)(QH + row * 2048 + col0 + bj * 128) = pack8(v); } }
    }
};

__device__ __forceinline__ float compute_lambda(const float* dl, int lane) {
    const float sa = wave_sum(dl[lane] * dl[64 + lane]), sb = wave_sum(dl[128 + lane] * dl[192 + lane]);
    return __expf(sa) - __expf(sb) + 0.2f;
}
namespace hg {
typedef short bf16x8 __attribute__((ext_vector_type(8)));
typedef short s16x4 __attribute__((ext_vector_type(4)));
typedef float f32x4 __attribute__((ext_vector_type(4)));
typedef unsigned u32x4 __attribute__((ext_vector_type(4)));
typedef unsigned u32x2 __attribute__((ext_vector_type(2)));
typedef float f32x2 __attribute__((ext_vector_type(2)));
constexpr int QT = 0, KT = 16384, VT = 32768, AT = 49152, PT = 81920, OT = 90112, SEG = 122880, DEC = 126976;
__device__ __forceinline__ int swzA(int row) { return row & 15; }
__device__ __forceinline__ int swzB(int row) { return ((row & 3) << 1) | (((row >> 3) & 1) << 3); }
__device__ __forceinline__ int swzP(int row) { return (((row >> 1) & 1) << 1) | (((row >> 3) & 1) << 2); }
__device__ __forceinline__ s16x4 vtr(const LAS unsigned char* p) { return __builtin_bit_cast(s16x4, __builtin_amdgcn_ds_read_tr16_b64_v4i16((LAS s16x4*)p)); }
__device__ __forceinline__ bf16x8 cat(s16x4 a, s16x4 b) { return (bf16x8){a[0], a[1], a[2], a[3], b[0], b[1], b[2], b[3]}; }
__device__ __forceinline__ unsigned cvtpk(float lo, float hi) { typedef float f2 __attribute__((ext_vector_type(2))); typedef __bf16 b2 __attribute__((ext_vector_type(2))); f2 v = {lo, hi}; b2 b = __builtin_convertvector(v, b2); return __builtin_bit_cast(unsigned, b); }

__device__ __forceinline__ void hgrn_pre(Frame& F, int task) {
    LAS unsigned char* lds = (LAS unsigned char*)F.lds;
    const int tid = F.tid, lane = F.lane, w = F.wave, c16 = lane & 15, g = lane >> 4, q4 = c16 >> 2, p4 = c16 & 3;
    const int c = task & 63, h = (task >> 6) & 3, b = task >> 8;
    const size_t row0 = (size_t)b * SEQ + (size_t)c * 64;
    const int srow = tid >> 4, sch = tid & 15;
#pragma unroll
    for (int i = 0; i < 2; ++i) { const int row = srow + 32 * i; const bf16* rp = F.PROJ + (row0 + row) * DIN + h * 128 + sch * 8;
        *(LAS u32x4*)(lds + QT + row * 256 + ((sch ^ swzA(row)) << 4)) = *(const u32x4*)(rp + C_HQ);
        *(LAS u32x4*)(lds + KT + row * 256 + ((sch ^ swzB(row)) << 4)) = *(const u32x4*)(rp + C_HF);
        *(LAS u32x4*)(lds + VT + row * 256 + ((sch ^ swzB(row)) << 4)) = *(const u32x4*)(rp + C_HI); }
#pragma unroll
    for (int i = 0; i < 4; ++i) { const int p = tid + 512 * i; *(LAS u32x4*)(lds + AT + (p >> 5) * 512 + (p & 31) * 16) = *(const u32x4*)(F.HA + (row0 + (p >> 5)) * 512 + h * 128 + (p & 31) * 4); }
    __syncthreads();
    {
        const int dp = tid & 63, ts = tid >> 6, d = 2 * dp;
        const LAS float* at = (const LAS float*)(lds + AT);
        LAS float* seg = (LAS float*)(lds + SEG);
        float cs0[8], cs1[8]; float r0 = 0.f, r1 = 0.f;
#pragma unroll
        for (int tt = 0; tt < 8; ++tt) { const f32x2 a = *(const LAS f32x2*)(at + (8 * ts + tt) * 128 + d); r0 += a.x; r1 += a.y; cs0[tt] = r0; cs1[tt] = r1; }
        *(LAS f32x2*)(seg + ts * 128 + d) = (f32x2){r0, r1};
        __syncthreads();
        float off0 = 0.f, off1 = 0.f, bl0 = 0.f, bl1 = 0.f;
#pragma unroll
        for (int k = 0; k < 8; ++k) { const f32x2 s = *(const LAS f32x2*)(seg + k * 128 + d); if (k < ts) { off0 += s.x; off1 += s.y; } bl0 += s.x; bl1 += s.y; }
        if (ts == 0) *(f32x2*)(F.DECG + ((size_t)(b * 64 + c) * 4 + h) * 128 + d) = (f32x2){__builtin_amdgcn_exp2f(fmaxf(bl0, -120.f)), __builtin_amdgcn_exp2f(fmaxf(bl1, -120.f))};
#pragma unroll
        for (int tt = 0; tt < 8; ++tt) { const int t = 8 * ts + tt;
            const float x0 = (off0 + cs0[tt]) - bl0, x1 = (off1 + cs1[tt]) - bl1;
            const float eq0 = __builtin_amdgcn_exp2f(fminf(x0, 120.f)), eq1 = __builtin_amdgcn_exp2f(fminf(x1, 120.f));
            const float ek0 = __builtin_amdgcn_exp2f(fmaxf(-x0, -120.f)), ek1 = __builtin_amdgcn_exp2f(fmaxf(-x1, -120.f));
            LAS unsigned* pq = (LAS unsigned*)(lds + QT + t * 256 + (((d >> 3) ^ swzA(t)) << 4) + (d & 7) * 2);
            LAS unsigned* pk = (LAS unsigned*)(lds + KT + t * 256 + (((d >> 3) ^ swzB(t)) << 4) + (d & 7) * 2);
            const unsigned qv = *pq, kv = *pk;
            *pq = cvtpk(bflo(qv) * eq0, bfhi(qv) * eq1); *pk = cvtpk(bflo(kv) * ek0, bfhi(kv) * ek1); }
    }
    __syncthreads();
#pragma unroll
    for (int i = 0; i < 2; ++i) { const int row = srow + 32 * i; bf16* rp = F.PROJ + (row0 + row) * DIN + h * 128 + sch * 8;
        *(u32x4*)(rp + C_HQ) = *(const LAS u32x4*)(lds + QT + row * 256 + ((sch ^ swzA(row)) << 4));
        *(u32x4*)(rp + C_HF) = *(const LAS u32x4*)(lds + KT + row * 256 + ((sch ^ swzB(row)) << 4)); }
#pragma unroll
    for (int rep = 0; rep < 2; ++rep) {
        const int idx = w + 8 * rep;
        if (idx < 12) {
            int tb, sb; bool zero = false;
            if (idx == 10) { tb = 0; sb = 1; zero = true; } else if (idx == 11) { tb = 2; sb = 3; zero = true; }
            else { tb = (idx >= 6) ? 3 : (idx >= 3) ? 2 : (idx >= 1) ? 1 : 0; sb = idx - (tb * (tb + 1)) / 2; }
            f32x4 acc = (f32x4){0.f, 0.f, 0.f, 0.f};
            if (!zero) {
                const int tr = 16 * tb + c16, sr = 16 * sb + c16;
#pragma unroll
                for (int ks = 0; ks < 4; ++ks) {
                    const bf16x8 a = *(const LAS bf16x8*)(lds + QT + tr * 256 + (((4 * ks + g) ^ swzA(tr)) << 4));
                    const bf16x8 bb = *(const LAS bf16x8*)(lds + KT + sr * 256 + (((4 * ks + g) ^ swzB(sr)) << 4));
                    acc = __builtin_amdgcn_mfma_f32_16x16x32_bf16(a, bb, acc, 0, 0, 0);
                }
                if (tb == sb) {
#pragma unroll
                    for (int r = 0; r < 4; ++r) if (c16 > 4 * g + r) acc[r] = 0.f;
                }
            }
            const int s = 16 * sb + c16;
            u32x2 pk; pk.x = cvtpk(acc[0], acc[1]); pk.y = cvtpk(acc[2], acc[3]);
            *(LAS u32x2*)(lds + PT + s * 128 + (((2 * tb + (g >> 1)) ^ swzP(s)) << 4) + (g & 1) * 8) = pk;
        }
    }
    __syncthreads();
    bf16x8 Vf[2];
#pragma unroll
    for (int ks2 = 0; ks2 < 2; ++ks2) {
        const int r0 = 32 * ks2 + 8 * g + q4, r1 = r0 + 4;
        Vf[ks2] = cat(vtr(lds + VT + r0 * 256 + (((2 * w + (p4 >> 1)) ^ swzB(r0)) << 4) + (p4 & 1) * 8), vtr(lds + VT + r1 * 256 + (((2 * w + (p4 >> 1)) ^ swzB(r1)) << 4) + (p4 & 1) * 8));
    }
    LAS float* ot = (LAS float*)(lds + OT);
#pragma unroll
    for (int tb = 0; tb < 4; ++tb) {
        f32x4 O = (f32x4){0.f, 0.f, 0.f, 0.f};
#pragma unroll
        for (int ks2 = 0; ks2 < 2; ++ks2) {
            if (ks2 <= (tb >> 1)) {
                const int r0 = 32 * ks2 + 8 * g + q4, r1 = r0 + 4;
                const s16x4 lo = vtr(lds + PT + r0 * 128 + (((2 * tb + (p4 >> 1)) ^ swzP(r0)) << 4) + (p4 & 1) * 8);
                const s16x4 hh = vtr(lds + PT + r1 * 128 + (((2 * tb + (p4 >> 1)) ^ swzP(r1)) << 4) + (p4 & 1) * 8);
                O = __builtin_amdgcn_mfma_f32_16x16x32_bf16(cat(lo, hh), Vf[ks2], O, 0, 0, 0);
            }
        }
#pragma unroll
        for (int r = 0; r < 4; ++r) ot[(16 * tb + 4 * g + r) * 128 + 16 * w + c16] = O[r];
    }
    __syncthreads();
#pragma unroll
    for (int i = 0; i < 4; ++i) { const int p = tid + 512 * i; *(u32x4*)(F.HO + (row0 + (p >> 5)) * 512 + h * 128 + (p & 31) * 4) = *(const LAS u32x4*)(lds + OT + (p >> 5) * 512 + (p & 31) * 16); }
    __syncthreads();
}

__device__ __forceinline__ void hgrn_scan(Frame& F, int b, int h) {
    LAS unsigned char* lds = (LAS unsigned char*)F.lds;
    const int tid = F.tid, lane = F.lane, w = F.wave;
    const size_t row0 = (size_t)b * SEQ;
    f32x4 S[8];
#pragma unroll
    for (int i = 0; i < 8; ++i) S[i] = (f32x4){0.f, 0.f, 0.f, 0.f};
    u32x4 sq[2], sk[2], sv[2], so[4], sgn[2]; float sdec = 0.f;
    const int srow = tid >> 4, sch = tid & 15;
    float hw[8];
    { const float4 a = *(const float4*)(F.hnw + sch * 8), bq = *(const float4*)(F.hnw + sch * 8 + 4); hw[0] = a.x; hw[1] = a.y; hw[2] = a.z; hw[3] = a.w; hw[4] = bq.x; hw[5] = bq.y; hw[6] = bq.z; hw[7] = bq.w; }
#define HG_LOAD(c) do { _Pragma("unroll") for (int i = 0; i < 2; ++i) { const bf16* rp = F.PROJ + (row0 + (size_t)(c) * 64 + srow + 32 * i) * DIN + h * 128 + sch * 8; \
        sq[i] = *(const u32x4*)(rp + C_HQ); sk[i] = *(const u32x4*)(rp + C_HF); sv[i] = *(const u32x4*)(rp + C_HI); sgn[i] = *(const u32x4*)(rp + C_HG); } \
    _Pragma("unroll") for (int i = 0; i < 4; ++i) { const int p = tid + 512 * i; so[i] = *(const u32x4*)(F.HO + (row0 + (size_t)(c) * 64 + (p >> 5)) * 512 + h * 128 + (p & 31) * 4); } \
    if (tid < 128) sdec = F.DECG[((size_t)(b * 64 + (c)) * 4 + h) * 128 + tid]; } while (0)
    HG_LOAD(0);
    for (int c = 0; c < SEQ / 64; ++c) {
        int lz = lane; asm volatile("" : "+v"(lz));
        const int c16 = lz & 15, g = lz >> 4, q4 = c16 >> 2, p4 = c16 & 3;
        u32x4 sgt[2]; sgt[0] = sgn[0]; sgt[1] = sgn[1];
#pragma unroll
        for (int i = 0; i < 2; ++i) { const int row = srow + 32 * i;
            *(LAS u32x4*)(lds + QT + row * 256 + ((sch ^ swzA(row)) << 4)) = sq[i];
            *(LAS u32x4*)(lds + KT + row * 256 + ((sch ^ swzB(row)) << 4)) = sk[i];
            *(LAS u32x4*)(lds + VT + row * 256 + ((sch ^ swzB(row)) << 4)) = sv[i]; }
#pragma unroll
        for (int i = 0; i < 4; ++i) { const int p = tid + 512 * i; *(LAS u32x4*)(lds + OT + (p >> 5) * 512 + (p & 31) * 16) = so[i]; }
        if (tid < 128) ((LAS float*)(lds + DEC))[tid] = sdec;
        __syncthreads();
        if (c + 1 < SEQ / 64) HG_LOAD(c + 1);
        bf16x8 Bf[4];
        {
            const LAS float* dec = (const LAS float*)(lds + DEC);
#pragma unroll
            for (int db = 0; db < 8; ++db) { const f32x4 dv = *(const LAS f32x4*)(dec + 16 * db + 4 * g); S[db] = S[db] * dv; }
#pragma unroll
            for (int ks = 0; ks < 4; ++ks) { u32x4 t; t.x = cvtpk(S[2 * ks][0], S[2 * ks][1]); t.y = cvtpk(S[2 * ks][2], S[2 * ks][3]); t.z = cvtpk(S[2 * ks + 1][0], S[2 * ks + 1][1]); t.w = cvtpk(S[2 * ks + 1][2], S[2 * ks + 1][3]);
                Bf[ks] = __builtin_bit_cast(bf16x8, t); }
        }
        LAS float* ot = (LAS float*)(lds + OT);
#pragma unroll
        for (int tb = 0; tb < 4; ++tb) {
            f32x4 O;
#pragma unroll
            for (int r = 0; r < 4; ++r) O[r] = ot[(16 * tb + 4 * g + r) * 128 + 16 * w + c16];
            const int tr = 16 * tb + c16;
#pragma unroll
            for (int ks = 0; ks < 4; ++ks) {
                const s16x4 lo = *(const LAS s16x4*)(lds + QT + tr * 256 + (((4 * ks + (g >> 1)) ^ swzA(tr)) << 4) + (g & 1) * 8);
                const s16x4 hh = *(const LAS s16x4*)(lds + QT + tr * 256 + (((4 * ks + 2 + (g >> 1)) ^ swzA(tr)) << 4) + (g & 1) * 8);
                O = __builtin_amdgcn_mfma_f32_16x16x32_bf16(cat(lo, hh), Bf[ks], O, 0, 0, 0);
            }
#pragma unroll
            for (int r = 0; r < 4; ++r) ot[(16 * tb + 4 * g + r) * 128 + 16 * w + c16] = O[r];
        }
        bf16x8 Vf[2];
#pragma unroll
        for (int ks2 = 0; ks2 < 2; ++ks2) {
            const int r0 = 32 * ks2 + 8 * g + q4, r1 = r0 + 4;
            Vf[ks2] = cat(vtr(lds + VT + r0 * 256 + (((2 * w + (p4 >> 1)) ^ swzB(r0)) << 4) + (p4 & 1) * 8), vtr(lds + VT + r1 * 256 + (((2 * w + (p4 >> 1)) ^ swzB(r1)) << 4) + (p4 & 1) * 8));
        }
#pragma unroll
        for (int db = 0; db < 8; ++db)
#pragma unroll
            for (int ks2 = 0; ks2 < 2; ++ks2) {
                const int r0 = 32 * ks2 + 8 * g + q4, r1 = r0 + 4;
                const s16x4 lo = vtr(lds + KT + r0 * 256 + (((2 * db + (p4 >> 1)) ^ swzB(r0)) << 4) + (p4 & 1) * 8);
                const s16x4 hh = vtr(lds + KT + r1 * 256 + (((2 * db + (p4 >> 1)) ^ swzB(r1)) << 4) + (p4 & 1) * 8);
                S[db] = __builtin_amdgcn_mfma_f32_16x16x32_bf16(cat(lo, hh), Vf[ks2], S[db], 0, 0, 0);
            }
        __syncthreads();
#pragma unroll
        for (int i = 0; i < 2; ++i) { const int t = srow + 32 * i; const size_t row = row0 + (size_t)c * 64 + t;
            const f32x4 xa = *(const LAS f32x4*)(ot + t * 128 + sch * 8), xb = *(const LAS f32x4*)(ot + t * 128 + sch * 8 + 4);
            float ss = (xa[0] * xa[0] + xa[1] * xa[1]) + (xa[2] * xa[2] + xa[3] * xa[3]) + (xb[0] * xb[0] + xb[1] * xb[1]) + (xb[2] * xb[2] + xb[3] * xb[3]);
            ss += __builtin_bit_cast(float, __builtin_amdgcn_update_dpp(0, __builtin_bit_cast(int, ss), 0xB1, 0xF, 0xF, false));
            ss += __builtin_bit_cast(float, __builtin_amdgcn_update_dpp(0, __builtin_bit_cast(int, ss), 0x4E, 0xF, 0xF, false));
            ss += __builtin_bit_cast(float, __builtin_amdgcn_update_dpp(0, __builtin_bit_cast(int, ss), 0x141, 0xF, 0xF, false));
            ss += __builtin_bit_cast(float, __builtin_amdgcn_update_dpp(0, __builtin_bit_cast(int, ss), 0x140, 0xF, 0xF, false));
            const float r = 1.0f / sqrtf(ss * (1.f / 128.f) + RMS_EPS);
            const u32x4 gt = sgt[i];
            u32x4 o;
            o.x = cvtpk(xa[0] * r * hw[0] * bflo(gt.x), xa[1] * r * hw[1] * bfhi(gt.x)); o.y = cvtpk(xa[2] * r * hw[2] * bflo(gt.y), xa[3] * r * hw[3] * bfhi(gt.y));
            o.z = cvtpk(xb[0] * r * hw[4] * bflo(gt.z), xb[1] * r * hw[5] * bfhi(gt.z)); o.w = cvtpk(xb[2] * r * hw[6] * bflo(gt.w), xb[3] * r * hw[7] * bfhi(gt.w));
            *(u32x4*)(F.MIX + row * D + h * 128 + sch * 8) = o; }
        __syncthreads();
    }
#undef HG_LOAD
}
}

namespace da {
typedef short bf16x8 __attribute__((ext_vector_type(8)));
typedef short s16x4 __attribute__((ext_vector_type(4)));
typedef float f32x16 __attribute__((ext_vector_type(16)));
constexpr int V_OFF = 16384, BUF_BYTES = 32768;
__device__ __forceinline__ s16x4 vtr(const LAS unsigned char* p) { return __builtin_bit_cast(s16x4, __builtin_amdgcn_ds_read_tr16_b64_v4i16((LAS s16x4*)p)); }
__device__ __forceinline__ unsigned cvtpk(float lo, float hi) { typedef float f2 __attribute__((ext_vector_type(2))); typedef __bf16 b2 __attribute__((ext_vector_type(2))); f2 v = {lo, hi}; b2 b = __builtin_convertvector(v, b2); return __builtin_bit_cast(unsigned, b); }

__device__ __forceinline__ float max3f(float a, float b, float c) { float r; asm("v_max3_f32 %0, %1, %2, %3" : "=v"(r) : "v"(a), "v"(b), "v"(c)); return r; }
__device__ __forceinline__ float exp2_pin(float x) { float y; asm volatile("v_exp_f32_e32 %0, %1" : "=v"(y) : "v"(x)); return y; }
__device__ __forceinline__ float max2f(float a, float b) { float r; asm("v_max_f32_e32 %0, %1, %2" : "=v"(r) : "v"(a), "v"(b)); return r; }
constexpr float RESC_THR = 8.0f;
__device__ __forceinline__ void attn_unit(Frame& F, int b, int h, int qblk, float lam) {
    LAS unsigned char* lds = (LAS unsigned char*)F.lds;
    const int lane = F.lane, r32 = lane & 31, hi = lane >> 5, w = F.wave, rg = w >> 1, map = w & 1;
    const int t0 = qblk * 128 + rg * 32;
    const int ntile_blk = 2 * qblk + 2, ntile_w = 2 * qblk + (rg >> 1) + 1;
    const bf16* base = F.PROJ + (size_t)b * SEQ * DIN;
    const bf16* gk = base + (size_t)(8 * w + (lane >> 3)) * DIN + C_AK + h * 128 + (((lane & 7) ^ ((4 * w + (lane >> 4)) & 7)) * 8);
    const bf16* gv = base + (size_t)(4 * w + (lane >> 4)) * DIN + C_AV + h * 128 + (((lane & 15) ^ ((lane >> 4) << 2)) * 8);
#define DA_DMA(tile, buf) do { const size_t to_ = (size_t)(tile) * 64 * DIN; LAS unsigned char* lb_ = lds + (buf) * BUF_BYTES + w * 1024; \
        __builtin_amdgcn_global_load_lds((const unsigned*)(gk + to_), (LAS unsigned*)(lb_), 16, 0, 0); \
        __builtin_amdgcn_global_load_lds((const unsigned*)(gk + to_ + 64), (LAS unsigned*)(lb_ + 8192), 16, 0, 0); \
        __builtin_amdgcn_global_load_lds((const unsigned*)(gv + to_), (LAS unsigned*)(lb_ + V_OFF), 16, 0, 0); \
        __builtin_amdgcn_global_load_lds((const unsigned*)(gv + to_ + (size_t)32 * DIN), (LAS unsigned*)(lb_ + V_OFF + 8192), 16, 0, 0); } while (0)
    DA_DMA(0, 0); DA_DMA(1, 1);
    if (ntile_blk > 2) DA_DMA(2, 2);
    bf16x8 qr[4];
#pragma unroll
    for (int d0 = 0; d0 < 4; ++d0) qr[d0] = *(const bf16x8*)(base + (size_t)(t0 + r32) * DIN + C_AQ + h * 128 + map * 64 + 16 * d0 + 8 * hi);
    asm volatile("s_waitcnt vmcnt(0)" : "+v"(qr[0]), "+v"(qr[1]), "+v"(qr[2]), "+v"(qr[3]) :: "memory");
    f32x16 o[4], negm;
#pragma unroll
    for (int eb = 0; eb < 4; ++eb)
#pragma unroll
        for (int r = 0; r < 16; ++r) o[eb][r] = 0.f;
#pragma unroll
    for (int r = 0; r < 16; ++r) negm[r] = 0.f;
    float mref = 0.f, l = 0.f;
    const int koff = map * 8192 + r32 * 128;
    const int q4 = (lane & 15) >> 2, p4 = lane & 3, eh = (lane >> 4) & 1;
    int voff[4];
#pragma unroll
    for (int eb = 0; eb < 4; ++eb) voff[eb] = V_OFF + (4 * hi + q4) * 256 + (p4 & 1) * 8 + (((((eb ^ q4) << 2) + 2 * eh + (p4 >> 1))) << 4);
#define DA_KFRAG(slot_, d0_, half_) (*(const LAS bf16x8*)(lds + (slot_) * BUF_BYTES + koff + (half_) * (32 * 128) + ((((2 * (d0_) + hi) ^ ((r32 >> 1) & 7))) << 4)))
#define DA_ROWMAX(c0_, c1_) ({ float a_ = fmaxf(fmaxf(c0_[0], c0_[1]), c1_[0]), b_ = fmaxf(fmaxf(c0_[2], c0_[3]), c1_[1]); a_ = fmaxf(fmaxf(a_, c1_[2]), c1_[3]); \
        _Pragma("unroll") for (int r = 4; r < 16; r += 4) { a_ = fmaxf(fmaxf(a_, c0_[r]), c0_[r + 1]); b_ = fmaxf(fmaxf(b_, c0_[r + 2]), c0_[r + 3]); a_ = fmaxf(fmaxf(a_, c1_[r]), c1_[r + 1]); b_ = fmaxf(fmaxf(b_, c1_[r + 2]), c1_[r + 3]); } \
        float m_ = fmaxf(a_, b_); auto rr_ = __builtin_amdgcn_permlane32_swap(__float_as_uint(m_), __float_as_uint(m_), false, false); fmaxf(__uint_as_float(rr_[0]), __uint_as_float(rr_[1])); })
    __builtin_amdgcn_s_barrier(); asm volatile("" ::: "memory");
    f32x16 pp0 = negm, pp1 = negm;
#pragma unroll
    for (int d0 = 0; d0 < 4; ++d0) { pp0 = __builtin_amdgcn_mfma_f32_32x32x16_bf16(DA_KFRAG(0, d0, 0), qr[d0], pp0, 0, 0, 0); pp1 = __builtin_amdgcn_mfma_f32_32x32x16_bf16(DA_KFRAG(0, d0, 1), qr[d0], pp1, 0, 0, 0); }
    { const float mx = DA_ROWMAX(pp0, pp1); mref = mx;
#pragma unroll
      for (int r = 0; r < 16; ++r) { negm[r] = -mref; pp0[r] = __builtin_amdgcn_exp2f(pp0[r] - mx); pp1[r] = __builtin_amdgcn_exp2f(pp1[r] - mx); } }
    asm volatile("s_waitcnt lgkmcnt(0)" ::: "memory");
    __builtin_amdgcn_s_barrier(); asm volatile("" ::: "memory");
    for (int t = 1; t <= ntile_blk; ++t) {
        if (t + 2 < ntile_blk) DA_DMA(t + 2, (t + 2) & 3);
        const int sc = t & 3, sp = (t - 1) & 3;
        if (t <= ntile_w) {
            const bool cur = t < ntile_w;
            f32x16 c0 = negm, c1 = negm;
            bf16x8 kf[8];
#pragma unroll
            for (int d0 = 0; d0 < 4; ++d0) { kf[2 * d0] = DA_KFRAG(sc, d0, 0); kf[2 * d0 + 1] = DA_KFRAG(sc, d0, 1); }
            unsigned pw[2][2][4]; float rs = 0.f;
#pragma unroll
            for (int r = 0; r < 16; ++r) rs += pp0[r] + pp1[r];
#pragma unroll
            for (int s = 0; s < 2; ++s)
#pragma unroll
                for (int j = 0; j < 4; ++j) { pw[0][s][j] = cvtpk(pp0[8 * s + 2 * j], pp0[8 * s + 2 * j + 1]); pw[1][s][j] = cvtpk(pp1[8 * s + 2 * j], pp1[8 * s + 2 * j + 1]); }
#pragma unroll
            for (int d0 = 0; d0 < 4; ++d0) { c0 = __builtin_amdgcn_mfma_f32_32x32x16_bf16(kf[2 * d0], qr[d0], c0, 0, 0, 0); c1 = __builtin_amdgcn_mfma_f32_32x32x16_bf16(kf[2 * d0 + 1], qr[d0], c1, 0, 0, 0); }
            __builtin_amdgcn_sched_group_barrier(0x100, 8, 0); __builtin_amdgcn_sched_group_barrier(0x2, 10, 0);
#pragma unroll
            for (int i = 0; i < 8; ++i) { __builtin_amdgcn_sched_group_barrier(0x8, 1, 0); __builtin_amdgcn_sched_group_barrier(0x2, 4, 0); }
            l += rs;
            bool resc = false; float f = 1.0f;
            if (cur) {
                const float mx = DA_ROWMAX(c0, c1);
                if (__any(mx > RESC_THR)) {
                    const float dl = fmaxf(mx, 0.f); f = __builtin_amdgcn_exp2f(-dl); mref += dl; l *= f; resc = true;
#pragma unroll
                    for (int r = 0; r < 16; ++r) { c0[r] -= dl; c1[r] -= dl; negm[r] = -mref; }
                }
            }
            {
                typedef unsigned u4 __attribute__((ext_vector_type(4)));
                const LAS unsigned char* vb_ = lds + sp * BUF_BYTES;
#define DA_VA(k_) (vb_ + voff[(k_) >> 2] + (16 * ((k_) & 3)) * 256)
                s16x4 lo_a = vtr(DA_VA(0)), hh_a = vtr(DA_VA(0) + 8 * 256), lo_b = vtr(DA_VA(1)), hh_b = vtr(DA_VA(1) + 8 * 256);
#pragma unroll
                for (int k = 0; k < 16; ++k) {
                    const s16x4 lo = lo_a, hh = hh_a;
                    lo_a = lo_b; hh_a = hh_b;
                    if (k < 14) { lo_b = vtr(DA_VA(k + 2)); hh_b = vtr(DA_VA(k + 2) + 8 * 256); }
                    const bf16x8 av = {lo[0], lo[1], lo[2], lo[3], hh[0], hh[1], hh[2], hh[3]};
                    const u4 pv = {pw[(k >> 1) & 1][k & 1][0], pw[(k >> 1) & 1][k & 1][1], pw[(k >> 1) & 1][k & 1][2], pw[(k >> 1) & 1][k & 1][3]};
                    o[k >> 2] = __builtin_amdgcn_mfma_f32_32x32x16_bf16(av, __builtin_bit_cast(bf16x8, pv), o[k >> 2], 0, 0, 0);
                    if (k < 8) { c0[2 * k] = exp2_pin(c0[2 * k]); c0[2 * k + 1] = exp2_pin(c0[2 * k + 1]); }
                    else { c1[2 * (k - 8)] = exp2_pin(c1[2 * (k - 8)]); c1[2 * (k - 8) + 1] = exp2_pin(c1[2 * (k - 8) + 1]); }
                }
#undef DA_VA
            }
            if (resc) {
#pragma unroll
                for (int eb = 0; eb < 4; ++eb)
#pragma unroll
                    for (int r = 0; r < 16; ++r) o[eb][r] *= f;
            }
            pp0 = c0; pp1 = c1;
        }
        if (t + 2 < ntile_blk) asm volatile("s_waitcnt vmcnt(4)" ::: "memory"); else asm volatile("s_waitcnt vmcnt(0)" ::: "memory");
        asm volatile("s_waitcnt lgkmcnt(0)" ::: "memory");
        __builtin_amdgcn_s_barrier(); asm volatile("" ::: "memory");
    }
#undef DA_KFRAG
#undef DA_ROWMAX
#undef DA_DMA
    l += __shfl_xor(l, 32);
    const float inv = 1.0f / l;
    LAS float* X = (LAS float*)lds + rg * 4096;
    if (map == 1) {
#pragma unroll
        for (int eb = 0; eb < 4; ++eb)
#pragma unroll
            for (int r = 0; r < 16; ++r) X[(eb * 16 + r) * 64 + lane] = o[eb][r] * inv;
    }
    __syncthreads();
    if (map == 0) {
        float ss = 0.f;
#pragma unroll
        for (int eb = 0; eb < 4; ++eb)
#pragma unroll
            for (int r = 0; r < 16; ++r) { const float d = o[eb][r] * inv - lam * X[(eb * 16 + r) * 64 + lane]; o[eb][r] = d; ss += d * d; }
        ss += __shfl_xor(ss, 32);
        const float rstd = 0.8f / sqrtf(ss * (1.f / 128.f) + RMS_EPS);
        bf16* orow = F.MIX + (size_t)(b * SEQ + t0 + r32) * D + 512 + h * 128;
#pragma unroll
        for (int eb = 0; eb < 4; ++eb)
#pragma unroll
            for (int r4 = 0; r4 < 4; ++r4) { const int e0 = 32 * eb + 8 * r4 + 4 * hi; const float4 wv = *(const float4*)(F.dnw + e0);
                uint2 pk; pk.x = pk2(o[eb][4 * r4 + 0] * rstd * wv.x, o[eb][4 * r4 + 1] * rstd * wv.y); pk.y = pk2(o[eb][4 * r4 + 2] * rstd * wv.z, o[eb][4 * r4 + 3] * rstd * wv.w);
                *(uint2*)(orow + e0) = pk; }
    }
    __syncthreads();
}
__device__ __forceinline__ void attn_phase(Frame& F, unsigned* ctl, volatile LAS unsigned* MISC, int cbase = 1024) {
    const float lam = compute_lambda(F.dlam, F.lane);
    const int x = F.bid & 7;
    if (F.tid == 0) MISC[16] = atomicAdd(&ctl[cbase + 64 * x], 1u);
    __syncthreads();
    for (;;) {
        const unsigned u = MISC[16];
        __syncthreads();
        if (u >= 128u) break;
        unsigned nxt = 0u;
        if (F.tid == 0) nxt = atomicAdd(&ctl[cbase + 64 * x], 1u);
        attn_unit(F, (4 * x + (int)(u & 3)) >> 2, (int)(u & 3), 31 - (int)(u >> 2), lam);
        if (F.tid == 0) MISC[16] = nxt;
        __syncthreads();
    }
}
}

__device__ __forceinline__ float row_rstd(const float* PSQ, int t) {
    const float4* p = (const float4*)(PSQ + (size_t)t * 16);
    const float4 a = p[0], b = p[1], c = p[2], d = p[3];
    const float s = ((a.x + a.y) + (a.z + a.w)) + ((b.x + b.y) + (b.z + b.w)) + ((c.x + c.y) + (c.z + c.w)) + ((d.x + d.y) + (d.z + d.w));
    return 1.0f / sqrtf(s * (1.f / D) + RMS_EPS);
}

__device__ __forceinline__ float gelu_tanh(float z) {
    const float y = 0.7978845608028654f * (z + 0.044715f * z * z * z);
    const float th = 1.0f - 2.0f / (1.0f + __expf(2.0f * y));
    return 0.5f * z * (1.0f + th);
}
__device__ __forceinline__ void unpack8(const uint4 v, float (&f)[8]) {
    f[0] = bflo(v.x); f[1] = bfhi(v.x); f[2] = bflo(v.y); f[3] = bfhi(v.y); f[4] = bflo(v.z); f[5] = bfhi(v.z); f[6] = bflo(v.w); f[7] = bfhi(v.w);
}
namespace tk {
typedef short bf16x8 __attribute__((ext_vector_type(8)));
typedef float f32x16 __attribute__((ext_vector_type(16)));
typedef unsigned u32x4 __attribute__((ext_vector_type(4)));
constexpr int NC = 50;
constexpr int CI[NC] = {0, 0, 0, 0, 0, 0, 0, 0, 0, 0, 0, 0, 0, 0, 0, 0, 1, 1, 1, 1, 1, 1, 1, 1, 2, 2, 2, 2, 2, 3, 3, 3, 3, 4, 4, 4, 5, 5, 6, 6, 7, 7, 8, 9, 10, 11, 12, 13, 14, 15};
constexpr int CJ[NC] = {0, 1, 2, 3, 4, 5, 6, 7, 8, 9, 10, 11, 12, 13, 14, 15, 0, 1, 2, 3, 4, 5, 6, 7, 0, 1, 2, 3, 4, 0, 1, 2, 3, 0, 1, 2, 0, 1, 0, 1, 0, 1, 0, 0, 0, 0, 0, 0, 0, 0};
constexpr int SLOT_OFF = 65536;
#define TK_SORT16(A) do { int h_, l_; \
    h_ = max(A[0], A[1]); l_ = min(A[0], A[1]); A[0] = h_; A[1] = l_; \
    h_ = max(A[3], A[2]); l_ = min(A[3], A[2]); A[3] = h_; A[2] = l_; \
    h_ = max(A[4], A[5]); l_ = min(A[4], A[5]); A[4] = h_; A[5] = l_; \
    h_ = max(A[7], A[6]); l_ = min(A[7], A[6]); A[7] = h_; A[6] = l_; \
    h_ = max(A[8], A[9]); l_ = min(A[8], A[9]); A[8] = h_; A[9] = l_; \
    h_ = max(A[11], A[10]); l_ = min(A[11], A[10]); A[11] = h_; A[10] = l_; \
    h_ = max(A[12], A[13]); l_ = min(A[12], A[13]); A[12] = h_; A[13] = l_; \
    h_ = max(A[15], A[14]); l_ = min(A[15], A[14]); A[15] = h_; A[14] = l_; \
    h_ = max(A[0], A[2]); l_ = min(A[0], A[2]); A[0] = h_; A[2] = l_; \
    h_ = max(A[1], A[3]); l_ = min(A[1], A[3]); A[1] = h_; A[3] = l_; \
    h_ = max(A[6], A[4]); l_ = min(A[6], A[4]); A[6] = h_; A[4] = l_; \
    h_ = max(A[7], A[5]); l_ = min(A[7], A[5]); A[7] = h_; A[5] = l_; \
    h_ = max(A[8], A[10]); l_ = min(A[8], A[10]); A[8] = h_; A[10] = l_; \
    h_ = max(A[9], A[11]); l_ = min(A[9], A[11]); A[9] = h_; A[11] = l_; \
    h_ = max(A[14], A[12]); l_ = min(A[14], A[12]); A[14] = h_; A[12] = l_; \
    h_ = max(A[15], A[13]); l_ = min(A[15], A[13]); A[15] = h_; A[13] = l_; \
    h_ = max(A[0], A[1]); l_ = min(A[0], A[1]); A[0] = h_; A[1] = l_; \
    h_ = max(A[2], A[3]); l_ = min(A[2], A[3]); A[2] = h_; A[3] = l_; \
    h_ = max(A[5], A[4]); l_ = min(A[5], A[4]); A[5] = h_; A[4] = l_; \
    h_ = max(A[7], A[6]); l_ = min(A[7], A[6]); A[7] = h_; A[6] = l_; \
    h_ = max(A[8], A[9]); l_ = min(A[8], A[9]); A[8] = h_; A[9] = l_; \
    h_ = max(A[10], A[11]); l_ = min(A[10], A[11]); A[10] = h_; A[11] = l_; \
    h_ = max(A[13], A[12]); l_ = min(A[13], A[12]); A[13] = h_; A[12] = l_; \
    h_ = max(A[15], A[14]); l_ = min(A[15], A[14]); A[15] = h_; A[14] = l_; \
    h_ = max(A[0], A[4]); l_ = min(A[0], A[4]); A[0] = h_; A[4] = l_; \
    h_ = max(A[1], A[5]); l_ = min(A[1], A[5]); A[1] = h_; A[5] = l_; \
    h_ = max(A[2], A[6]); l_ = min(A[2], A[6]); A[2] = h_; A[6] = l_; \
    h_ = max(A[3], A[7]); l_ = min(A[3], A[7]); A[3] = h_; A[7] = l_; \
    h_ = max(A[12], A[8]); l_ = min(A[12], A[8]); A[12] = h_; A[8] = l_; \
    h_ = max(A[13], A[9]); l_ = min(A[13], A[9]); A[13] = h_; A[9] = l_; \
    h_ = max(A[14], A[10]); l_ = min(A[14], A[10]); A[14] = h_; A[10] = l_; \
    h_ = max(A[15], A[11]); l_ = min(A[15], A[11]); A[15] = h_; A[11] = l_; \
    h_ = max(A[0], A[2]); l_ = min(A[0], A[2]); A[0] = h_; A[2] = l_; \
    h_ = max(A[1], A[3]); l_ = min(A[1], A[3]); A[1] = h_; A[3] = l_; \
    h_ = max(A[4], A[6]); l_ = min(A[4], A[6]); A[4] = h_; A[6] = l_; \
    h_ = max(A[5], A[7]); l_ = min(A[5], A[7]); A[5] = h_; A[7] = l_; \
    h_ = max(A[10], A[8]); l_ = min(A[10], A[8]); A[10] = h_; A[8] = l_; \
    h_ = max(A[11], A[9]); l_ = min(A[11], A[9]); A[11] = h_; A[9] = l_; \
    h_ = max(A[14], A[12]); l_ = min(A[14], A[12]); A[14] = h_; A[12] = l_; \
    h_ = max(A[15], A[13]); l_ = min(A[15], A[13]); A[15] = h_; A[13] = l_; \
    h_ = max(A[0], A[1]); l_ = min(A[0], A[1]); A[0] = h_; A[1] = l_; \
    h_ = max(A[2], A[3]); l_ = min(A[2], A[3]); A[2] = h_; A[3] = l_; \
    h_ = max(A[4], A[5]); l_ = min(A[4], A[5]); A[4] = h_; A[5] = l_; \
    h_ = max(A[6], A[7]); l_ = min(A[6], A[7]); A[6] = h_; A[7] = l_; \
    h_ = max(A[9], A[8]); l_ = min(A[9], A[8]); A[9] = h_; A[8] = l_; \
    h_ = max(A[11], A[10]); l_ = min(A[11], A[10]); A[11] = h_; A[10] = l_; \
    h_ = max(A[13], A[12]); l_ = min(A[13], A[12]); A[13] = h_; A[12] = l_; \
    h_ = max(A[15], A[14]); l_ = min(A[15], A[14]); A[15] = h_; A[14] = l_; \
    h_ = max(A[0], A[8]); l_ = min(A[0], A[8]); A[0] = h_; A[8] = l_; \
    h_ = max(A[1], A[9]); l_ = min(A[1], A[9]); A[1] = h_; A[9] = l_; \
    h_ = max(A[2], A[10]); l_ = min(A[2], A[10]); A[2] = h_; A[10] = l_; \
    h_ = max(A[3], A[11]); l_ = min(A[3], A[11]); A[3] = h_; A[11] = l_; \
    h_ = max(A[4], A[12]); l_ = min(A[4], A[12]); A[4] = h_; A[12] = l_; \
    h_ = max(A[5], A[13]); l_ = min(A[5], A[13]); A[5] = h_; A[13] = l_; \
    h_ = max(A[6], A[14]); l_ = min(A[6], A[14]); A[6] = h_; A[14] = l_; \
    h_ = max(A[7], A[15]); l_ = min(A[7], A[15]); A[7] = h_; A[15] = l_; \
    h_ = max(A[0], A[4]); l_ = min(A[0], A[4]); A[0] = h_; A[4] = l_; \
    h_ = max(A[1], A[5]); l_ = min(A[1], A[5]); A[1] = h_; A[5] = l_; \
    h_ = max(A[2], A[6]); l_ = min(A[2], A[6]); A[2] = h_; A[6] = l_; \
    h_ = max(A[3], A[7]); l_ = min(A[3], A[7]); A[3] = h_; A[7] = l_; \
    h_ = max(A[8], A[12]); l_ = min(A[8], A[12]); A[8] = h_; A[12] = l_; \
    h_ = max(A[9], A[13]); l_ = min(A[9], A[13]); A[9] = h_; A[13] = l_; \
    h_ = max(A[10], A[14]); l_ = min(A[10], A[14]); A[10] = h_; A[14] = l_; \
    h_ = max(A[11], A[15]); l_ = min(A[11], A[15]); A[11] = h_; A[15] = l_; \
    h_ = max(A[0], A[2]); l_ = min(A[0], A[2]); A[0] = h_; A[2] = l_; \
    h_ = max(A[1], A[3]); l_ = min(A[1], A[3]); A[1] = h_; A[3] = l_; \
    h_ = max(A[4], A[6]); l_ = min(A[4], A[6]); A[4] = h_; A[6] = l_; \
    h_ = max(A[5], A[7]); l_ = min(A[5], A[7]); A[5] = h_; A[7] = l_; \
    h_ = max(A[8], A[10]); l_ = min(A[8], A[10]); A[8] = h_; A[10] = l_; \
    h_ = max(A[9], A[11]); l_ = min(A[9], A[11]); A[9] = h_; A[11] = l_; \
    h_ = max(A[12], A[14]); l_ = min(A[12], A[14]); A[12] = h_; A[14] = l_; \
    h_ = max(A[13], A[15]); l_ = min(A[13], A[15]); A[13] = h_; A[15] = l_; \
    h_ = max(A[0], A[1]); l_ = min(A[0], A[1]); A[0] = h_; A[1] = l_; \
    h_ = max(A[2], A[3]); l_ = min(A[2], A[3]); A[2] = h_; A[3] = l_; \
    h_ = max(A[4], A[5]); l_ = min(A[4], A[5]); A[4] = h_; A[5] = l_; \
    h_ = max(A[6], A[7]); l_ = min(A[6], A[7]); A[6] = h_; A[7] = l_; \
    h_ = max(A[8], A[9]); l_ = min(A[8], A[9]); A[8] = h_; A[9] = l_; \
    h_ = max(A[10], A[11]); l_ = min(A[10], A[11]); A[10] = h_; A[11] = l_; \
    h_ = max(A[12], A[13]); l_ = min(A[12], A[13]); A[12] = h_; A[13] = l_; \
    h_ = max(A[14], A[15]); l_ = min(A[14], A[15]); A[14] = h_; A[15] = l_; \
} while (0)
#define TK_MERGE16(A) do { int h_, l_; \
    h_ = max(A[0], A[8]); l_ = min(A[0], A[8]); A[0] = h_; A[8] = l_; \
    h_ = max(A[1], A[9]); l_ = min(A[1], A[9]); A[1] = h_; A[9] = l_; \
    h_ = max(A[2], A[10]); l_ = min(A[2], A[10]); A[2] = h_; A[10] = l_; \
    h_ = max(A[3], A[11]); l_ = min(A[3], A[11]); A[3] = h_; A[11] = l_; \
    h_ = max(A[4], A[12]); l_ = min(A[4], A[12]); A[4] = h_; A[12] = l_; \
    h_ = max(A[5], A[13]); l_ = min(A[5], A[13]); A[5] = h_; A[13] = l_; \
    h_ = max(A[6], A[14]); l_ = min(A[6], A[14]); A[6] = h_; A[14] = l_; \
    h_ = max(A[7], A[15]); l_ = min(A[7], A[15]); A[7] = h_; A[15] = l_; \
    h_ = max(A[0], A[4]); l_ = min(A[0], A[4]); A[0] = h_; A[4] = l_; \
    h_ = max(A[1], A[5]); l_ = min(A[1], A[5]); A[1] = h_; A[5] = l_; \
    h_ = max(A[2], A[6]); l_ = min(A[2], A[6]); A[2] = h_; A[6] = l_; \
    h_ = max(A[3], A[7]); l_ = min(A[3], A[7]); A[3] = h_; A[7] = l_; \
    h_ = max(A[8], A[12]); l_ = min(A[8], A[12]); A[8] = h_; A[12] = l_; \
    h_ = max(A[9], A[13]); l_ = min(A[9], A[13]); A[9] = h_; A[13] = l_; \
    h_ = max(A[10], A[14]); l_ = min(A[10], A[14]); A[10] = h_; A[14] = l_; \
    h_ = max(A[11], A[15]); l_ = min(A[11], A[15]); A[11] = h_; A[15] = l_; \
    h_ = max(A[0], A[2]); l_ = min(A[0], A[2]); A[0] = h_; A[2] = l_; \
    h_ = max(A[1], A[3]); l_ = min(A[1], A[3]); A[1] = h_; A[3] = l_; \
    h_ = max(A[4], A[6]); l_ = min(A[4], A[6]); A[4] = h_; A[6] = l_; \
    h_ = max(A[5], A[7]); l_ = min(A[5], A[7]); A[5] = h_; A[7] = l_; \
    h_ = max(A[8], A[10]); l_ = min(A[8], A[10]); A[8] = h_; A[10] = l_; \
    h_ = max(A[9], A[11]); l_ = min(A[9], A[11]); A[9] = h_; A[11] = l_; \
    h_ = max(A[12], A[14]); l_ = min(A[12], A[14]); A[12] = h_; A[14] = l_; \
    h_ = max(A[13], A[15]); l_ = min(A[13], A[15]); A[13] = h_; A[15] = l_; \
    h_ = max(A[0], A[1]); l_ = min(A[0], A[1]); A[0] = h_; A[1] = l_; \
    h_ = max(A[2], A[3]); l_ = min(A[2], A[3]); A[2] = h_; A[3] = l_; \
    h_ = max(A[4], A[5]); l_ = min(A[4], A[5]); A[4] = h_; A[5] = l_; \
    h_ = max(A[6], A[7]); l_ = min(A[6], A[7]); A[6] = h_; A[7] = l_; \
    h_ = max(A[8], A[9]); l_ = min(A[8], A[9]); A[8] = h_; A[9] = l_; \
    h_ = max(A[10], A[11]); l_ = min(A[10], A[11]); A[10] = h_; A[11] = l_; \
    h_ = max(A[12], A[13]); l_ = min(A[12], A[13]); A[12] = h_; A[13] = l_; \
    h_ = max(A[14], A[15]); l_ = min(A[14], A[15]); A[14] = h_; A[15] = l_; \
} while (0)

__device__ __forceinline__ int f2ord(float f) { const int b = (int)__float_as_uint(f); return b ^ (int)((unsigned)(b >> 31) >> 1); }
__device__ __forceinline__ float ord2f(int k) { return __uint_as_float((unsigned)(k ^ (int)((unsigned)(k >> 31) >> 1))); }
__device__ __forceinline__ void topk_phase(Frame& F) {
    LAS unsigned char* lds = (LAS unsigned char*)F.lds;
    const int tid = F.tid, lane = F.lane, r32 = lane & 31, hi = lane >> 5, w = F.wave;
    LAS unsigned* slots = (LAS unsigned*)(lds + SLOT_OFF + w * 8192);
    for (int u = F.bid; u < 256; u += F.G) {
        const int tile = u >> 1, hgp = u & 1;
        const int t = tile * 256 + w * 32 + r32;
        const float rl2 = row_rstd(F.PSQ, t) * 1.4426950408889634f;
        for (int hh = 0; hh < 4; ++hh) {
            const int h = hgp * 4 + hh;
            __syncthreads();
#pragma unroll
            for (int i = 0; i < 8; ++i) { const int p = tid + 512 * i, half = p >> 11, row = (p >> 4) & 127, ch = p & 15;
                const u32x4 v = *(const u32x4*)(F.SKb + ((size_t)(h * 2 + half) * 128 + row) * 128 + ch * 8);
                *(LAS u32x4*)(lds + half * 32768 + row * 256 + ((ch ^ (row & 15)) << 4)) = v; }
            __syncthreads();
            int topk[2][16];
#pragma unroll
            for (int half = 0; half < 2; ++half) {
                bf16x8 bq[8];
#pragma unroll
                for (int ks = 0; ks < 8; ++ks) bq[ks] = *(const bf16x8*)(F.QH + (size_t)t * 2048 + h * 256 + half * 128 + 16 * ks + 8 * hi);
                f32x16 s[4];
#pragma unroll
                for (int nb = 0; nb < 4; ++nb) {
#pragma unroll
                    for (int r = 0; r < 16; ++r) s[nb][r] = 0.f;
#pragma unroll
                    for (int ks = 0; ks < 8; ++ks) {
                        const bf16x8 a = *(const LAS bf16x8*)(lds + half * 32768 + (32 * nb + r32) * 256 + (((2 * ks + hi) ^ (r32 & 15)) << 4));
                        s[nb] = __builtin_amdgcn_mfma_f32_32x32x16_bf16(a, bq[ks], s[nb], 0, 0, 0);
                    }
                }
                int kk[4][16];
#pragma unroll
                for (int nb = 0; nb < 4; ++nb)
#pragma unroll
                    for (int r = 0; r < 16; ++r) { const float sv = s[nb][r]; kk[nb][r] = (f2ord(sv) & ~127) | (32 * nb + (r & 3) + 8 * (r >> 2) + 4 * hi); }
                TK_SORT16(kk[0]); TK_SORT16(kk[1]); TK_SORT16(kk[2]); TK_SORT16(kk[3]);
#pragma unroll
                for (int i = 0; i < 16; ++i) { kk[0][i] = max(kk[0][i], kk[1][15 - i]); kk[2][i] = max(kk[2][i], kk[3][15 - i]); }
                TK_MERGE16(kk[0]); TK_MERGE16(kk[2]);
#pragma unroll
                for (int i = 0; i < 16; ++i) kk[0][i] = max(kk[0][i], kk[2][15 - i]);
                TK_MERGE16(kk[0]);
#pragma unroll
                for (int i = 0; i < 16; ++i) { auto rr = __builtin_amdgcn_permlane32_swap((unsigned)kk[0][i], (unsigned)kk[0][i], false, false); kk[1][i] = (int)(hi ? rr[0] : rr[1]); }
#pragma unroll
                for (int i = 0; i < 16; ++i) kk[0][i] = max(kk[0][i], kk[1][15 - i]);
                TK_MERGE16(kk[0]);
#pragma unroll
                for (int i = 0; i < 16; ++i) topk[half][i] = kk[0][i];
            }
            float v1[16], v2[16]; unsigned i1[16], i2[16];
#pragma unroll
            for (int r = 0; r < 16; ++r) { v1[r] = ord2f(topk[0][r] & ~127); i1[r] = (unsigned)topk[0][r] & 127u; v2[r] = ord2f(topk[1][r] & ~127); i2[r] = (unsigned)topk[1][r] & 127u; }
            float cv[NC / 2]; unsigned cp[NC / 2];
#pragma unroll
            for (int c = 0; c < NC / 2; ++c) {
                const float va = v1[CI[2 * c]] + v2[CJ[2 * c]], vb = v1[CI[2 * c + 1]] + v2[CJ[2 * c + 1]];
                const unsigned pa = (i1[CI[2 * c]] << 7) | i2[CJ[2 * c]], pb = (i1[CI[2 * c + 1]] << 7) | i2[CJ[2 * c + 1]];
                cv[c] = hi ? vb : va; cp[c] = hi ? pb : pa;
            }
            float rv[16]; unsigned rp[16];
            {
                int kc[2][16];
#pragma unroll
                for (int c = 0; c < NC / 2; ++c) { kc[c >> 4][c & 15] = (f2ord(cv[c]) & ~63) | (hi << 5) | c; slots[((hi << 5) | c) * 32 + r32] = cp[c]; }
#pragma unroll
                for (int c = NC / 2; c < 32; ++c) kc[c >> 4][c & 15] = (int)0x80000000;
                TK_SORT16(kc[0]); TK_SORT16(kc[1]);
#pragma unroll
                for (int i = 0; i < 16; ++i) kc[0][i] = max(kc[0][i], kc[1][15 - i]);
                TK_MERGE16(kc[0]);
#pragma unroll
                for (int i = 0; i < 16; ++i) { auto rr = __builtin_amdgcn_permlane32_swap((unsigned)kc[0][i], (unsigned)kc[0][i], false, false); kc[1][i] = (int)(hi ? rr[0] : rr[1]); }
#pragma unroll
                for (int i = 0; i < 16; ++i) kc[0][i] = max(kc[0][i], kc[1][15 - i]);
                TK_MERGE16(kc[0]);
#pragma unroll
                for (int r = 0; r < 16; ++r) { rv[r] = ord2f(kc[0][r] & ~63); rp[r] = slots[(kc[0][r] & 63) * 32 + r32]; }
            }
            float sum = 0.f; const float mx0 = rv[0];
#pragma unroll
            for (int r = 0; r < 16; ++r) rv[r] = __builtin_amdgcn_exp2f((rv[r] - mx0) * rl2);
#pragma unroll
            for (int r = 0; r < 16; ++r) sum += rv[r];
            const float inv = 1.0f / sum;
            if (hi == 0) {
                int4* ip = (int4*)(F.IDX + (size_t)t * 128 + h * 16); float4* gp = (float4*)(F.GW + (size_t)t * 128 + h * 16);
#pragma unroll
                for (int q = 0; q < 4; ++q) { ip[q] = make_int4((int)rp[4 * q], (int)rp[4 * q + 1], (int)rp[4 * q + 2], (int)rp[4 * q + 3]);
                    gp[q] = make_float4(rv[4 * q] * inv, rv[4 * q + 1] * inv, rv[4 * q + 2] * inv, rv[4 * q + 3] * inv); }
            }
        }
    }
    __syncthreads();
}
}

namespace peer {
typedef __bf16 bf2 __attribute__((ext_vector_type(2)));
typedef unsigned u32x4 __attribute__((ext_vector_type(4)));
template <int CTRL, int RM> __device__ __forceinline__ float dpp_add(float v) {
    return v + __builtin_bit_cast(float, __builtin_amdgcn_update_dpp(0, __builtin_bit_cast(int, v), CTRL, RM, 0xF, false));
}
__device__ __forceinline__ float wave_total(float v) {
    v = dpp_add<0xB1, 0xF>(v); v = dpp_add<0x4E, 0xF>(v); v = dpp_add<0x141, 0xF>(v); v = dpp_add<0x140, 0xF>(v);
    v = dpp_add<0x142, 0xA>(v); v = dpp_add<0x143, 0xC>(v);
    return __builtin_bit_cast(float, __builtin_amdgcn_readlane(__builtin_bit_cast(int, v), 63));
}
__device__ __forceinline__ float dot2(unsigned a, unsigned b, float c) { return __builtin_amdgcn_fdot2_f32_bf16(__builtin_bit_cast(bf2, a), __builtin_bit_cast(bf2, b), c, false); }
__device__ __forceinline__ float dot8(const u32x4 a, const u32x4 b, float c) { c = dot2(a.x, b.x, c); c = dot2(a.y, b.y, c); c = dot2(a.z, b.z, c); return dot2(a.w, b.w, c); }

__device__ __forceinline__ int wave_isum(int v) {
    v += __builtin_amdgcn_update_dpp(0, v, 0xB1, 0xF, 0xF, false); v += __builtin_amdgcn_update_dpp(0, v, 0x4E, 0xF, 0xF, false);
    v += __builtin_amdgcn_update_dpp(0, v, 0x141, 0xF, 0xF, false); v += __builtin_amdgcn_update_dpp(0, v, 0x140, 0xF, 0xF, false);
    v += __builtin_amdgcn_update_dpp(0, v, 0x142, 0xA, 0xF, false); v += __builtin_amdgcn_update_dpp(0, v, 0x143, 0xC, 0xF, false);
    return __builtin_amdgcn_readlane(v, 63);
}
constexpr int TPW = 8, SLSH = 9;
constexpr int UGRP = 1;
constexpr int VGRP = 2;
constexpr int PW_BYTES = 17440, PW_LIST = 0, PW_XQ = 8192, PW_CNT = 16416;
static_assert(NWAVES * PW_BYTES <= MISC_OFF, "PEER LDS map");
template <int CTRL, int RM> __device__ __forceinline__ int dpp_iadd(int v) { return v + __builtin_amdgcn_update_dpp(0, v, CTRL, RM, 0xF, false); }
template <int CTRL, int RM> __device__ __forceinline__ unsigned dpp_umax(unsigned v) { const unsigned t = (unsigned)__builtin_amdgcn_update_dpp(0, (int)v, CTRL, RM, 0xF, false); return v > t ? v : t; }
__device__ __forceinline__ float wave_max_pos(float f) {
    unsigned v = __float_as_uint(f);
    v = dpp_umax<0xB1, 0xF>(v); v = dpp_umax<0x4E, 0xF>(v); v = dpp_umax<0x141, 0xF>(v); v = dpp_umax<0x140, 0xF>(v); v = dpp_umax<0x142, 0xA>(v); v = dpp_umax<0x143, 0xC>(v);
    return __uint_as_float((unsigned)__builtin_amdgcn_readlane((int)v, 63));
}
__device__ __forceinline__ unsigned long long read_entry(const LAS unsigned char* pw, int j, int p) {
    const int idx = p < 128 ? p : 127;
    return *(const LAS unsigned long long*)(pw + PW_LIST + (j * 128 + idx) * 8);
}
__device__ __forceinline__ int utok(int lane) { return ((lane >> 5) & 1) | (((lane >> 4) & 1) << 1) | (((lane >> 3) & 1) << 2); }
struct UGroup { u32x4 u[TPW]; unsigned long long ent; float us, vs; };
template <int EMASK> __device__ __forceinline__ void issue_ug(Frame& F, UGroup& G, const LAS unsigned char* pw, int p, int lane) {
    const int idx = p < 128 ? p : 127;
    G.ent = *(const LAS unsigned long long*)(pw + PW_LIST + (utok(lane) * 128 + idx) * 8);
    const unsigned ev = (unsigned)G.ent & (unsigned)EMASK;
    typedef float f32x2 __attribute__((ext_vector_type(2)));
    const f32x2 sc = *(const f32x2*)(F.US + 2 * (size_t)ev);
    G.us = sc.x; G.vs = sc.y;
#pragma unroll
    for (int j = 0; j < TPW; ++j) { const unsigned e = (unsigned)__builtin_amdgcn_readlane((int)ev, 32 * (j & 1) + 16 * ((j >> 1) & 1) + 8 * ((j >> 2) & 1)); G.u[j] = *(const u32x4*)(F.U8 + (size_t)e * D + 16 * lane); }
}
__device__ __forceinline__ void compute_ug(const UGroup& G, const u32x4 (&xq)[TPW], LAS unsigned char* pw, int p, int lane, float sxrv) {
    int d[TPW];
#pragma unroll
    for (int j = 0; j < TPW; ++j) {
        d[j] = __builtin_amdgcn_sdot4((int)G.u[j].x, (int)xq[j].x, 0, false); d[j] = __builtin_amdgcn_sdot4((int)G.u[j].y, (int)xq[j].y, d[j], false);
        d[j] = __builtin_amdgcn_sdot4((int)G.u[j].z, (int)xq[j].z, d[j], false); d[j] = __builtin_amdgcn_sdot4((int)G.u[j].w, (int)xq[j].w, d[j], false); }
    int m4[4], m2[2];
#pragma unroll
    for (int i = 0; i < 4; ++i) { auto rr = __builtin_amdgcn_permlane32_swap((unsigned)d[2 * i], (unsigned)d[2 * i + 1], false, false); m4[i] = (int)rr[0] + (int)rr[1]; }
#pragma unroll
    for (int i = 0; i < 2; ++i) { auto rr = __builtin_amdgcn_permlane16_swap((unsigned)m4[2 * i], (unsigned)m4[2 * i + 1], false, false); m2[i] = (int)rr[0] + (int)rr[1]; }
    const int ra = m2[0] + __builtin_amdgcn_update_dpp(0, m2[0], 0x128, 0xF, 0xF, false), rb = m2[1] + __builtin_amdgcn_update_dpp(0, m2[1], 0x128, 0xF, 0xF, false);
    int dv = (lane & 8) ? rb : ra;
    dv = dpp_iadd<0xB1, 0xF>(dv); dv = dpp_iadd<0x4E, 0xF>(dv); dv = dpp_iadd<0x141, 0xF>(dv);
    const float z = (float)dv * G.us * sxrv;
    const float y2 = -2.3022082f * (z + 0.044715f * z * z * z);
    const float cw = __uint_as_float((unsigned)(G.ent >> 32)) * G.vs * z * __builtin_amdgcn_rcpf(1.0f + __builtin_amdgcn_exp2f(y2));
    const int pp = p < 128 ? p : 127;
    if ((lane & 7) == 0) *(LAS float*)(pw + PW_LIST + (utok(lane) * 128 + pp) * 8 + 4) = cw;
}
#define PEER_ACC(A, cw, vv) do { \
    A[0] += cw * (float)(vv.x & 0xff); A[1] += cw * (float)((vv.x >> 8) & 0xff); A[2] += cw * (float)((vv.x >> 16) & 0xff); A[3] += cw * (float)(vv.x >> 24); \
    A[4] += cw * (float)(vv.y & 0xff); A[5] += cw * (float)((vv.y >> 8) & 0xff); A[6] += cw * (float)((vv.y >> 16) & 0xff); A[7] += cw * (float)(vv.y >> 24); \
    A[8] += cw * (float)(vv.z & 0xff); A[9] += cw * (float)((vv.z >> 8) & 0xff); A[10] += cw * (float)((vv.z >> 16) & 0xff); A[11] += cw * (float)(vv.z >> 24); \
    A[12] += cw * (float)(vv.w & 0xff); A[13] += cw * (float)((vv.w >> 8) & 0xff); A[14] += cw * (float)((vv.w >> 16) & 0xff); A[15] += cw * (float)(vv.w >> 24); } while (0)
template <int EMASK, int MODE> __device__ __forceinline__ void peer_phase_t(Frame& F, float* outp, const XcdBarrier& bar) {
    const int gw = F.bid * NWAVES + F.wave, NGW = F.G * NWAVES, lane = F.lane;
    LAS unsigned char* pw = (LAS unsigned char*)F.lds + F.wave * PW_BYTES;
    LAS unsigned* cnt = (LAS unsigned*)(pw + PW_CNT);
    const int rounds = (T / TPW + NGW - 1) / NGW;
    for (int rd = 0; rd < rounds; ++rd) {
        const int wt = gw + rd * NGW; const bool live = wt < T / TPW;
        if (rd) xcd_barrier_light(bar);
        const int t0 = (live ? wt : gw) * TPW;
        u32x4 xq[TPW]; float sxrv;
        {
            int lq = lane; asm volatile("" : "+v"(lq));
            uint4 hA[TPW], hB[TPW]; int id0[TPW], id1[TPW]; float g0[TPW], g1[TPW];
#pragma unroll
            for (int j = 0; j < TPW; ++j) { const size_t t = (size_t)(t0 + j);
                hA[j] = *(const uint4*)(F.HB + t * D + 16 * lq); hB[j] = *(const uint4*)(F.HB + t * D + 16 * lq + 8);
                id0[j] = F.IDX[t * 128 + lq]; id1[j] = F.IDX[t * 128 + 64 + lq]; g0[j] = F.GW[t * 128 + lq]; g1[j] = F.GW[t * 128 + 64 + lq]; }
            const float rstd = row_rstd(F.PSQ, t0 + utok(lq));
            *(LAS u32x4*)(pw + PW_CNT + 16 * lq) = u32x4{0u, 0u, 0u, 0u};
            float msel = 0.f;
#pragma unroll
            for (int j = 0; j < TPW; ++j) {
                float x[16];
                { float xa[8], xb[8]; unpack8(hA[j], xa); unpack8(hB[j], xb);
#pragma unroll
                  for (int i = 0; i < 8; ++i) { x[i] = xa[i]; x[8 + i] = xb[i]; } }
                float m = 0.f;
#pragma unroll
                for (int i = 0; i < 16; ++i) m = fmaxf(m, fabsf(x[i]));
                m = wave_max_pos(m);
                const float inv = m > 0.f ? 127.0f * __builtin_amdgcn_rcpf(m) : 0.f;
                int qi[16];
#pragma unroll
                for (int i = 0; i < 16; ++i) qi[i] = (int)rintf(x[i] * inv) & 0xff;
                xq[j].x = (unsigned)qi[0] | ((unsigned)qi[1] << 8) | ((unsigned)qi[2] << 16) | ((unsigned)qi[3] << 24); xq[j].y = (unsigned)qi[4] | ((unsigned)qi[5] << 8) | ((unsigned)qi[6] << 16) | ((unsigned)qi[7] << 24);
                xq[j].z = (unsigned)qi[8] | ((unsigned)qi[9] << 8) | ((unsigned)qi[10] << 16) | ((unsigned)qi[11] << 24); xq[j].w = (unsigned)qi[12] | ((unsigned)qi[13] << 8) | ((unsigned)qi[14] << 16) | ((unsigned)qi[15] << 24);
                msel = (utok(lq) == j) ? m : msel;
            }
            sxrv = msel * (1.0f / 127.0f) * rstd;
            asm volatile("s_waitcnt lgkmcnt(0)" ::: "memory");
            unsigned r0[TPW], r1[TPW];
#pragma unroll
            for (int j = 0; j < TPW; ++j) {
                r0[j] = __hip_atomic_fetch_add(cnt + j * 32 + (id0[j] >> SLSH), 1u, __ATOMIC_RELAXED, __HIP_MEMORY_SCOPE_WORKGROUP);
                r1[j] = __hip_atomic_fetch_add(cnt + j * 32 + (id1[j] >> SLSH), 1u, __ATOMIC_RELAXED, __HIP_MEMORY_SCOPE_WORKGROUP); }
            asm volatile("s_waitcnt lgkmcnt(0)" ::: "memory");
#pragma unroll
            for (int j = 0; j < TPW; ++j) {
                const int own = lq < 32 ? (int)cnt[j * 32 + lq] : 0; int c = own;
                c = dpp_iadd<0x111, 0xF>(c); c = dpp_iadd<0x112, 0xF>(c); c = dpp_iadd<0x114, 0xF>(c); c = dpp_iadd<0x118, 0xF>(c); c = dpp_iadd<0x142, 0xA>(c);
                if (lq < 32) cnt[j * 32 + lq] = (unsigned)(c - own); }
            asm volatile("s_waitcnt lgkmcnt(0)" ::: "memory");
#pragma unroll
            for (int j = 0; j < TPW; ++j) {
                const unsigned p0 = cnt[j * 32 + (id0[j] >> SLSH)] + r0[j], p1 = cnt[j * 32 + (id1[j] >> SLSH)] + r1[j];
                *(LAS unsigned long long*)(pw + PW_LIST + (j * 128 + p0) * 8) = (unsigned long long)(unsigned)id0[j] | ((unsigned long long)__float_as_uint(g0[j]) << 32);
                *(LAS unsigned long long*)(pw + PW_LIST + (j * 128 + p1) * 8) = (unsigned long long)(unsigned)id1[j] | ((unsigned long long)__float_as_uint(g1[j]) << 32); }
            asm volatile("s_waitcnt lgkmcnt(0)" ::: "memory");
        }
        {
            UGroup G[UGRP];
#pragma unroll
            for (int q = 0; q < UGRP; ++q) issue_ug<EMASK>(F, G[q], pw, q, lane);
            for (int p = 0; p < 128; p += UGRP) {
                if (p == 64) xcd_barrier_light(bar);
#pragma unroll
                for (int q = 0; q < UGRP; ++q) { compute_ug(G[q], xq, pw, p + q, lane, sxrv); issue_ug<EMASK>(F, G[q], pw, p + UGRP + q, lane); }
            }
        }
        asm volatile("s_waitcnt lgkmcnt(0)" ::: "memory");
        xcd_barrier_light(bar);
        float stok[TPW];
        int lc = lane; asm volatile("" : "+v"(lc));
#pragma unroll
        for (int j = 0; j < TPW; ++j) {
            const unsigned long long a0 = *(const LAS unsigned long long*)(pw + PW_LIST + (j * 128 + lc) * 8), a1 = *(const LAS unsigned long long*)(pw + PW_LIST + (j * 128 + 64 + lc) * 8);
            const float c0 = __uint_as_float((unsigned)(a0 >> 32)), c1 = __uint_as_float((unsigned)(a1 >> 32));
            const float m = wave_max_pos(fmaxf(fabsf(c0), fabsf(c1)));
            const float sc = m > 0.f ? 127.0f * __builtin_amdgcn_rcpf(m) : 0.f;
            stok[j] = m * (1.0f / 127.0f);
            *(LAS unsigned short*)(pw + PW_XQ + (j * 128 + lc) * 2) = (unsigned short)(unsigned)a0; *(LAS unsigned short*)(pw + PW_XQ + (j * 128 + 64 + lc) * 2) = (unsigned short)(unsigned)a1;
            *(LAS signed char*)(pw + PW_XQ + 2048 + j * 128 + lc) = (signed char)(int)rintf(c0 * sc); *(LAS signed char*)(pw + PW_XQ + 2048 + j * 128 + 64 + lc) = (signed char)(int)rintf(c1 * sc);
        }
        asm volatile("s_waitcnt lgkmcnt(0)" ::: "memory");
        int acc[TPW][16];
#pragma unroll
        for (int j = 0; j < TPW; ++j)
#pragma unroll
            for (int i = 0; i < 16; ++i) acc[j][i] = 0;
        {
            struct VG4 { u32x4 r[4]; int cw4; };
            VG4 S[VGRP];
#define PEER_VISSUE(S_, j_, gp_) do { const int g_ = (gp_) < 32 ? (gp_) : 31; \
                const unsigned long long ev_ = *(const LAS unsigned long long*)(pw + PW_XQ + ((j_) * 128 + 4 * g_) * 2); \
                const unsigned s0_ = (unsigned)__builtin_amdgcn_readfirstlane((int)(unsigned)ev_), s1_ = (unsigned)__builtin_amdgcn_readfirstlane((int)(unsigned)(ev_ >> 32)); \
                (S_).cw4 = __builtin_amdgcn_readfirstlane(*(const LAS int*)(pw + PW_XQ + 2048 + (j_) * 128 + 4 * g_)); \
                (S_).r[0] = *(const u32x4*)(F.V8 + (size_t)((s0_ & 0xffffu) & (unsigned)EMASK) * D + 16 * lane); (S_).r[1] = *(const u32x4*)(F.V8 + (size_t)((s0_ >> 16) & (unsigned)EMASK) * D + 16 * lane); \
                (S_).r[2] = *(const u32x4*)(F.V8 + (size_t)((s1_ & 0xffffu) & (unsigned)EMASK) * D + 16 * lane); (S_).r[3] = *(const u32x4*)(F.V8 + (size_t)((s1_ >> 16) & (unsigned)EMASK) * D + 16 * lane); } while (0)
#define PEER_VTR(A_, i_, a0_, a1_, a2_, a3_, cw_) do { \
                const unsigned x01l_ = __builtin_amdgcn_perm(a1_, a0_, 0x05010400u), x01h_ = __builtin_amdgcn_perm(a1_, a0_, 0x07030602u); \
                const unsigned x23l_ = __builtin_amdgcn_perm(a3_, a2_, 0x05010400u), x23h_ = __builtin_amdgcn_perm(a3_, a2_, 0x07030602u); \
                A_[4 * (i_) + 0] = __builtin_amdgcn_sdot4((int)__builtin_amdgcn_perm(x23l_, x01l_, 0x05040100u), cw_, A_[4 * (i_) + 0], false); \
                A_[4 * (i_) + 1] = __builtin_amdgcn_sdot4((int)__builtin_amdgcn_perm(x23l_, x01l_, 0x07060302u), cw_, A_[4 * (i_) + 1], false); \
                A_[4 * (i_) + 2] = __builtin_amdgcn_sdot4((int)__builtin_amdgcn_perm(x23h_, x01h_, 0x05040100u), cw_, A_[4 * (i_) + 2], false); \
                A_[4 * (i_) + 3] = __builtin_amdgcn_sdot4((int)__builtin_amdgcn_perm(x23h_, x01h_, 0x07060302u), cw_, A_[4 * (i_) + 3], false); } while (0)
#pragma unroll
            for (int n = 0; n < VGRP; ++n) PEER_VISSUE(S[n], n % TPW, n / TPW);
            for (int gp = 0; gp < 32; ++gp) {
                if (gp == 16) xcd_barrier_light(bar);
#pragma unroll
                for (int j = 0; j < TPW; ++j) {
                    VG4& G = S[j % VGRP];
                    PEER_VTR(acc[j], 0, G.r[0].x, G.r[1].x, G.r[2].x, G.r[3].x, G.cw4); PEER_VTR(acc[j], 1, G.r[0].y, G.r[1].y, G.r[2].y, G.r[3].y, G.cw4);
                    PEER_VTR(acc[j], 2, G.r[0].z, G.r[1].z, G.r[2].z, G.r[3].z, G.cw4); PEER_VTR(acc[j], 3, G.r[0].w, G.r[1].w, G.r[2].w, G.r[3].w, G.cw4);
                    PEER_VISSUE(G, (j + VGRP) % TPW, gp + (j + VGRP) / TPW);
                }
            }
#undef PEER_VISSUE
#undef PEER_VTR
        }
#pragma unroll
        for (int j = 0; j < TPW; ++j) {
            float* orow = outp + (size_t)(t0 + j) * D + 16 * lane;
            float y[16]; float ss = 0.f;
            { float ha[8], hb[8]; unpack8(*(const uint4*)(F.HB + (size_t)(t0 + j) * D + 16 * lane), ha); unpack8(*(const uint4*)(F.HB + (size_t)(t0 + j) * D + 16 * lane + 8), hb);
#pragma unroll
              for (int i = 0; i < 8; ++i) { y[i] = ha[i] + stok[j] * (float)acc[j][i]; y[8 + i] = hb[i] + stok[j] * (float)acc[j][8 + i]; } }
#pragma unroll
            for (int i = 0; i < 16; ++i) ss += y[i] * y[i];
            const float r = 1.0f / sqrtf(wave_total(ss) * (1.f / D) + RMS_EPS);
#pragma unroll
            for (int q = 0; q < 4; ++q) { const float4 wv = *(const float4*)(F.nfin + 16 * lane + 4 * q);
                *(float4*)(orow + 4 * q) = make_float4(y[4 * q] * r * wv.x, y[4 * q + 1] * r * wv.y, y[4 * q + 2] * r * wv.z, y[4 * q + 3] * r * wv.w); }
        }
        asm volatile("s_waitcnt lgkmcnt(0)" ::: "memory");
    }
}
}

constexpr int N_PHASES = 11;
__global__ void __launch_bounds__(NTHREADS, 2) mk_fwd(Args args) {
    extern __shared__ __attribute__((aligned(16))) unsigned char lds[];
    Frame F;
    F.lds = lds;
    F.tid = threadIdx.x; F.lane = F.tid & 63; F.wave = __builtin_amdgcn_readfirstlane(F.tid >> 6);
    F.G = gridDim.x; F.bid = blockIdx.x;
    F.x = args.in[0]; F.nmw = args.in[1]; F.w_in = args.in[2]; F.lbp = args.in[3]; F.hnw = args.in[4]; F.dlam = args.in[5]; F.dnw = args.in[6];
    F.w_out = args.in[7]; F.nfw = args.in[8]; F.wq = args.in[9]; F.sk = args.in[10]; F.u = args.in[11]; F.v = args.in[12]; F.nfin = args.in[13];
    F.out = args.out;
    unsigned char* ws = args.ws;
    F.WinT = (bf16*)(ws + WS_WIN); F.WoT = (bf16*)(ws + WS_WO); F.WqT = (bf16*)(ws + WS_WQ); F.SKb = (bf16*)(ws + WS_SK);
    F.XN = (bf16*)(ws + WS_XN); F.MIX = (bf16*)(ws + WS_MIX);
    F.PROJ = (bf16*)(ws + WS_PROJ); F.HB = (bf16*)(ws + WS_HB); F.QH = (bf16*)(ws + WS_QH);
    F.HA = (float*)(ws + WS_HA); F.HO = (float*)(ws + WS_HO); F.PSQ = (float*)(ws + WS_PSQ); F.GW = (float*)(ws + WS_G);
    F.IDX = (int*)(ws + WS_IDX); F.DECG = (float*)(ws + WS_DECG);
    F.U8 = ws + WS_U8; F.V8 = ws + WS_V8; F.US = (float*)(ws + WS_US);
    const int lo = args.ph_lo, hi = args.ph_hi;
    volatile LAS unsigned* MISC = (volatile LAS unsigned*)((LAS unsigned char*)lds + MISC_OFF);
    if (F.tid < 32) MISC[F.tid] = 0u;
    __syncthreads();
    XcdBarrier bar; bar.bar = (unsigned*)(ws + WS_CTL) + 4096; bar.x = 0; bar.st = nullptr;
    if (hi - lo > 1) bar = xcd_barrier_post((unsigned*)(ws + WS_CTL) + 4096, MISC + 8);
#define IN(k) (lo <= (k) && (k) < hi)
#define SEAM(k) do { if (IN(k) && IN((k) + 1)) xcd_barrier(bar); } while (0)
    if (IN(0)) { stage_prep(F);
    }
    SEAM(0);
    if (IN(1)) { pg8::Gemm g{F.XN, F.WinT, T, DIN, D}; pg8::StaticOrder S; S.init(T, DIN, F.G, F.bid); EpiIn E{F.PROJ, F.HA, F.lbp};
        pg8::gemm_phase<EpiIn, pg8::StaticOrder, true, true>((PG8_LAS unsigned char*)lds, g, S, E); }
    if (IN(1) && IN(3)) xcd_barrier(bar);
    if (IN(3)) for (int task = F.bid; task < BATCH * 4 * 64; task += F.G) hg::hgrn_pre(F, task);
    if (IN(3) && IN(4)) xcd_barrier(bar);
    if (IN(4)) { for (int unit = F.bid; unit < 32; unit += F.G) hg::hgrn_scan(F, unit >> 2, unit & 3);
        da::attn_phase(F, (unsigned*)(ws + WS_CTL), MISC);
    }
    SEAM(5);
    if (IN(6)) { pg8::Gemm g{F.MIX, F.WoT, T, D, D}; pg8::StaticOrder S; S.init(T, D, F.G, F.bid); EpiOut E{F.x, F.HB, F.PSQ};
        pg8::gemm_phase<EpiOut, pg8::StaticOrder, true, true>((PG8_LAS unsigned char*)lds, g, S, E); }
    if (IN(6) && IN(8)) xcd_barrier(bar);
    if (IN(8)) { pg8::Gemm g{F.HB, F.WqT, T, 2048, D}; pg8::StaticOrder S; S.init(T, 2048, F.G, F.bid); EpiQ E{F.QH};
        pg8::gemm_phase<EpiQ, pg8::StaticOrder, true, true>((PG8_LAS unsigned char*)lds, g, S, E); }
    SEAM(8);
    if (IN(9)) tk::topk_phase(F);
    SEAM(9);
    if (IN(10)) { peer::peer_phase_t<0xffff, 0>(F, F.out, bar);
    }
#undef IN
#undef SEAM
}

extern "C" void kernel_launch(void* const* d_in, const int* in_sizes, int n_in, void* d_out, int out_size, void* d_ws, size_t ws_size, hipStream_t stream) {
    static int grid = 0;
    if (grid == 0) {
        if (n_in != 14 || in_sizes[0] != T * D || out_size != T * D || ws_size < WS_END) {
            fprintf(stderr, "kernel_launch: unexpected shapes: n_in %d in0 %d out %d ws %zu (need %zu)\n", n_in, n_in > 0 ? in_sizes[0] : -1, out_size, ws_size, (size_t)WS_END);
            grid = -1; return; }
        int dev = 0, cus = 0;
        if (hipGetDevice(&dev) != hipSuccess || hipDeviceGetAttribute(&cus, hipDeviceAttributeMultiprocessorCount, dev) != hipSuccess) { grid = -1; return; }
        if (hipFuncSetAttribute((const void*)mk_fwd, hipFuncAttributeMaxDynamicSharedMemorySize, LDS_BYTES) != hipSuccess) { fprintf(stderr, "kernel_launch: hipFuncSetAttribute failed\n"); grid = -1; return; }
        int per_cu = 0;
        if (hipOccupancyMaxActiveBlocksPerMultiprocessor(&per_cu, (const void*)mk_fwd, NTHREADS, LDS_BYTES) != hipSuccess || per_cu < 1) {
            fprintf(stderr, "kernel_launch: the occupancy query reports %d workgroups per CU for %d threads / %d B of LDS; nothing launched\n", per_cu, NTHREADS, LDS_BYTES); grid = -1; return; }
        (void)hipGetLastError();
        grid = cus;
    }
    if (grid < 0) return;
    Args a{};
    for (int i = 0; i < 14; ++i) a.in[i] = (const float*)d_in[i];
    a.out = (float*)d_out; a.ws = (unsigned char*)d_ws;
    if (hipMemsetAsync((char*)d_ws + WS_CTL, 0, 64 * 1024, stream) != hipSuccess) { fprintf(stderr, "kernel_launch: memset failed\n"); return; }
    a.ph_lo = 0; a.ph_hi = N_PHASES;
    hipLaunchKernelGGL(mk_fwd, dim3(grid), dim3(NTHREADS), LDS_BYTES, stream, a);
}
```

```cpp
#include <hip/hip_runtime.h>
#include <cstdio>
#include <cstdint>

constexpr int BATCH = 8, SEQ = 4096, T = BATCH * SEQ, D = 1024, DIN = 3584;
constexpr int NEXP = 16384;
constexpr float RMS_EPS = 1e-6f;
constexpr int NWAVES = 8, NTHREADS = NWAVES * 64;

constexpr int C_HQ = 0, C_HF = 512, C_HI = 1024, C_HG = 1536, C_AQ = 2048, C_AK = 2560, C_AV = 3072;

constexpr size_t MiB = 1u << 20;
constexpr size_t WS_CTL = 0;
constexpr size_t WS_WIN = 2 * MiB;
constexpr size_t WS_WO = 9 * MiB;
constexpr size_t WS_WQ = 11 * MiB;
constexpr size_t WS_SK = 15 * MiB;
constexpr size_t WS_U8 = 16 * MiB;
constexpr size_t WS_V8 = 32 * MiB;
constexpr size_t WS_US = 48 * MiB;
constexpr size_t WS_XN = 80 * MiB;
constexpr size_t WS_MIX = 80 * MiB;
constexpr size_t WS_PROJ = 144 * MiB;
constexpr size_t WS_HA = 368 * MiB;
constexpr size_t WS_HO = 432 * MiB;
constexpr size_t WS_PSQ = 496 * MiB;
constexpr size_t WS_HB = 144 * MiB;
constexpr size_t WS_QH = 208 * MiB;
constexpr size_t WS_IDX = 336 * MiB;
constexpr size_t WS_G = 352 * MiB;
constexpr size_t WS_DECG = 498 * MiB;
constexpr size_t WS_END = 499 * MiB;

constexpr int LDS_BYTES = 147456;
constexpr int MISC_OFF = 139520 + 64;

typedef unsigned short bf16;
#define LAS __attribute__((address_space(3)))

__device__ __forceinline__ unsigned f2bf(float f) { unsigned u = __builtin_bit_cast(unsigned, f); return (u + 0x7fffu + ((u >> 16) & 1u)) >> 16; }
__device__ __forceinline__ unsigned pk2(float lo, float hi) { return f2bf(lo) | (f2bf(hi) << 16); }
__device__ __forceinline__ float bf2f(unsigned b) { return __builtin_bit_cast(float, b << 16); }
__device__ __forceinline__ float bflo(unsigned w) { return __builtin_bit_cast(float, w << 16); }
__device__ __forceinline__ float bfhi(unsigned w) { return __builtin_bit_cast(float, w & 0xffff0000u); }
__device__ __forceinline__ float wave_sum(float v) {
#pragma unroll
    for (int o = 1; o < 64; o <<= 1) v += __shfl_xor(v, o);
    return v;
}


#define GAS __attribute__((address_space(1)))
typedef GAS unsigned gu32;
#define RLX_AGENT __ATOMIC_RELAXED, __HIP_MEMORY_SCOPE_AGENT
#define XB_TMO      128
#define XB_XCNT(j)  (256  + 64 * (j))
#define XB_XSUB(j)  (1280 + 64 * (j))
#define XB_XGEN(j)  (2304 + 64 * (j))
#define XB_TOP      3328
#define XB_TOPGEN   3392
#define XCD_BAR_WORDS 3456
#define XB_SPIN_CAP (1u << 22)
__device__ __forceinline__ unsigned xb_ld(unsigned* p)              { return __hip_atomic_load(p, __ATOMIC_RELAXED, __HIP_MEMORY_SCOPE_AGENT); }
__device__ __forceinline__ unsigned xb_add(unsigned* p, unsigned v) { return __hip_atomic_fetch_add(p, v, __ATOMIC_RELAXED, __HIP_MEMORY_SCOPE_AGENT); }
__device__ __forceinline__ unsigned xb_xcc_id() { return (unsigned)__builtin_amdgcn_s_getreg((3 << 11) | 20) & 0xFu; }
#define XB_SPIN(cond, bar) do { unsigned _sp = 0; while (cond) { __builtin_amdgcn_s_sleep(1); \
    if ((++_sp & 255u) == 0u) { if (xb_ld(&(bar)[XB_TMO])) break; if (_sp > XB_SPIN_CAP) { atomicAdd(&(bar)[XB_TMO], 1u); break; } } } } while (0)
struct XcdBarrier { unsigned* bar; unsigned x; volatile LAS unsigned* st; };
__device__ __forceinline__ XcdBarrier xcd_barrier_post(unsigned* bar, volatile LAS unsigned* st) {
    XcdBarrier b; b.bar = bar; b.x = xb_xcc_id(); b.st = st;
    if (threadIdx.x == 0) (void)xb_add(&bar[XB_XCNT(b.x)], 1u);
    return b;
}
__device__ __forceinline__ void xcd_barrier_complete(unsigned* bar, unsigned x, unsigned& nloc, unsigned& nx) {
    const unsigned G = gridDim.x * gridDim.y * gridDim.z;
    unsigned sum, cnt, mine, sp = 0u;
    for (;;) {
        sum = 0u; cnt = 0u; mine = 0u;
#pragma unroll
        for (unsigned j = 0; j < 16; ++j) { const unsigned c = xb_ld(&bar[XB_XCNT(j)]); sum += c; cnt += (c > 0u) ? 1u : 0u; mine = (j == x) ? c : mine; }
        if (sum == G) break;
        __builtin_amdgcn_s_sleep(1);
        if ((++sp & 255u) == 0u) { if (xb_ld(&bar[XB_TMO])) break; if (sp > XB_SPIN_CAP) { atomicAdd(&bar[XB_TMO], 1u); break; } }
    }
    nloc = mine > 0u ? mine : 1u; nx = cnt > 0u ? cnt : 1u;
}
__device__ __forceinline__ void xcd_barrier(const XcdBarrier& b) {
    asm volatile("s_waitcnt vmcnt(0)" ::: "memory");
    __syncthreads();
    if (threadIdx.x == 0) {
        unsigned* bar = b.bar;
        __builtin_amdgcn_s_waitcnt(0);
        unsigned nloc = b.st[0], nx = b.st[1];
        if (nloc == 0u) { xcd_barrier_complete(bar, b.x, nloc, nx); b.st[0] = nloc; b.st[1] = nx; }
        const unsigned old = xb_add(&bar[XB_XSUB(b.x)], 1u);
        const unsigned gen = old / nloc;
        if (old + 1u == (gen + 1u) * nloc) {
            __builtin_amdgcn_fence(__ATOMIC_RELEASE, "agent");
            asm volatile("s_waitcnt vmcnt(0)" ::: "memory");
            const unsigned og = xb_add(&bar[XB_TOP], 1u);
            const unsigned tg = og / nx;
            if (og + 1u == (tg + 1u) * nx) xb_add(&bar[XB_TOPGEN], 1u);
            else XB_SPIN(xb_ld(&bar[XB_TOPGEN]) == tg, bar);
            __builtin_amdgcn_fence(__ATOMIC_ACQUIRE, "agent");
            xb_add(&bar[XB_XGEN(b.x)], 1u);
            asm volatile("s_waitcnt vmcnt(0)" ::: "memory");
        } else {
            XB_SPIN(xb_ld(&bar[XB_XGEN(b.x)]) == gen, bar);
            __builtin_amdgcn_fence(__ATOMIC_ACQUIRE, "agent");
            asm volatile("s_waitcnt vmcnt(0)" ::: "memory");
        }
    }
    __syncthreads();
}

__device__ __forceinline__ void xcd_barrier_light(const XcdBarrier& b) {
    __syncthreads();
    if (threadIdx.x == 0) {
        unsigned* bar = b.bar;
        unsigned nloc = b.st[0], nx = b.st[1];
        if (nloc == 0u) { xcd_barrier_complete(bar, b.x, nloc, nx); b.st[0] = nloc; b.st[1] = nx; }
        const unsigned old = xb_add(&bar[XB_XSUB(b.x)], 1u);
        const unsigned gen = old / nloc;
        if (old + 1u == (gen + 1u) * nloc) {
            const unsigned og = xb_add(&bar[XB_TOP], 1u);
            const unsigned tg = og / nx;
            if (og + 1u == (tg + 1u) * nx) xb_add(&bar[XB_TOPGEN], 1u);
            else XB_SPIN(xb_ld(&bar[XB_TOPGEN]) == tg, bar);
            xb_add(&bar[XB_XGEN(b.x)], 1u);
        } else {
            XB_SPIN(xb_ld(&bar[XB_XGEN(b.x)]) == gen, bar);
        }
    }
    __syncthreads();
}

__device__ __forceinline__ void xcd_barrier_local(const XcdBarrier& b) {
    __syncthreads();
    if (threadIdx.x == 0) {
        unsigned* bar = b.bar;
        unsigned nloc = b.st[0], nx = b.st[1];
        if (nloc == 0u) { xcd_barrier_complete(bar, b.x, nloc, nx); b.st[0] = nloc; b.st[1] = nx; }
        const unsigned old = xb_add(&bar[XB_XSUB(b.x)], 1u);
        const unsigned gen = old / nloc;
        if (old + 1u == (gen + 1u) * nloc) xb_add(&bar[XB_XGEN(b.x)], 1u);
        else XB_SPIN(xb_ld(&bar[XB_XGEN(b.x)]) == gen, bar);
    }
    __syncthreads();
}

struct Args { const float* in[14]; float* out; unsigned char* ws; int ph_lo, ph_hi; };

struct Frame {
    unsigned char* lds;
    int tid, lane, wave, G, bid;
    const float *x, *nmw, *w_in, *lbp, *hnw, *dlam, *dnw, *w_out, *nfw, *wq, *sk, *u, *v, *nfin;
    float* out;
    bf16 *WinT, *WoT, *WqT, *SKb, *XN, *MIX, *PROJ, *HB, *QH;
    float *HA, *HO, *PSQ, *GW, *US, *DECG;
    int* IDX;
    unsigned char *U8, *V8;
};

__device__ __forceinline__ void transpose_item(const float* W, const float* scale, int K, int N, bf16* WT, float* scr, int item, int lane) {
    const int nblk = N / 32, kb = item / nblk, nb = item % nblk, k0 = 64 * kb, n0 = 32 * nb;
#pragma unroll 8
    for (int i = 0; i < 32; ++i) { const int kk = 2 * i + (lane >> 5); float s = scale ? scale[k0 + kk] : 1.0f; scr[kk * 33 + (lane & 31)] = W[(size_t)(k0 + kk) * N + n0 + (lane & 31)] * s; }
    __builtin_amdgcn_s_waitcnt(0xc07f); asm volatile("" ::: "memory");
    const int c = lane & 7;
#pragma unroll
    for (int j = 0; j < 4; ++j) { const int n = (lane >> 3) + 8 * j; const float* s = scr + (8 * c) * 33 + n;
        uint4 o; o.x = pk2(s[0 * 33], s[1 * 33]); o.y = pk2(s[2 * 33], s[3 * 33]); o.z = pk2(s[4 * 33], s[5 * 33]); o.w = pk2(s[6 * 33], s[7 * 33]);
        *(uint4*)(WT + (size_t)(n0 + n) * K + k0 + 8 * c) = o; }
    __builtin_amdgcn_s_waitcnt(0xc07f); asm volatile("" ::: "memory");
}

__device__ __forceinline__ void stage_prep(Frame& F, const int parts = 7) {
    float* scr = (float*)(F.lds + F.wave * 16384);
    const int gw = F.bid * NWAVES + F.wave, NGW = F.G * NWAVES;
    constexpr int I_IN = (D / 64) * (DIN / 32), I_O = (D / 64) * (D / 32), I_Q = (D / 64) * (2048 / 32);
    if (parts & 1) for (int it = gw; it < I_IN + I_O + I_Q; it += NGW) {
        int r = it;
        if (r < I_IN) { transpose_item(F.w_in, nullptr, D, DIN, F.WinT, scr, r, F.lane); continue; } r -= I_IN;
        if (r < I_O) { transpose_item(F.w_out, nullptr, D, D, F.WoT, scr, r, F.lane); continue; } r -= I_O;
        transpose_item(F.wq, F.nfw, D, 2048, F.WqT, scr, r, F.lane);
    }
    const size_t gt = (size_t)F.bid * NTHREADS + F.tid, NGT = (size_t)F.G * NTHREADS;
    if (parts & 2) for (int e = gw; e < NEXP; e += NGW) {
        const float4* ur = (const float4*)(F.u + (size_t)e * D) + F.lane; const float4* vr = (const float4*)(F.v + (size_t)e * D) + F.lane; const float4* wr = (const float4*)F.nfw + F.lane;
        float4 a[4], b[4]; float mu = 0.f, mv = 0.f;
#pragma unroll
        for (int j = 0; j < 4; ++j) { const float4 w = wr[64 * j]; a[j] = ur[64 * j]; b[j] = vr[64 * j]; a[j].x *= w.x; a[j].y *= w.y; a[j].z *= w.z; a[j].w *= w.w;
            mu = fmaxf(mu, fmaxf(fmaxf(fabsf(a[j].x), fabsf(a[j].y)), fmaxf(fabsf(a[j].z), fabsf(a[j].w))));
            mv = fmaxf(mv, fmaxf(fmaxf(fabsf(b[j].x), fabsf(b[j].y)), fmaxf(fabsf(b[j].z), fabsf(b[j].w)))); }
#pragma unroll
        for (int o = 1; o < 64; o <<= 1) { mu = fmaxf(mu, __shfl_xor(mu, o)); mv = fmaxf(mv, __shfl_xor(mv, o)); }
        const float iu = mu > 0.f ? 127.0f / mu : 0.f, iv = mv > 0.f ? 127.0f / mv : 0.f;
        unsigned* u8 = (unsigned*)(F.U8 + (size_t)e * D) + F.lane; unsigned* v8 = (unsigned*)(F.V8 + (size_t)e * D) + F.lane;
#pragma unroll
        for (int j = 0; j < 4; ++j) {
            const int q0 = (int)rintf(a[j].x * iu), q1 = (int)rintf(a[j].y * iu), q2 = (int)rintf(a[j].z * iu), q3 = (int)rintf(a[j].w * iu);
            u8[64 * j] = (unsigned)(q0 & 0xff) | ((unsigned)(q1 & 0xff) << 8) | ((unsigned)(q2 & 0xff) << 16) | ((unsigned)(q3 & 0xff) << 24);
            const int p0 = (int)rintf(b[j].x * iv), p1 = (int)rintf(b[j].y * iv), p2 = (int)rintf(b[j].z * iv), p3 = (int)rintf(b[j].w * iv);
            v8[64 * j] = (unsigned)(p0 & 0xff) | ((unsigned)(p1 & 0xff) << 8) | ((unsigned)(p2 & 0xff) << 16) | ((unsigned)(p3 & 0xff) << 24); }
        if (F.lane == 0) { F.US[2 * e] = mu * (1.0f / 127.0f); F.US[2 * e + 1] = mv * (1.0f / 127.0f); }
    }
    if (parts & 2) for (size_t i = gt; i < (size_t)8 * 2 * 128 * 128 / 8; i += NGT) {
        const float4 c = *(const float4*)(F.sk + i * 8), d = *(const float4*)(F.sk + i * 8 + 4);
        uint4 p; p.x = pk2(c.x, c.y); p.y = pk2(c.z, c.w); p.z = pk2(d.x, d.y); p.w = pk2(d.z, d.w);
        *(uint4*)(F.SKb + i * 8) = p;
    }
    if (parts & 4) {
        float4 wv[4];
#pragma unroll
        for (int j = 0; j < 4; ++j) wv[j] = ((const float4*)F.nmw)[F.lane + 64 * j];
        for (int m = gw; m < T; m += 2 * NGW) {
            const int m1 = m + NGW; const bool has1 = m1 < T;
            const float4* xr0 = (const float4*)(F.x + (size_t)m * D) + F.lane; const float4* xr1 = (const float4*)(F.x + (size_t)(has1 ? m1 : m) * D) + F.lane;
            float4 v0[4], v1[4]; float s0 = 0.f, s1 = 0.f;
#pragma unroll
            for (int j = 0; j < 4; ++j) { v0[j] = xr0[64 * j]; v1[j] = xr1[64 * j]; }
#pragma unroll
            for (int j = 0; j < 4; ++j) { s0 += (v0[j].x * v0[j].x + v0[j].y * v0[j].y) + (v0[j].z * v0[j].z + v0[j].w * v0[j].w); s1 += (v1[j].x * v1[j].x + v1[j].y * v1[j].y) + (v1[j].z * v1[j].z + v1[j].w * v1[j].w); }
#pragma unroll
            for (int o = 1; o < 64; o <<= 1) { s0 += __shfl_xor(s0, o); s1 += __shfl_xor(s1, o); }
            const float r0 = 1.0f / sqrtf(s0 * (1.f / D) + RMS_EPS), r1 = 1.0f / sqrtf(s1 * (1.f / D) + RMS_EPS);
            unsigned long long* o0 = (unsigned long long*)(F.XN + (size_t)m * D) + F.lane; unsigned long long* o1 = (unsigned long long*)(F.XN + (size_t)m1 * D) + F.lane;
#pragma unroll
            for (int j = 0; j < 4; ++j) {
                o0[64 * j] = (unsigned long long)pk2(v0[j].x * r0 * wv[j].x, v0[j].y * r0 * wv[j].y) | ((unsigned long long)pk2(v0[j].z * r0 * wv[j].z, v0[j].w * r0 * wv[j].w) << 32);
                if (has1) o1[64 * j] = (unsigned long long)pk2(v1[j].x * r1 * wv[j].x, v1[j].y * r1 * wv[j].y) | ((unsigned long long)pk2(v1[j].z * r1 * wv[j].z, v1[j].w * r1 * wv[j].w) << 32); }
        }
    }
}

namespace pg8 {
#define PG8_LAS __attribute__((address_space(3)))
typedef unsigned short bf16_t;
typedef short bf16x8 __attribute__((ext_vector_type(8)));
typedef float f32x4 __attribute__((ext_vector_type(4)));
typedef unsigned u32x4 __attribute__((ext_vector_type(4)));
constexpr int BM = 256, BK = 64, HALF = 128, HTB = HALF * BK * 2  , STAGE_BYTES = 8 * HTB, NXCD = 8, WGM = 4;

__host__ __device__ __forceinline__ int lds_byte(int r, int c) { const int st = (r >> 4) * 2 + (c >> 5), rr = r & 15, cc = c & 31, ob = rr * 64 + cc * 2; return st * 1024 + (ob ^ (((ob >> 9) & 1) << 5)); }
__host__ __device__ __forceinline__ void stage_rc(int b, int& R, int& C) { const int st = b / 1024, sb = b % 1024, swz = sb ^ (((sb >> 9) & 1) << 5); R = (st >> 1) * 16 + swz / 64; C = (st & 1) * 32 + (swz % 64) / 2; }
__host__ __device__ __forceinline__ int perm32(int rho) { const int n = rho >> 4, i = rho & 15; return 8 * (i >> 2) + 4 * n + (i & 3); }

struct Unit { int pm, pn; };
struct Gemm { const bf16_t* A; const bf16_t* Bt; int M, N, K; };

struct StaticOrder {
    int nM, nN, nwg, G, c;
    __host__ __device__ void init(int M, int N, int G_, int c_) { nM = M / BM; nN = N / BM; nwg = nM * nN; G = G_; c = c_; }
    __host__ __device__ bool next(int i, Unit& u) const {
        const long L = (long)i * G + c; if (L >= nwg) return false;
        int wgid = (int)L; { const int q = nwg / NXCD, r = nwg % NXCD, xcd = wgid % NXCD, off = wgid / NXCD; wgid = (xcd < r ? xcd * (q + 1) : r * (q + 1) + (xcd - r) * q) + off; }
        const int nig = WGM * nN, gid = wgid / nig, fm = gid * WGM, gsz = (nM - fm) < WGM ? (nM - fm) : WGM;
        u.pm = fm + ((wgid % nig) % gsz); u.pn = (wgid % nig) / gsz; return true;
    }
    __device__ __forceinline__ void a_ready(const Unit&) const {}
    __device__ __forceinline__ void done(const Unit&) const {}
};

__device__ __forceinline__ unsigned cvt_pk_bf16(float lo, float hi) { unsigned r; asm volatile("v_cvt_pk_bf16_f32 %0, %1, %2" : "=v"(r) : "v"(lo), "v"(hi)); return r; }
template <class Epi, class Sched, bool ALIGN_EPI = false, bool SP2 = false>
__device__ __forceinline__ void gemm_phase(PG8_LAS unsigned char* lds, const Gemm g, const Sched& S, const Epi& E) {
    const int tid = threadIdx.x, wid = __builtin_amdgcn_readfirstlane(tid >> 6), lane = tid & 63, wr = wid >> 2, wc = wid & 3, fr = lane & 15, fq = lane >> 4;
    const int K = g.K, nt = K / BK;
    unsigned voffA[2], voffB[2];
#pragma unroll
    for (int i = 0; i < 2; ++i) { int R, C; stage_rc(tid * 16 + i * 8192, R, C); const int Rb = Epi::PERM ? ((R & ~31) + perm32(R & 31)) : R;
        voffA[i] = (unsigned)(R * K + C) * 2u; voffB[i] = (unsigned)(Rb * K + C) * 2u; }
    const size_t kstep = (size_t)(BK * 2);
    const size_t hstep = (size_t)HALF * K * 2;
    const size_t tstep = 2 * hstep;
    const unsigned ldsw = (unsigned)wid * 1024u;
    const int aoff = lds_byte(wr * 64 + fr, fq * 8), boff = lds_byte(wc * 32 + fr, fq * 8);
#define PG8_SA(b, h) (((b) * 2 + (h)) * HTB)
#define PG8_SB(b, h) ((4 + (b) * 2 + (h)) * HTB)
#define PG8_STAGE(bufoff, gbase, voff) do { _Pragma("unroll") for (int _i = 0; _i < 2; ++_i) \
        __builtin_amdgcn_global_load_lds((const unsigned*)((const char*)(gbase) + (voff)[_i]), (PG8_LAS unsigned*)(lds + (bufoff) + ldsw + _i * 8192), 16, 0, 0); } while (0)
#define PG8_LDA(dst, b, h) do { _Pragma("unroll") for (int m = 0; m < 4; ++m) _Pragma("unroll") for (int k = 0; k < 2; ++k) dst[m][k] = *(const PG8_LAS bf16x8*)(lds + PG8_SA(b, h) + aoff + m * 2048 + k * 1024); } while (0)
#define PG8_LDB(dst, b, h) do { _Pragma("unroll") for (int n = 0; n < 2; ++n) _Pragma("unroll") for (int k = 0; k < 2; ++k) dst[n][k] = *(const PG8_LAS bf16x8*)(lds + PG8_SB(b, h) + boff + n * 2048 + k * 1024); } while (0)
#define PG8_MMA(ai, bj, At, Bt) do { __builtin_amdgcn_s_setprio(1); _Pragma("unroll") for (int m = 0; m < 4; ++m) _Pragma("unroll") for (int n = 0; n < 2; ++n) _Pragma("unroll") for (int k = 0; k < 2; ++k) \
        acc[ai][bj][m][n] = __builtin_amdgcn_mfma_f32_16x16x32_bf16(Bt[n][k], At[m][k], acc[ai][bj][m][n], 0, 0, 0); __builtin_amdgcn_s_setprio(0); } while (0)
#define PG8_WAIT_V(n) asm volatile("s_waitcnt vmcnt(" #n ")" ::: "memory")
#define PG8_WAIT_L(n) asm volatile("s_waitcnt lgkmcnt(" #n ")" ::: "memory")
#define PG8_BAR __builtin_amdgcn_s_barrier()
#define PG8_SCHED __builtin_amdgcn_sched_barrier(0)
    Unit cur, nxt; int ui = 0;
    if (!S.next(0, cur)) return;
    f32x4 acc[2][2][4][2];
#pragma unroll
    for (int a = 0; a < 2; ++a)
#pragma unroll
        for (int b = 0; b < 2; ++b)
#pragma unroll
            for (int m = 0; m < 4; ++m)
#pragma unroll
                for (int n = 0; n < 2; ++n) acc[a][b][m][n] = (f32x4){0.f, 0.f, 0.f, 0.f};
    bf16x8 At[4][2], B0[2][2], B1[2][2];
    const char* cA = (const char*)g.A + (size_t)cur.pm * tstep; const char* cB = (const char*)g.Bt + (size_t)cur.pn * tstep;
    S.a_ready(cur);
    if constexpr (SP2) {
        PG8_STAGE(PG8_SB(0, 0), cB, voffB); PG8_STAGE(PG8_SB(0, 1), cB + hstep, voffB); PG8_STAGE(PG8_SA(0, 0), cA, voffA); PG8_STAGE(PG8_SA(0, 1), cA + hstep, voffA);
        if (wr == 1) PG8_BAR;
        PG8_WAIT_V(2); PG8_BAR;
        PG8_STAGE(PG8_SB(1, 0), cB + kstep, voffB); PG8_STAGE(PG8_SA(1, 0), cA + kstep, voffA); PG8_STAGE(PG8_SB(1, 1), cB + hstep + kstep, voffB);
        PG8_WAIT_V(6); PG8_BAR;
    } else {
        PG8_STAGE(PG8_SB(0, 0), cB, voffB); PG8_STAGE(PG8_SA(0, 0), cA, voffA); PG8_STAGE(PG8_SB(0, 1), cB + hstep, voffB); PG8_STAGE(PG8_SA(0, 1), cA + hstep, voffA);
        if (wr == 1) PG8_BAR;
        PG8_WAIT_V(4); PG8_BAR;
        PG8_STAGE(PG8_SB(1, 0), cB + kstep, voffB); PG8_STAGE(PG8_SA(1, 0), cA + kstep, voffA); PG8_STAGE(PG8_SB(1, 1), cB + hstep + kstep, voffB);
        PG8_WAIT_V(6); PG8_BAR;
    }
    for (;;) {
        const bool has_next = S.next(ui + 1, nxt);
        const char* nA = has_next ? (const char*)g.A + (size_t)nxt.pm * tstep : cA; const char* nB = has_next ? (const char*)g.Bt + (size_t)nxt.pn * tstep : cB;
        for (int t = 0; t < nt; t += 2) {
            const bool last = (t == nt - 2);
            const char* a1 = cA + (size_t)(t + 1) * kstep;
            const char* a2 = last ? nA : cA + (size_t)(t + 2) * kstep; const char* b2 = last ? nB : cB + (size_t)(t + 2) * kstep;
            const char* a3 = a2 + kstep; const char* b3 = b2 + kstep;
            if (last && has_next) S.a_ready(nxt);
            if constexpr (SP2) {
            PG8_LDB(B0, 0, 0); PG8_LDB(B1, 0, 1); PG8_SCHED; PG8_LDA(At, 0, 0); PG8_STAGE(PG8_SA(1, 1), a1 + hstep, voffA);
            PG8_WAIT_V(8); PG8_WAIT_L(0); PG8_BAR; PG8_MMA(0, 0, At, B0); PG8_MMA(0, 1, At, B1); PG8_BAR; PG8_SCHED;
            PG8_LDA(At, 0, 1); PG8_STAGE(PG8_SB(0, 0), b2, voffB); PG8_STAGE(PG8_SB(0, 1), b2 + hstep, voffB); PG8_STAGE(PG8_SA(0, 0), a2, voffA);
            PG8_WAIT_V(8); PG8_WAIT_L(0); PG8_BAR; PG8_MMA(1, 0, At, B0); PG8_MMA(1, 1, At, B1); PG8_BAR; PG8_SCHED;
            PG8_LDB(B0, 1, 0); PG8_LDB(B1, 1, 1); PG8_SCHED; PG8_LDA(At, 1, 0); PG8_STAGE(PG8_SA(0, 1), a2 + hstep, voffA);
            PG8_WAIT_V(8); PG8_WAIT_L(0); PG8_BAR; PG8_MMA(0, 0, At, B0); PG8_MMA(0, 1, At, B1); PG8_BAR; PG8_SCHED;
            PG8_LDA(At, 1, 1); PG8_STAGE(PG8_SB(1, 0), b3, voffB); PG8_STAGE(PG8_SB(1, 1), b3 + hstep, voffB); PG8_STAGE(PG8_SA(1, 0), a3, voffA);
            PG8_WAIT_V(8); PG8_WAIT_L(0); PG8_BAR; PG8_MMA(1, 0, At, B0); PG8_MMA(1, 1, At, B1); PG8_BAR; PG8_SCHED;
            } else {
            PG8_LDB(B0, 0, 0); PG8_SCHED; PG8_LDA(At, 0, 0); PG8_STAGE(PG8_SA(1, 1), a1 + hstep, voffA);
            PG8_WAIT_L(8); PG8_BAR; PG8_WAIT_L(0); PG8_MMA(0, 0, At, B0); PG8_BAR; PG8_SCHED;
            PG8_LDB(B1, 0, 1); PG8_STAGE(PG8_SB(0, 0), b2, voffB);
            PG8_BAR; PG8_WAIT_L(0); PG8_MMA(0, 1, At, B1); PG8_BAR;
            PG8_LDA(At, 0, 1); PG8_STAGE(PG8_SA(0, 0), a2, voffA);
            PG8_BAR; PG8_WAIT_L(0); PG8_MMA(1, 0, At, B0); PG8_BAR; PG8_SCHED;
            PG8_STAGE(PG8_SB(0, 1), b2 + hstep, voffB);
            PG8_WAIT_V(6); PG8_BAR; PG8_MMA(1, 1, At, B1); PG8_BAR;
            PG8_LDB(B0, 1, 0); PG8_SCHED; PG8_LDA(At, 1, 0); PG8_STAGE(PG8_SA(0, 1), a2 + hstep, voffA);
            PG8_WAIT_L(8); PG8_BAR; PG8_WAIT_L(0); PG8_MMA(0, 0, At, B0); PG8_BAR; PG8_SCHED;
            PG8_LDB(B1, 1, 1); PG8_STAGE(PG8_SB(1, 0), b3, voffB);
            PG8_BAR; PG8_WAIT_L(0); PG8_MMA(0, 1, At, B1); PG8_BAR;
            PG8_LDA(At, 1, 1); PG8_STAGE(PG8_SA(1, 0), a3, voffA);
            PG8_BAR; PG8_WAIT_L(0); PG8_MMA(1, 0, At, B0); PG8_BAR; PG8_SCHED;
            PG8_STAGE(PG8_SB(1, 1), b3 + hstep, voffB);
            PG8_WAIT_V(6); PG8_BAR; PG8_MMA(1, 1, At, B1); PG8_BAR;
            }
        }
        if constexpr (ALIGN_EPI) { if (wr == 0) PG8_BAR; }
        if constexpr (!Epi::AFTER_DRAIN) { E(acc, cur, wr, wc, fr, fq); S.done(cur); }
        if (!has_next) break;
#pragma unroll
        for (int a = 0; a < 2; ++a)
#pragma unroll
            for (int b = 0; b < 2; ++b)
#pragma unroll
                for (int m = 0; m < 4; ++m)
#pragma unroll
                    for (int n = 0; n < 2; ++n) acc[a][b][m][n] = (f32x4){0.f, 0.f, 0.f, 0.f};
        cur = nxt; cA = nA; cB = nB; ++ui;
        if constexpr (ALIGN_EPI) { if (wr == 1) PG8_BAR; }
    }
    PG8_WAIT_V(0);
    if constexpr (!ALIGN_EPI) { if (wr == 0) PG8_BAR; }
    PG8_BAR;
    if constexpr (Epi::AFTER_DRAIN) { E.fused(acc, cur, wr, wc, fr, fq, lds, wid, lane); S.done(cur); }
#undef PG8_SA
#undef PG8_SB
#undef PG8_STAGE
#undef PG8_LDA
#undef PG8_LDB
#undef PG8_MMA
#undef PG8_WAIT_V
#undef PG8_WAIT_L
#undef PG8_BAR
#undef PG8_SCHED
}
}

__device__ __forceinline__ uint4 pack8(const float (&v)[8]) { uint4 w; w.x = pk2(v[0], v[1]); w.y = pk2(v[2], v[3]); w.z = pk2(v[4], v[5]); w.w = pk2(v[6], v[7]); return w; }
struct EpiIn {
    static constexpr bool PERM = true, AFTER_DRAIN = false;
    bf16* PROJ; float* HA; const float* lbp;
    template <int GRP> __device__ __forceinline__ void run(const pg8::f32x4 (&acc)[2][2][4][2], int row0, int col0, float sc) const {
#pragma unroll
        for (int bj = 0; bj < 2; ++bj) {
            float lb[8];
            if (GRP == 1) {
#pragma unroll
                for (int i = 0; i < 8; ++i) { const int j = col0 - C_HF + bj * 128 + i; lb[i] = 1.0f / (1.0f + __expf(lbp[512 + j] - lbp[j])); }
            }
#pragma unroll
            for (int ai = 0; ai < 2; ++ai)
#pragma unroll
                for (int m = 0; m < 4; ++m) { const size_t row = (size_t)(row0 + ai * 128 + m * 16);
                    float v[8];
#pragma unroll
                    for (int i = 0; i < 4; ++i) { v[i] = acc[ai][bj][m][0][i]; v[4 + i] = acc[ai][bj][m][1][i]; }
                    if (GRP == 0) {
#pragma unroll
                        for (int i = 0; i < 8; ++i) v[i] *= sc;
                    } else if (GRP == 1) {
                        float a[8];
#pragma unroll
                        for (int i = 0; i < 8; ++i) { const float ex = __expf(-fminf(fmaxf(v[i], -30.f), 30.f)); const float sig = 1.0f / (1.0f + ex), omsig = ex * sig;
                            const float f = lb[i] + (1.0f - lb[i]) * sig; a[i] = __log2f(f); v[i] = (1.0f - lb[i]) * omsig; }
                        float4* hp = (float4*)(HA + row * 512 + (col0 - C_HF) + bj * 128);
                        hp[0] = make_float4(a[0], a[1], a[2], a[3]); hp[1] = make_float4(a[4], a[5], a[6], a[7]);
                    } else if (GRP == 3) {
#pragma unroll
                        for (int i = 0; i < 8; ++i) v[i] = v[i] * __builtin_amdgcn_rcpf(1.0f + __expf(-v[i]));
                    }
                    *(uint4*)(PROJ + row * DIN + col0 + bj * 128) = pack8(v);
                    asm volatile("" ::: "memory");
                }
        }
    }
    __device__ __forceinline__ void operator()(const pg8::f32x4 (&acc)[2][2][4][2], const pg8::Unit& u, int wr, int wc, int fr, int fq) const {
        const int row0 = u.pm * 256 + wr * 64 + fr, col0 = u.pn * 256 + wc * 32 + 8 * fq, grp = u.pn >> 1;
        const float sc = (grp == 0) ? 0.08838834764831845f : ((grp == 4) ? 0.18033688011112042f : 1.0f);
        if (grp == 1) run<1>(acc, row0, col0, sc); else if (grp == 3) run<3>(acc, row0, col0, sc); else run<0>(acc, row0, col0, sc);
    }
};
struct EpiOut {
    static constexpr bool PERM = true, AFTER_DRAIN = false;
    const float* x; bf16* HB; float* PSQ;
    __device__ __forceinline__ void operator()(const pg8::f32x4 (&acc)[2][2][4][2], const pg8::Unit& u, int wr, int wc, int fr, int fq) const {
        const int row0 = u.pm * 256 + wr * 64 + fr, col0 = u.pn * 256 + wc * 32 + 8 * fq;
#pragma unroll
        for (int ai = 0; ai < 2; ++ai) {
            float4 xv[4][2][2];
#pragma unroll
            for (int m = 0; m < 4; ++m)
#pragma unroll
                for (int bj = 0; bj < 2; ++bj) { const size_t off = (size_t)(row0 + ai * 128 + m * 16) * D + col0 + bj * 128;
                    xv[m][bj][0] = *(const float4*)(x + off); xv[m][bj][1] = *(const float4*)(x + off + 4); }
#pragma unroll
            for (int m = 0; m < 4; ++m) { const size_t row = (size_t)(row0 + ai * 128 + m * 16); float ss = 0.f;
#pragma unroll
                for (int bj = 0; bj < 2; ++bj) { const size_t off = row * D + col0 + bj * 128;
                    const float4 x0 = xv[m][bj][0], x1 = xv[m][bj][1];
                    float h[8] = {x0.x + acc[ai][bj][m][0][0], x0.y + acc[ai][bj][m][0][1], x0.z + acc[ai][bj][m][0][2], x0.w + acc[ai][bj][m][0][3],
                                  x1.x + acc[ai][bj][m][1][0], x1.y + acc[ai][bj][m][1][1], x1.z + acc[ai][bj][m][1][2], x1.w + acc[ai][bj][m][1][3]};
                    *(uint4*)(HB + off) = pack8(h);
#pragma unroll
                    for (int i = 0; i < 8; ++i) ss += h[i] * h[i]; }
                ss += __shfl_xor(ss, 16); ss += __shfl_xor(ss, 32);
                if (fq == 0) PSQ[row * 16 + u.pn * 4 + wc] = ss; }
            asm volatile("" ::: "memory");
        }
    }
};
struct EpiQ {
    static constexpr bool PERM = true, AFTER_DRAIN = false;
    bf16* QH;
    __device__ __forceinline__ void operator()(const pg8::f32x4 (&acc)[2][2][4][2], const pg8::Unit& u, int wr, int wc, int fr, int fq) const {
        const int row0 = u.pm * 256 + wr * 64 + fr, col0 = u.pn * 256 + wc * 32 + 8 * fq;
#pragma unroll
        for (int ai = 0; ai < 2; ++ai)
#pragma unroll
            for (int m = 0; m < 4; ++m) { const size_t row = (size_t)(row0 + ai * 128 + m * 16);
#pragma unroll
                for (int bj = 0; bj < 2; ++bj) { float v[8];
#pragma unroll
                    for (int i = 0; i < 4; ++i) { v[i] = acc[ai][bj][m][0][i]; v[4 + i] = acc[ai][bj][m][1][i]; }
                    *(uint4*)(QH + row * 2048 + col0 + bj * 128) = pack8(v); } }
    }
};

__device__ __forceinline__ float compute_lambda(const float* dl, int lane) {
    const float sa = wave_sum(dl[lane] * dl[64 + lane]), sb = wave_sum(dl[128 + lane] * dl[192 + lane]);
    return __expf(sa) - __expf(sb) + 0.2f;
}
namespace hg {
typedef short bf16x8 __attribute__((ext_vector_type(8)));
typedef short s16x4 __attribute__((ext_vector_type(4)));
typedef float f32x4 __attribute__((ext_vector_type(4)));
typedef unsigned u32x4 __attribute__((ext_vector_type(4)));
typedef unsigned u32x2 __attribute__((ext_vector_type(2)));
typedef float f32x2 __attribute__((ext_vector_type(2)));
constexpr int QT = 0, KT = 16384, VT = 32768, AT = 49152, PT = 81920, OT = 90112, SEG = 122880, DEC = 126976;
__device__ __forceinline__ int swzA(int row) { return row & 15; }
__device__ __forceinline__ int swzB(int row) { return ((row & 3) << 1) | (((row >> 3) & 1) << 3); }
__device__ __forceinline__ int swzP(int row) { return (((row >> 1) & 1) << 1) | (((row >> 3) & 1) << 2); }
__device__ __forceinline__ s16x4 vtr(const LAS unsigned char* p) { return __builtin_bit_cast(s16x4, __builtin_amdgcn_ds_read_tr16_b64_v4i16((LAS s16x4*)p)); }
__device__ __forceinline__ bf16x8 cat(s16x4 a, s16x4 b) { return (bf16x8){a[0], a[1], a[2], a[3], b[0], b[1], b[2], b[3]}; }
__device__ __forceinline__ unsigned cvtpk(float lo, float hi) { typedef float f2 __attribute__((ext_vector_type(2))); typedef __bf16 b2 __attribute__((ext_vector_type(2))); f2 v = {lo, hi}; b2 b = __builtin_convertvector(v, b2); return __builtin_bit_cast(unsigned, b); }

__device__ __forceinline__ void hgrn_pre(Frame& F, int task) {
    LAS unsigned char* lds = (LAS unsigned char*)F.lds;
    const int tid = F.tid, lane = F.lane, w = F.wave, c16 = lane & 15, g = lane >> 4, q4 = c16 >> 2, p4 = c16 & 3;
    const int c = task & 63, h = (task >> 6) & 3, b = task >> 8;
    const size_t row0 = (size_t)b * SEQ + (size_t)c * 64;
    const int srow = tid >> 4, sch = tid & 15;
#pragma unroll
    for (int i = 0; i < 2; ++i) { const int row = srow + 32 * i; const bf16* rp = F.PROJ + (row0 + row) * DIN + h * 128 + sch * 8;
        *(LAS u32x4*)(lds + QT + row * 256 + ((sch ^ swzA(row)) << 4)) = *(const u32x4*)(rp + C_HQ);
        *(LAS u32x4*)(lds + KT + row * 256 + ((sch ^ swzB(row)) << 4)) = *(const u32x4*)(rp + C_HF);
        *(LAS u32x4*)(lds + VT + row * 256 + ((sch ^ swzB(row)) << 4)) = *(const u32x4*)(rp + C_HI); }
#pragma unroll
    for (int i = 0; i < 4; ++i) { const int p = tid + 512 * i; *(LAS u32x4*)(lds + AT + (p >> 5) * 512 + (p & 31) * 16) = *(const u32x4*)(F.HA + (row0 + (p >> 5)) * 512 + h * 128 + (p & 31) * 4); }
    __syncthreads();
    {
        const int dp = tid & 63, ts = tid >> 6, d = 2 * dp;
        const LAS float* at = (const LAS float*)(lds + AT);
        LAS float* seg = (LAS float*)(lds + SEG);
        float cs0[8], cs1[8]; float r0 = 0.f, r1 = 0.f;
#pragma unroll
        for (int tt = 0; tt < 8; ++tt) { const f32x2 a = *(const LAS f32x2*)(at + (8 * ts + tt) * 128 + d); r0 += a.x; r1 += a.y; cs0[tt] = r0; cs1[tt] = r1; }
        *(LAS f32x2*)(seg + ts * 128 + d) = (f32x2){r0, r1};
        __syncthreads();
        float off0 = 0.f, off1 = 0.f, bl0 = 0.f, bl1 = 0.f;
#pragma unroll
        for (int k = 0; k < 8; ++k) { const f32x2 s = *(const LAS f32x2*)(seg + k * 128 + d); if (k < ts) { off0 += s.x; off1 += s.y; } bl0 += s.x; bl1 += s.y; }
        if (ts == 0) *(f32x2*)(F.DECG + ((size_t)(b * 64 + c) * 4 + h) * 128 + d) = (f32x2){__builtin_amdgcn_exp2f(fmaxf(bl0, -120.f)), __builtin_amdgcn_exp2f(fmaxf(bl1, -120.f))};
#pragma unroll
        for (int tt = 0; tt < 8; ++tt) { const int t = 8 * ts + tt;
            const float x0 = (off0 + cs0[tt]) - bl0, x1 = (off1 + cs1[tt]) - bl1;
            const float eq0 = __builtin_amdgcn_exp2f(fminf(x0, 120.f)), eq1 = __builtin_amdgcn_exp2f(fminf(x1, 120.f));
            const float ek0 = __builtin_amdgcn_exp2f(fmaxf(-x0, -120.f)), ek1 = __builtin_amdgcn_exp2f(fmaxf(-x1, -120.f));
            LAS unsigned* pq = (LAS unsigned*)(lds + QT + t * 256 + (((d >> 3) ^ swzA(t)) << 4) + (d & 7) * 2);
            LAS unsigned* pk = (LAS unsigned*)(lds + KT + t * 256 + (((d >> 3) ^ swzB(t)) << 4) + (d & 7) * 2);
            const unsigned qv = *pq, kv = *pk;
            *pq = cvtpk(bflo(qv) * eq0, bfhi(qv) * eq1); *pk = cvtpk(bflo(kv) * ek0, bfhi(kv) * ek1); }
    }
    __syncthreads();
#pragma unroll
    for (int i = 0; i < 2; ++i) { const int row = srow + 32 * i; bf16* rp = F.PROJ + (row0 + row) * DIN + h * 128 + sch * 8;
        *(u32x4*)(rp + C_HQ) = *(const LAS u32x4*)(lds + QT + row * 256 + ((sch ^ swzA(row)) << 4));
        *(u32x4*)(rp + C_HF) = *(const LAS u32x4*)(lds + KT + row * 256 + ((sch ^ swzB(row)) << 4)); }
#pragma unroll
    for (int rep = 0; rep < 2; ++rep) {
        const int idx = w + 8 * rep;
        if (idx < 12) {
            int tb, sb; bool zero = false;
            if (idx == 10) { tb = 0; sb = 1; zero = true; } else if (idx == 11) { tb = 2; sb = 3; zero = true; }
            else { tb = (idx >= 6) ? 3 : (idx >= 3) ? 2 : (idx >= 1) ? 1 : 0; sb = idx - (tb * (tb + 1)) / 2; }
            f32x4 acc = (f32x4){0.f, 0.f, 0.f, 0.f};
            if (!zero) {
                const int tr = 16 * tb + c16, sr = 16 * sb + c16;
#pragma unroll
                for (int ks = 0; ks < 4; ++ks) {
                    const bf16x8 a = *(const LAS bf16x8*)(lds + QT + tr * 256 + (((4 * ks + g) ^ swzA(tr)) << 4));
                    const bf16x8 bb = *(const LAS bf16x8*)(lds + KT + sr * 256 + (((4 * ks + g) ^ swzB(sr)) << 4));
                    acc = __builtin_amdgcn_mfma_f32_16x16x32_bf16(a, bb, acc, 0, 0, 0);
                }
                if (tb == sb) {
#pragma unroll
                    for (int r = 0; r < 4; ++r) if (c16 > 4 * g + r) acc[r] = 0.f;
                }
            }
            const int s = 16 * sb + c16;
            u32x2 pk; pk.x = cvtpk(acc[0], acc[1]); pk.y = cvtpk(acc[2], acc[3]);
            *(LAS u32x2*)(lds + PT + s * 128 + (((2 * tb + (g >> 1)) ^ swzP(s)) << 4) + (g & 1) * 8) = pk;
        }
    }
    __syncthreads();
    bf16x8 Vf[2];
#pragma unroll
    for (int ks2 = 0; ks2 < 2; ++ks2) {
        const int r0 = 32 * ks2 + 8 * g + q4, r1 = r0 + 4;
        Vf[ks2] = cat(vtr(lds + VT + r0 * 256 + (((2 * w + (p4 >> 1)) ^ swzB(r0)) << 4) + (p4 & 1) * 8), vtr(lds + VT + r1 * 256 + (((2 * w + (p4 >> 1)) ^ swzB(r1)) << 4) + (p4 & 1) * 8));
    }
    LAS float* ot = (LAS float*)(lds + OT);
#pragma unroll
    for (int tb = 0; tb < 4; ++tb) {
        f32x4 O = (f32x4){0.f, 0.f, 0.f, 0.f};
#pragma unroll
        for (int ks2 = 0; ks2 < 2; ++ks2) {
            if (ks2 <= (tb >> 1)) {
                const int r0 = 32 * ks2 + 8 * g + q4, r1 = r0 + 4;
                const s16x4 lo = vtr(lds + PT + r0 * 128 + (((2 * tb + (p4 >> 1)) ^ swzP(r0)) << 4) + (p4 & 1) * 8);
                const s16x4 hh = vtr(lds + PT + r1 * 128 + (((2 * tb + (p4 >> 1)) ^ swzP(r1)) << 4) + (p4 & 1) * 8);
                O = __builtin_amdgcn_mfma_f32_16x16x32_bf16(cat(lo, hh), Vf[ks2], O, 0, 0, 0);
            }
        }
#pragma unroll
        for (int r = 0; r < 4; ++r) ot[(16 * tb + 4 * g + r) * 128 + 16 * w + c16] = O[r];
    }
    __syncthreads();
#pragma unroll
    for (int i = 0; i < 4; ++i) { const int p = tid + 512 * i; *(u32x4*)(F.HO + (row0 + (p >> 5)) * 512 + h * 128 + (p & 31) * 4) = *(const LAS u32x4*)(lds + OT + (p >> 5) * 512 + (p & 31) * 16); }
    __syncthreads();
}

__device__ __forceinline__ void hgrn_scan(Frame& F, int b, int h) {
    LAS unsigned char* lds = (LAS unsigned char*)F.lds;
    const int tid = F.tid, lane = F.lane, w = F.wave;
    const size_t row0 = (size_t)b * SEQ;
    f32x4 S[8];
#pragma unroll
    for (int i = 0; i < 8; ++i) S[i] = (f32x4){0.f, 0.f, 0.f, 0.f};
    u32x4 sq[2], sk[2], sv[2], so[4], sgn[2]; float sdec = 0.f;
    const int srow = tid >> 4, sch = tid & 15;
    float hw[8];
    { const float4 a = *(const float4*)(F.hnw + sch * 8), bq = *(const float4*)(F.hnw + sch * 8 + 4); hw[0] = a.x; hw[1] = a.y; hw[2] = a.z; hw[3] = a.w; hw[4] = bq.x; hw[5] = bq.y; hw[6] = bq.z; hw[7] = bq.w; }
#define HG_LOAD(c) do { _Pragma("unroll") for (int i = 0; i < 2; ++i) { const bf16* rp = F.PROJ + (row0 + (size_t)(c) * 64 + srow + 32 * i) * DIN + h * 128 + sch * 8; \
        sq[i] = *(const u32x4*)(rp + C_HQ); sk[i] = *(const u32x4*)(rp + C_HF); sv[i] = *(const u32x4*)(rp + C_HI); sgn[i] = *(const u32x4*)(rp + C_HG); } \
    _Pragma("unroll") for (int i = 0; i < 4; ++i) { const int p = tid + 512 * i; so[i] = *(const u32x4*)(F.HO + (row0 + (size_t)(c) * 64 + (p >> 5)) * 512 + h * 128 + (p & 31) * 4); } \
    if (tid < 128) sdec = F.DECG[((size_t)(b * 64 + (c)) * 4 + h) * 128 + tid]; } while (0)
    HG_LOAD(0);
    for (int c = 0; c < SEQ / 64; ++c) {
        int lz = lane; asm volatile("" : "+v"(lz));
        const int c16 = lz & 15, g = lz >> 4, q4 = c16 >> 2, p4 = c16 & 3;
        u32x4 sgt[2]; sgt[0] = sgn[0]; sgt[1] = sgn[1];
#pragma unroll
        for (int i = 0; i < 2; ++i) { const int row = srow + 32 * i;
            *(LAS u32x4*)(lds + QT + row * 256 + ((sch ^ swzA(row)) << 4)) = sq[i];
            *(LAS u32x4*)(lds + KT + row * 256 + ((sch ^ swzB(row)) << 4)) = sk[i];
            *(LAS u32x4*)(lds + VT + row * 256 + ((sch ^ swzB(row)) << 4)) = sv[i]; }
#pragma unroll
        for (int i = 0; i < 4; ++i) { const int p = tid + 512 * i; *(LAS u32x4*)(lds + OT + (p >> 5) * 512 + (p & 31) * 16) = so[i]; }
        if (tid < 128) ((LAS float*)(lds + DEC))[tid] = sdec;
        __syncthreads();
        if (c + 1 < SEQ / 64) HG_LOAD(c + 1);
        bf16x8 Bf[4];
        {
            const LAS float* dec = (const LAS float*)(lds + DEC);
#pragma unroll
            for (int db = 0; db < 8; ++db) { const f32x4 dv = *(const LAS f32x4*)(dec + 16 * db + 4 * g); S[db] = S[db] * dv; }
#pragma unroll
            for (int ks = 0; ks < 4; ++ks) { u32x4 t; t.x = cvtpk(S[2 * ks][0], S[2 * ks][1]); t.y = cvtpk(S[2 * ks][2], S[2 * ks][3]); t.z = cvtpk(S[2 * ks + 1][0], S[2 * ks + 1][1]); t.w = cvtpk(S[2 * ks + 1][2], S[2 * ks + 1][3]);
                Bf[ks] = __builtin_bit_cast(bf16x8, t); }
        }
        LAS float* ot = (LAS float*)(lds + OT);
#pragma unroll
        for (int tb = 0; tb < 4; ++tb) {
            f32x4 O;
#pragma unroll
            for (int r = 0; r < 4; ++r) O[r] = ot[(16 * tb + 4 * g + r) * 128 + 16 * w + c16];
            const int tr = 16 * tb + c16;
#pragma unroll
            for (int ks = 0; ks < 4; ++ks) {
                const s16x4 lo = *(const LAS s16x4*)(lds + QT + tr * 256 + (((4 * ks + (g >> 1)) ^ swzA(tr)) << 4) + (g & 1) * 8);
                const s16x4 hh = *(const LAS s16x4*)(lds + QT + tr * 256 + (((4 * ks + 2 + (g >> 1)) ^ swzA(tr)) << 4) + (g & 1) * 8);
                O = __builtin_amdgcn_mfma_f32_16x16x32_bf16(cat(lo, hh), Bf[ks], O, 0, 0, 0);
            }
#pragma unroll
            for (int r = 0; r < 4; ++r) ot[(16 * tb + 4 * g + r) * 128 + 16 * w + c16] = O[r];
        }
        bf16x8 Vf[2];
#pragma unroll
        for (int ks2 = 0; ks2 < 2; ++ks2) {
            const int r0 = 32 * ks2 + 8 * g + q4, r1 = r0 + 4;
            Vf[ks2] = cat(vtr(lds + VT + r0 * 256 + (((2 * w + (p4 >> 1)) ^ swzB(r0)) << 4) + (p4 & 1) * 8), vtr(lds + VT + r1 * 256 + (((2 * w + (p4 >> 1)) ^ swzB(r1)) << 4) + (p4 & 1) * 8));
        }
#pragma unroll
        for (int db = 0; db < 8; ++db)
#pragma unroll
            for (int ks2 = 0; ks2 < 2; ++ks2) {
                const int r0 = 32 * ks2 + 8 * g + q4, r1 = r0 + 4;
                const s16x4 lo = vtr(lds + KT + r0 * 256 + (((2 * db + (p4 >> 1)) ^ swzB(r0)) << 4) + (p4 & 1) * 8);
                const s16x4 hh = vtr(lds + KT + r1 * 256 + (((2 * db + (p4 >> 1)) ^ swzB(r1)) << 4) + (p4 & 1) * 8);
                S[db] = __builtin_amdgcn_mfma_f32_16x16x32_bf16(cat(lo, hh), Vf[ks2], S[db], 0, 0, 0);
            }
        __syncthreads();
#pragma unroll
        for (int i = 0; i < 2; ++i) { const int t = srow + 32 * i; const size_t row = row0 + (size_t)c * 64 + t;
            const f32x4 xa = *(const LAS f32x4*)(ot + t * 128 + sch * 8), xb = *(const LAS f32x4*)(ot + t * 128 + sch * 8 + 4);
            float ss = (xa[0] * xa[0] + xa[1] * xa[1]) + (xa[2] * xa[2] + xa[3] * xa[3]) + (xb[0] * xb[0] + xb[1] * xb[1]) + (xb[2] * xb[2] + xb[3] * xb[3]);
            ss += __builtin_bit_cast(float, __builtin_amdgcn_update_dpp(0, __builtin_bit_cast(int, ss), 0xB1, 0xF, 0xF, false));
            ss += __builtin_bit_cast(float, __builtin_amdgcn_update_dpp(0, __builtin_bit_cast(int, ss), 0x4E, 0xF, 0xF, false));
            ss += __builtin_bit_cast(float, __builtin_amdgcn_update_dpp(0, __builtin_bit_cast(int, ss), 0x141, 0xF, 0xF, false));
            ss += __builtin_bit_cast(float, __builtin_amdgcn_update_dpp(0, __builtin_bit_cast(int, ss), 0x140, 0xF, 0xF, false));
            const float r = 1.0f / sqrtf(ss * (1.f / 128.f) + RMS_EPS);
            const u32x4 gt = sgt[i];
            u32x4 o;
            o.x = cvtpk(xa[0] * r * hw[0] * bflo(gt.x), xa[1] * r * hw[1] * bfhi(gt.x)); o.y = cvtpk(xa[2] * r * hw[2] * bflo(gt.y), xa[3] * r * hw[3] * bfhi(gt.y));
            o.z = cvtpk(xb[0] * r * hw[4] * bflo(gt.z), xb[1] * r * hw[5] * bfhi(gt.z)); o.w = cvtpk(xb[2] * r * hw[6] * bflo(gt.w), xb[3] * r * hw[7] * bfhi(gt.w));
            *(u32x4*)(F.MIX + row * D + h * 128 + sch * 8) = o; }
        __syncthreads();
    }
#undef HG_LOAD
}
}

namespace da {
typedef short bf16x8 __attribute__((ext_vector_type(8)));
typedef short s16x4 __attribute__((ext_vector_type(4)));
typedef float f32x16 __attribute__((ext_vector_type(16)));
constexpr int V_OFF = 16384, BUF_BYTES = 32768;
__device__ __forceinline__ s16x4 vtr(const LAS unsigned char* p) { return __builtin_bit_cast(s16x4, __builtin_amdgcn_ds_read_tr16_b64_v4i16((LAS s16x4*)p)); }
__device__ __forceinline__ unsigned cvtpk(float lo, float hi) { typedef float f2 __attribute__((ext_vector_type(2))); typedef __bf16 b2 __attribute__((ext_vector_type(2))); f2 v = {lo, hi}; b2 b = __builtin_convertvector(v, b2); return __builtin_bit_cast(unsigned, b); }

__device__ __forceinline__ float max3f(float a, float b, float c) { float r; asm("v_max3_f32 %0, %1, %2, %3" : "=v"(r) : "v"(a), "v"(b), "v"(c)); return r; }
__device__ __forceinline__ float exp2_pin(float x) { float y; asm volatile("v_exp_f32_e32 %0, %1" : "=v"(y) : "v"(x)); return y; }
__device__ __forceinline__ float max2f(float a, float b) { float r; asm("v_max_f32_e32 %0, %1, %2" : "=v"(r) : "v"(a), "v"(b)); return r; }
constexpr float RESC_THR = 8.0f;
__device__ __forceinline__ void attn_unit(Frame& F, int b, int h, int qblk, float lam) {
    LAS unsigned char* lds = (LAS unsigned char*)F.lds;
    const int lane = F.lane, r32 = lane & 31, hi = lane >> 5, w = F.wave, rg = w >> 1, map = w & 1;
    const int t0 = qblk * 128 + rg * 32;
    const int ntile_blk = 2 * qblk + 2, ntile_w = 2 * qblk + (rg >> 1) + 1;
    const bf16* base = F.PROJ + (size_t)b * SEQ * DIN;
    const bf16* gk = base + (size_t)(8 * w + (lane >> 3)) * DIN + C_AK + h * 128 + (((lane & 7) ^ ((4 * w + (lane >> 4)) & 7)) * 8);
    const bf16* gv = base + (size_t)(4 * w + (lane >> 4)) * DIN + C_AV + h * 128 + (((lane & 15) ^ ((lane >> 4) << 2)) * 8);
#define DA_DMA(tile, buf) do { const size_t to_ = (size_t)(tile) * 64 * DIN; LAS unsigned char* lb_ = lds + (buf) * BUF_BYTES + w * 1024; \
        __builtin_amdgcn_global_load_lds((const unsigned*)(gk + to_), (LAS unsigned*)(lb_), 16, 0, 0); \
        __builtin_amdgcn_global_load_lds((const unsigned*)(gk + to_ + 64), (LAS unsigned*)(lb_ + 8192), 16, 0, 0); \
        __builtin_amdgcn_global_load_lds((const unsigned*)(gv + to_), (LAS unsigned*)(lb_ + V_OFF), 16, 0, 0); \
        __builtin_amdgcn_global_load_lds((const unsigned*)(gv + to_ + (size_t)32 * DIN), (LAS unsigned*)(lb_ + V_OFF + 8192), 16, 0, 0); } while (0)
    DA_DMA(0, 0); DA_DMA(1, 1);
    if (ntile_blk > 2) DA_DMA(2, 2);
    bf16x8 qr[4];
#pragma unroll
    for (int d0 = 0; d0 < 4; ++d0) qr[d0] = *(const bf16x8*)(base + (size_t)(t0 + r32) * DIN + C_AQ + h * 128 + map * 64 + 16 * d0 + 8 * hi);
    asm volatile("s_waitcnt vmcnt(0)" : "+v"(qr[0]), "+v"(qr[1]), "+v"(qr[2]), "+v"(qr[3]) :: "memory");
    f32x16 o[4], negm;
#pragma unroll
    for (int eb = 0; eb < 4; ++eb)
#pragma unroll
        for (int r = 0; r < 16; ++r) o[eb][r] = 0.f;
#pragma unroll
    for (int r = 0; r < 16; ++r) negm[r] = 0.f;
    float mref = 0.f, l = 0.f;
    const int koff = map * 8192 + r32 * 128;
    const int q4 = (lane & 15) >> 2, p4 = lane & 3, eh = (lane >> 4) & 1;
    int voff[4];
#pragma unroll
    for (int eb = 0; eb < 4; ++eb) voff[eb] = V_OFF + (4 * hi + q4) * 256 + (p4 & 1) * 8 + (((((eb ^ q4) << 2) + 2 * eh + (p4 >> 1))) << 4);
#define DA_KFRAG(slot_, d0_, half_) (*(const LAS bf16x8*)(lds + (slot_) * BUF_BYTES + koff + (half_) * (32 * 128) + ((((2 * (d0_) + hi) ^ ((r32 >> 1) & 7))) << 4)))
#define DA_ROWMAX(c0_, c1_) ({ float a_ = fmaxf(fmaxf(c0_[0], c0_[1]), c1_[0]), b_ = fmaxf(fmaxf(c0_[2], c0_[3]), c1_[1]); a_ = fmaxf(fmaxf(a_, c1_[2]), c1_[3]); \
        _Pragma("unroll") for (int r = 4; r < 16; r += 4) { a_ = fmaxf(fmaxf(a_, c0_[r]), c0_[r + 1]); b_ = fmaxf(fmaxf(b_, c0_[r + 2]), c0_[r + 3]); a_ = fmaxf(fmaxf(a_, c1_[r]), c1_[r + 1]); b_ = fmaxf(fmaxf(b_, c1_[r + 2]), c1_[r + 3]); } \
        float m_ = fmaxf(a_, b_); auto rr_ = __builtin_amdgcn_permlane32_swap(__float_as_uint(m_), __float_as_uint(m_), false, false); fmaxf(__uint_as_float(rr_[0]), __uint_as_float(rr_[1])); })
    __builtin_amdgcn_s_barrier(); asm volatile("" ::: "memory");
    f32x16 pp0 = negm, pp1 = negm;
#pragma unroll
    for (int d0 = 0; d0 < 4; ++d0) { pp0 = __builtin_amdgcn_mfma_f32_32x32x16_bf16(DA_KFRAG(0, d0, 0), qr[d0], pp0, 0, 0, 0); pp1 = __builtin_amdgcn_mfma_f32_32x32x16_bf16(DA_KFRAG(0, d0, 1), qr[d0], pp1, 0, 0, 0); }
    { const float mx = DA_ROWMAX(pp0, pp1); mref = mx;
#pragma unroll
      for (int r = 0; r < 16; ++r) { negm[r] = -mref; pp0[r] = __builtin_amdgcn_exp2f(pp0[r] - mx); pp1[r] = __builtin_amdgcn_exp2f(pp1[r] - mx); } }
    asm volatile("s_waitcnt lgkmcnt(0)" ::: "memory");
    __builtin_amdgcn_s_barrier(); asm volatile("" ::: "memory");
    for (int t = 1; t <= ntile_blk; ++t) {
        if (t + 2 < ntile_blk) DA_DMA(t + 2, (t + 2) & 3);
        const int sc = t & 3, sp = (t - 1) & 3;
        if (t <= ntile_w) {
            const bool cur = t < ntile_w;
            f32x16 c0 = negm, c1 = negm;
            bf16x8 kf[8];
#pragma unroll
            for (int d0 = 0; d0 < 4; ++d0) { kf[2 * d0] = DA_KFRAG(sc, d0, 0); kf[2 * d0 + 1] = DA_KFRAG(sc, d0, 1); }
            unsigned pw[2][2][4]; float rs = 0.f;
#pragma unroll
            for (int r = 0; r < 16; ++r) rs += pp0[r] + pp1[r];
#pragma unroll
            for (int s = 0; s < 2; ++s)
#pragma unroll
                for (int j = 0; j < 4; ++j) { pw[0][s][j] = cvtpk(pp0[8 * s + 2 * j], pp0[8 * s + 2 * j + 1]); pw[1][s][j] = cvtpk(pp1[8 * s + 2 * j], pp1[8 * s + 2 * j + 1]); }
#pragma unroll
            for (int d0 = 0; d0 < 4; ++d0) { c0 = __builtin_amdgcn_mfma_f32_32x32x16_bf16(kf[2 * d0], qr[d0], c0, 0, 0, 0); c1 = __builtin_amdgcn_mfma_f32_32x32x16_bf16(kf[2 * d0 + 1], qr[d0], c1, 0, 0, 0); }
            __builtin_amdgcn_sched_group_barrier(0x100, 8, 0); __builtin_amdgcn_sched_group_barrier(0x2, 10, 0);
#pragma unroll
            for (int i = 0; i < 8; ++i) { __builtin_amdgcn_sched_group_barrier(0x8, 1, 0); __builtin_amdgcn_sched_group_barrier(0x2, 4, 0); }
            l += rs;
            bool resc = false; float f = 1.0f;
            if (cur) {
                const float mx = DA_ROWMAX(c0, c1);
                if (__any(mx > RESC_THR)) {
                    const float dl = fmaxf(mx, 0.f); f = __builtin_amdgcn_exp2f(-dl); mref += dl; l *= f; resc = true;
#pragma unroll
                    for (int r = 0; r < 16; ++r) { c0[r] -= dl; c1[r] -= dl; negm[r] = -mref; }
                }
            }
            {
                typedef unsigned u4 __attribute__((ext_vector_type(4)));
                const LAS unsigned char* vb_ = lds + sp * BUF_BYTES;
#define DA_VA(k_) (vb_ + voff[(k_) >> 2] + (16 * ((k_) & 3)) * 256)
                s16x4 lo_a = vtr(DA_VA(0)), hh_a = vtr(DA_VA(0) + 8 * 256), lo_b = vtr(DA_VA(1)), hh_b = vtr(DA_VA(1) + 8 * 256);
#pragma unroll
                for (int k = 0; k < 16; ++k) {
                    const s16x4 lo = lo_a, hh = hh_a;
                    lo_a = lo_b; hh_a = hh_b;
                    if (k < 14) { lo_b = vtr(DA_VA(k + 2)); hh_b = vtr(DA_VA(k + 2) + 8 * 256); }
                    const bf16x8 av = {lo[0], lo[1], lo[2], lo[3], hh[0], hh[1], hh[2], hh[3]};
                    const u4 pv = {pw[(k >> 1) & 1][k & 1][0], pw[(k >> 1) & 1][k & 1][1], pw[(k >> 1) & 1][k & 1][2], pw[(k >> 1) & 1][k & 1][3]};
                    o[k >> 2] = __builtin_amdgcn_mfma_f32_32x32x16_bf16(av, __builtin_bit_cast(bf16x8, pv), o[k >> 2], 0, 0, 0);
                    if (k < 8) { c0[2 * k] = exp2_pin(c0[2 * k]); c0[2 * k + 1] = exp2_pin(c0[2 * k + 1]); }
                    else { c1[2 * (k - 8)] = exp2_pin(c1[2 * (k - 8)]); c1[2 * (k - 8) + 1] = exp2_pin(c1[2 * (k - 8) + 1]); }
                }
#undef DA_VA
            }
            if (resc) {
#pragma unroll
                for (int eb = 0; eb < 4; ++eb)
#pragma unroll
                    for (int r = 0; r < 16; ++r) o[eb][r] *= f;
            }
            pp0 = c0; pp1 = c1;
        }
        if (t + 2 < ntile_blk) asm volatile("s_waitcnt vmcnt(4)" ::: "memory"); else asm volatile("s_waitcnt vmcnt(0)" ::: "memory");
        asm volatile("s_waitcnt lgkmcnt(0)" ::: "memory");
        __builtin_amdgcn_s_barrier(); asm volatile("" ::: "memory");
    }
#undef DA_KFRAG
#undef DA_ROWMAX
#undef DA_DMA
    l += __shfl_xor(l, 32);
    const float inv = 1.0f / l;
    LAS float* X = (LAS float*)lds + rg * 4096;
    if (map == 1) {
#pragma unroll
        for (int eb = 0; eb < 4; ++eb)
#pragma unroll
            for (int r = 0; r < 16; ++r) X[(eb * 16 + r) * 64 + lane] = o[eb][r] * inv;
    }
    __syncthreads();
    if (map == 0) {
        float ss = 0.f;
#pragma unroll
        for (int eb = 0; eb < 4; ++eb)
#pragma unroll
            for (int r = 0; r < 16; ++r) { const float d = o[eb][r] * inv - lam * X[(eb * 16 + r) * 64 + lane]; o[eb][r] = d; ss += d * d; }
        ss += __shfl_xor(ss, 32);
        const float rstd = 0.8f / sqrtf(ss * (1.f / 128.f) + RMS_EPS);
        bf16* orow = F.MIX + (size_t)(b * SEQ + t0 + r32) * D + 512 + h * 128;
#pragma unroll
        for (int eb = 0; eb < 4; ++eb)
#pragma unroll
            for (int r4 = 0; r4 < 4; ++r4) { const int e0 = 32 * eb + 8 * r4 + 4 * hi; const float4 wv = *(const float4*)(F.dnw + e0);
                uint2 pk; pk.x = pk2(o[eb][4 * r4 + 0] * rstd * wv.x, o[eb][4 * r4 + 1] * rstd * wv.y); pk.y = pk2(o[eb][4 * r4 + 2] * rstd * wv.z, o[eb][4 * r4 + 3] * rstd * wv.w);
                *(uint2*)(orow + e0) = pk; }
    }
    __syncthreads();
}
__device__ __forceinline__ void attn_phase(Frame& F, unsigned* ctl, volatile LAS unsigned* MISC, int cbase = 1024) {
    const float lam = compute_lambda(F.dlam, F.lane);
    const int x = F.bid & 7;
    if (F.tid == 0) MISC[16] = atomicAdd(&ctl[cbase + 64 * x], 1u);
    __syncthreads();
    for (;;) {
        const unsigned u = MISC[16];
        __syncthreads();
        if (u >= 128u) break;
        unsigned nxt = 0u;
        if (F.tid == 0) nxt = atomicAdd(&ctl[cbase + 64 * x], 1u);
        attn_unit(F, (4 * x + (int)(u & 3)) >> 2, (int)(u & 3), 31 - (int)(u >> 2), lam);
        if (F.tid == 0) MISC[16] = nxt;
        __syncthreads();
    }
}
}

__device__ __forceinline__ float row_rstd(const float* PSQ, int t) {
    const float4* p = (const float4*)(PSQ + (size_t)t * 16);
    const float4 a = p[0], b = p[1], c = p[2], d = p[3];
    const float s = ((a.x + a.y) + (a.z + a.w)) + ((b.x + b.y) + (b.z + b.w)) + ((c.x + c.y) + (c.z + c.w)) + ((d.x + d.y) + (d.z + d.w));
    return 1.0f / sqrtf(s * (1.f / D) + RMS_EPS);
}

__device__ __forceinline__ float gelu_tanh(float z) {
    const float y = 0.7978845608028654f * (z + 0.044715f * z * z * z);
    const float th = 1.0f - 2.0f / (1.0f + __expf(2.0f * y));
    return 0.5f * z * (1.0f + th);
}
__device__ __forceinline__ void unpack8(const uint4 v, float (&f)[8]) {
    f[0] = bflo(v.x); f[1] = bfhi(v.x); f[2] = bflo(v.y); f[3] = bfhi(v.y); f[4] = bflo(v.z); f[5] = bfhi(v.z); f[6] = bflo(v.w); f[7] = bfhi(v.w);
}
namespace tk {
typedef short bf16x8 __attribute__((ext_vector_type(8)));
typedef float f32x16 __attribute__((ext_vector_type(16)));
typedef unsigned u32x4 __attribute__((ext_vector_type(4)));
constexpr int NC = 50;
constexpr int CI[NC] = {0, 0, 0, 0, 0, 0, 0, 0, 0, 0, 0, 0, 0, 0, 0, 0, 1, 1, 1, 1, 1, 1, 1, 1, 2, 2, 2, 2, 2, 3, 3, 3, 3, 4, 4, 4, 5, 5, 6, 6, 7, 7, 8, 9, 10, 11, 12, 13, 14, 15};
constexpr int CJ[NC] = {0, 1, 2, 3, 4, 5, 6, 7, 8, 9, 10, 11, 12, 13, 14, 15, 0, 1, 2, 3, 4, 5, 6, 7, 0, 1, 2, 3, 4, 0, 1, 2, 3, 0, 1, 2, 0, 1, 0, 1, 0, 1, 0, 0, 0, 0, 0, 0, 0, 0};
constexpr int SLOT_OFF = 65536;
#define TK_SORT16(A) do { int h_, l_; \
    h_ = max(A[0], A[1]); l_ = min(A[0], A[1]); A[0] = h_; A[1] = l_; \
    h_ = max(A[3], A[2]); l_ = min(A[3], A[2]); A[3] = h_; A[2] = l_; \
    h_ = max(A[4], A[5]); l_ = min(A[4], A[5]); A[4] = h_; A[5] = l_; \
    h_ = max(A[7], A[6]); l_ = min(A[7], A[6]); A[7] = h_; A[6] = l_; \
    h_ = max(A[8], A[9]); l_ = min(A[8], A[9]); A[8] = h_; A[9] = l_; \
    h_ = max(A[11], A[10]); l_ = min(A[11], A[10]); A[11] = h_; A[10] = l_; \
    h_ = max(A[12], A[13]); l_ = min(A[12], A[13]); A[12] = h_; A[13] = l_; \
    h_ = max(A[15], A[14]); l_ = min(A[15], A[14]); A[15] = h_; A[14] = l_; \
    h_ = max(A[0], A[2]); l_ = min(A[0], A[2]); A[0] = h_; A[2] = l_; \
    h_ = max(A[1], A[3]); l_ = min(A[1], A[3]); A[1] = h_; A[3] = l_; \
    h_ = max(A[6], A[4]); l_ = min(A[6], A[4]); A[6] = h_; A[4] = l_; \
    h_ = max(A[7], A[5]); l_ = min(A[7], A[5]); A[7] = h_; A[5] = l_; \
    h_ = max(A[8], A[10]); l_ = min(A[8], A[10]); A[8] = h_; A[10] = l_; \
    h_ = max(A[9], A[11]); l_ = min(A[9], A[11]); A[9] = h_; A[11] = l_; \
    h_ = max(A[14], A[12]); l_ = min(A[14], A[12]); A[14] = h_; A[12] = l_; \
    h_ = max(A[15], A[13]); l_ = min(A[15], A[13]); A[15] = h_; A[13] = l_; \
    h_ = max(A[0], A[1]); l_ = min(A[0], A[1]); A[0] = h_; A[1] = l_; \
    h_ = max(A[2], A[3]); l_ = min(A[2], A[3]); A[2] = h_; A[3] = l_; \
    h_ = max(A[5], A[4]); l_ = min(A[5], A[4]); A[5] = h_; A[4] = l_; \
    h_ = max(A[7], A[6]); l_ = min(A[7], A[6]); A[7] = h_; A[6] = l_; \
    h_ = max(A[8], A[9]); l_ = min(A[8], A[9]); A[8] = h_; A[9] = l_; \
    h_ = max(A[10], A[11]); l_ = min(A[10], A[11]); A[10] = h_; A[11] = l_; \
    h_ = max(A[13], A[12]); l_ = min(A[13], A[12]); A[13] = h_; A[12] = l_; \
    h_ = max(A[15], A[14]); l_ = min(A[15], A[14]); A[15] = h_; A[14] = l_; \
    h_ = max(A[0], A[4]); l_ = min(A[0], A[4]); A[0] = h_; A[4] = l_; \
    h_ = max(A[1], A[5]); l_ = min(A[1], A[5]); A[1] = h_; A[5] = l_; \
    h_ = max(A[2], A[6]); l_ = min(A[2], A[6]); A[2] = h_; A[6] = l_; \
    h_ = max(A[3], A[7]); l_ = min(A[3], A[7]); A[3] = h_; A[7] = l_; \
    h_ = max(A[12], A[8]); l_ = min(A[12], A[8]); A[12] = h_; A[8] = l_; \
    h_ = max(A[13], A[9]); l_ = min(A[13], A[9]); A[13] = h_; A[9] = l_; \
    h_ = max(A[14], A[10]); l_ = min(A[14], A[10]); A[14] = h_; A[10] = l_; \
    h_ = max(A[15], A[11]); l_ = min(A[15], A[11]); A[15] = h_; A[11] = l_; \
    h_ = max(A[0], A[2]); l_ = min(A[0], A[2]); A[0] = h_; A[2] = l_; \
    h_ = max(A[1], A[3]); l_ = min(A[1], A[3]); A[1] = h_; A[3] = l_; \
    h_ = max(A[4], A[6]); l_ = min(A[4], A[6]); A[4] = h_; A[6] = l_; \
    h_ = max(A[5], A[7]); l_ = min(A[5], A[7]); A[5] = h_; A[7] = l_; \
    h_ = max(A[10], A[8]); l_ = min(A[10], A[8]); A[10] = h_; A[8] = l_; \
    h_ = max(A[11], A[9]); l_ = min(A[11], A[9]); A[11] = h_; A[9] = l_; \
    h_ = max(A[14], A[12]); l_ = min(A[14], A[12]); A[14] = h_; A[12] = l_; \
    h_ = max(A[15], A[13]); l_ = min(A[15], A[13]); A[15] = h_; A[13] = l_; \
    h_ = max(A[0], A[1]); l_ = min(A[0], A[1]); A[0] = h_; A[1] = l_; \
    h_ = max(A[2], A[3]); l_ = min(A[2], A[3]); A[2] = h_; A[3] = l_; \
    h_ = max(A[4], A[5]); l_ = min(A[4], A[5]); A[4] = h_; A[5] = l_; \
    h_ = max(A[6], A[7]); l_ = min(A[6], A[7]); A[6] = h_; A[7] = l_; \
    h_ = max(A[9], A[8]); l_ = min(A[9], A[8]); A[9] = h_; A[8] = l_; \
    h_ = max(A[11], A[10]); l_ = min(A[11], A[10]); A[11] = h_; A[10] = l_; \
    h_ = max(A[13], A[12]); l_ = min(A[13], A[12]); A[13] = h_; A[12] = l_; \
    h_ = max(A[15], A[14]); l_ = min(A[15], A[14]); A[15] = h_; A[14] = l_; \
    h_ = max(A[0], A[8]); l_ = min(A[0], A[8]); A[0] = h_; A[8] = l_; \
    h_ = max(A[1], A[9]); l_ = min(A[1], A[9]); A[1] = h_; A[9] = l_; \
    h_ = max(A[2], A[10]); l_ = min(A[2], A[10]); A[2] = h_; A[10] = l_; \
    h_ = max(A[3], A[11]); l_ = min(A[3], A[11]); A[3] = h_; A[11] = l_; \
    h_ = max(A[4], A[12]); l_ = min(A[4], A[12]); A[4] = h_; A[12] = l_; \
    h_ = max(A[5], A[13]); l_ = min(A[5], A[13]); A[5] = h_; A[13] = l_; \
    h_ = max(A[6], A[14]); l_ = min(A[6], A[14]); A[6] = h_; A[14] = l_; \
    h_ = max(A[7], A[15]); l_ = min(A[7], A[15]); A[7] = h_; A[15] = l_; \
    h_ = max(A[0], A[4]); l_ = min(A[0], A[4]); A[0] = h_; A[4] = l_; \
    h_ = max(A[1], A[5]); l_ = min(A[1], A[5]); A[1] = h_; A[5] = l_; \
    h_ = max(A[2], A[6]); l_ = min(A[2], A[6]); A[2] = h_; A[6] = l_; \
    h_ = max(A[3], A[7]); l_ = min(A[3], A[7]); A[3] = h_; A[7] = l_; \
    h_ = max(A[8], A[12]); l_ = min(A[8], A[12]); A[8] = h_; A[12] = l_; \
    h_ = max(A[9], A[13]); l_ = min(A[9], A[13]); A[9] = h_; A[13] = l_; \
    h_ = max(A[10], A[14]); l_ = min(A[10], A[14]); A[10] = h_; A[14] = l_; \
    h_ = max(A[11], A[15]); l_ = min(A[11], A[15]); A[11] = h_; A[15] = l_; \
    h_ = max(A[0], A[2]); l_ = min(A[0], A[2]); A[0] = h_; A[2] = l_; \
    h_ = max(A[1], A[3]); l_ = min(A[1], A[3]); A[1] = h_; A[3] = l_; \
    h_ = max(A[4], A[6]); l_ = min(A[4], A[6]); A[4] = h_; A[6] = l_; \
    h_ = max(A[5], A[7]); l_ = min(A[5], A[7]); A[5] = h_; A[7] = l_; \
    h_ = max(A[8], A[10]); l_ = min(A[8], A[10]); A[8] = h_; A[10] = l_; \
    h_ = max(A[9], A[11]); l_ = min(A[9], A[11]); A[9] = h_; A[11] = l_; \
    h_ = max(A[12], A[14]); l_ = min(A[12], A[14]); A[12] = h_; A[14] = l_; \
    h_ = max(A[13], A[15]); l_ = min(A[13], A[15]); A[13] = h_; A[15] = l_; \
    h_ = max(A[0], A[1]); l_ = min(A[0], A[1]); A[0] = h_; A[1] = l_; \
    h_ = max(A[2], A[3]); l_ = min(A[2], A[3]); A[2] = h_; A[3] = l_; \
    h_ = max(A[4], A[5]); l_ = min(A[4], A[5]); A[4] = h_; A[5] = l_; \
    h_ = max(A[6], A[7]); l_ = min(A[6], A[7]); A[6] = h_; A[7] = l_; \
    h_ = max(A[8], A[9]); l_ = min(A[8], A[9]); A[8] = h_; A[9] = l_; \
    h_ = max(A[10], A[11]); l_ = min(A[10], A[11]); A[10] = h_; A[11] = l_; \
    h_ = max(A[12], A[13]); l_ = min(A[12], A[13]); A[12] = h_; A[13] = l_; \
    h_ = max(A[14], A[15]); l_ = min(A[14], A[15]); A[14] = h_; A[15] = l_; \
} while (0)
#define TK_MERGE16(A) do { int h_, l_; \
    h_ = max(A[0], A[8]); l_ = min(A[0], A[8]); A[0] = h_; A[8] = l_; \
    h_ = max(A[1], A[9]); l_ = min(A[1], A[9]); A[1] = h_; A[9] = l_; \
    h_ = max(A[2], A[10]); l_ = min(A[2], A[10]); A[2] = h_; A[10] = l_; \
    h_ = max(A[3], A[11]); l_ = min(A[3], A[11]); A[3] = h_; A[11] = l_; \
    h_ = max(A[4], A[12]); l_ = min(A[4], A[12]); A[4] = h_; A[12] = l_; \
    h_ = max(A[5], A[13]); l_ = min(A[5], A[13]); A[5] = h_; A[13] = l_; \
    h_ = max(A[6], A[14]); l_ = min(A[6], A[14]); A[6] = h_; A[14] = l_; \
    h_ = max(A[7], A[15]); l_ = min(A[7], A[15]); A[7] = h_; A[15] = l_; \
    h_ = max(A[0], A[4]); l_ = min(A[0], A[4]); A[0] = h_; A[4] = l_; \
    h_ = max(A[1], A[5]); l_ = min(A[1], A[5]); A[1] = h_; A[5] = l_; \
    h_ = max(A[2], A[6]); l_ = min(A[2], A[6]); A[2] = h_; A[6] = l_; \
    h_ = max(A[3], A[7]); l_ = min(A[3], A[7]); A[3] = h_; A[7] = l_; \
    h_ = max(A[8], A[12]); l_ = min(A[8], A[12]); A[8] = h_; A[12] = l_; \
    h_ = max(A[9], A[13]); l_ = min(A[9], A[13]); A[9] = h_; A[13] = l_; \
    h_ = max(A[10], A[14]); l_ = min(A[10], A[14]); A[10] = h_; A[14] = l_; \
    h_ = max(A[11], A[15]); l_ = min(A[11], A[15]); A[11] = h_; A[15] = l_; \
    h_ = max(A[0], A[2]); l_ = min(A[0], A[2]); A[0] = h_; A[2] = l_; \
    h_ = max(A[1], A[3]); l_ = min(A[1], A[3]); A[1] = h_; A[3] = l_; \
    h_ = max(A[4], A[6]); l_ = min(A[4], A[6]); A[4] = h_; A[6] = l_; \
    h_ = max(A[5], A[7]); l_ = min(A[5], A[7]); A[5] = h_; A[7] = l_; \
    h_ = max(A[8], A[10]); l_ = min(A[8], A[10]); A[8] = h_; A[10] = l_; \
    h_ = max(A[9], A[11]); l_ = min(A[9], A[11]); A[9] = h_; A[11] = l_; \
    h_ = max(A[12], A[14]); l_ = min(A[12], A[14]); A[12] = h_; A[14] = l_; \
    h_ = max(A[13], A[15]); l_ = min(A[13], A[15]); A[13] = h_; A[15] = l_; \
    h_ = max(A[0], A[1]); l_ = min(A[0], A[1]); A[0] = h_; A[1] = l_; \
    h_ = max(A[2], A[3]); l_ = min(A[2], A[3]); A[2] = h_; A[3] = l_; \
    h_ = max(A[4], A[5]); l_ = min(A[4], A[5]); A[4] = h_; A[5] = l_; \
    h_ = max(A[6], A[7]); l_ = min(A[6], A[7]); A[6] = h_; A[7] = l_; \
    h_ = max(A[8], A[9]); l_ = min(A[8], A[9]); A[8] = h_; A[9] = l_; \
    h_ = max(A[10], A[11]); l_ = min(A[10], A[11]); A[10] = h_; A[11] = l_; \
    h_ = max(A[12], A[13]); l_ = min(A[12], A[13]); A[12] = h_; A[13] = l_; \
    h_ = max(A[14], A[15]); l_ = min(A[14], A[15]); A[14] = h_; A[15] = l_; \
} while (0)

__device__ __forceinline__ int f2ord(float f) { const int b = (int)__float_as_uint(f); return b ^ (int)((unsigned)(b >> 31) >> 1); }
__device__ __forceinline__ float ord2f(int k) { return __uint_as_float((unsigned)(k ^ (int)((unsigned)(k >> 31) >> 1))); }
__device__ __forceinline__ void topk_phase(Frame& F) {
    LAS unsigned char* lds = (LAS unsigned char*)F.lds;
    const int tid = F.tid, lane = F.lane, r32 = lane & 31, hi = lane >> 5, w = F.wave;
    LAS unsigned* slots = (LAS unsigned*)(lds + SLOT_OFF + w * 8192);
    for (int u = F.bid; u < 256; u += F.G) {
        const int tile = u >> 1, hgp = u & 1;
        const int t = tile * 256 + w * 32 + r32;
        const float rl2 = row_rstd(F.PSQ, t) * 1.4426950408889634f;
        for (int hh = 0; hh < 4; ++hh) {
            const int h = hgp * 4 + hh;
            __syncthreads();
#pragma unroll
            for (int i = 0; i < 8; ++i) { const int p = tid + 512 * i, half = p >> 11, row = (p >> 4) & 127, ch = p & 15;
                const u32x4 v = *(const u32x4*)(F.SKb + ((size_t)(h * 2 + half) * 128 + row) * 128 + ch * 8);
                *(LAS u32x4*)(lds + half * 32768 + row * 256 + ((ch ^ (row & 15)) << 4)) = v; }
            __syncthreads();
            int topk[2][16];
#pragma unroll
            for (int half = 0; half < 2; ++half) {
                bf16x8 bq[8];
#pragma unroll
                for (int ks = 0; ks < 8; ++ks) bq[ks] = *(const bf16x8*)(F.QH + (size_t)t * 2048 + h * 256 + half * 128 + 16 * ks + 8 * hi);
                f32x16 s[4];
#pragma unroll
                for (int nb = 0; nb < 4; ++nb) {
#pragma unroll
                    for (int r = 0; r < 16; ++r) s[nb][r] = 0.f;
#pragma unroll
                    for (int ks = 0; ks < 8; ++ks) {
                        const bf16x8 a = *(const LAS bf16x8*)(lds + half * 32768 + (32 * nb + r32) * 256 + (((2 * ks + hi) ^ (r32 & 15)) << 4));
                        s[nb] = __builtin_amdgcn_mfma_f32_32x32x16_bf16(a, bq[ks], s[nb], 0, 0, 0);
                    }
                }
                int kk[4][16];
#pragma unroll
                for (int nb = 0; nb < 4; ++nb)
#pragma unroll
                    for (int r = 0; r < 16; ++r) { const float sv = s[nb][r]; kk[nb][r] = (f2ord(sv) & ~127) | (32 * nb + (r & 3) + 8 * (r >> 2) + 4 * hi); }
                TK_SORT16(kk[0]); TK_SORT16(kk[1]); TK_SORT16(kk[2]); TK_SORT16(kk[3]);
#pragma unroll
                for (int i = 0; i < 16; ++i) { kk[0][i] = max(kk[0][i], kk[1][15 - i]); kk[2][i] = max(kk[2][i], kk[3][15 - i]); }
                TK_MERGE16(kk[0]); TK_MERGE16(kk[2]);
#pragma unroll
                for (int i = 0; i < 16; ++i) kk[0][i] = max(kk[0][i], kk[2][15 - i]);
                TK_MERGE16(kk[0]);
#pragma unroll
                for (int i = 0; i < 16; ++i) { auto rr = __builtin_amdgcn_permlane32_swap((unsigned)kk[0][i], (unsigned)kk[0][i], false, false); kk[1][i] = (int)(hi ? rr[0] : rr[1]); }
#pragma unroll
                for (int i = 0; i < 16; ++i) kk[0][i] = max(kk[0][i], kk[1][15 - i]);
                TK_MERGE16(kk[0]);
#pragma unroll
                for (int i = 0; i < 16; ++i) topk[half][i] = kk[0][i];
            }
            float v1[16], v2[16]; unsigned i1[16], i2[16];
#pragma unroll
            for (int r = 0; r < 16; ++r) { v1[r] = ord2f(topk[0][r] & ~127); i1[r] = (unsigned)topk[0][r] & 127u; v2[r] = ord2f(topk[1][r] & ~127); i2[r] = (unsigned)topk[1][r] & 127u; }
            float cv[NC / 2]; unsigned cp[NC / 2];
#pragma unroll
            for (int c = 0; c < NC / 2; ++c) {
                const float va = v1[CI[2 * c]] + v2[CJ[2 * c]], vb = v1[CI[2 * c + 1]] + v2[CJ[2 * c + 1]];
                const unsigned pa = (i1[CI[2 * c]] << 7) | i2[CJ[2 * c]], pb = (i1[CI[2 * c + 1]] << 7) | i2[CJ[2 * c + 1]];
                cv[c] = hi ? vb : va; cp[c] = hi ? pb : pa;
            }
            float rv[16]; unsigned rp[16];
            {
                int kc[2][16];
#pragma unroll
                for (int c = 0; c < NC / 2; ++c) { kc[c >> 4][c & 15] = (f2ord(cv[c]) & ~63) | (hi << 5) | c; slots[((hi << 5) | c) * 32 + r32] = cp[c]; }
#pragma unroll
                for (int c = NC / 2; c < 32; ++c) kc[c >> 4][c & 15] = (int)0x80000000;
                TK_SORT16(kc[0]); TK_SORT16(kc[1]);
#pragma unroll
                for (int i = 0; i < 16; ++i) kc[0][i] = max(kc[0][i], kc[1][15 - i]);
                TK_MERGE16(kc[0]);
#pragma unroll
                for (int i = 0; i < 16; ++i) { auto rr = __builtin_amdgcn_permlane32_swap((unsigned)kc[0][i], (unsigned)kc[0][i], false, false); kc[1][i] = (int)(hi ? rr[0] : rr[1]); }
#pragma unroll
                for (int i = 0; i < 16; ++i) kc[0][i] = max(kc[0][i], kc[1][15 - i]);
                TK_MERGE16(kc[0]);
#pragma unroll
                for (int r = 0; r < 16; ++r) { rv[r] = ord2f(kc[0][r] & ~63); rp[r] = slots[(kc[0][r] & 63) * 32 + r32]; }
            }
            float sum = 0.f; const float mx0 = rv[0];
#pragma unroll
            for (int r = 0; r < 16; ++r) rv[r] = __builtin_amdgcn_exp2f((rv[r] - mx0) * rl2);
#pragma unroll
            for (int r = 0; r < 16; ++r) sum += rv[r];
            const float inv = 1.0f / sum;
            if (hi == 0) {
                int4* ip = (int4*)(F.IDX + (size_t)t * 128 + h * 16); float4* gp = (float4*)(F.GW + (size_t)t * 128 + h * 16);
#pragma unroll
                for (int q = 0; q < 4; ++q) { ip[q] = make_int4((int)rp[4 * q], (int)rp[4 * q + 1], (int)rp[4 * q + 2], (int)rp[4 * q + 3]);
                    gp[q] = make_float4(rv[4 * q] * inv, rv[4 * q + 1] * inv, rv[4 * q + 2] * inv, rv[4 * q + 3] * inv); }
            }
        }
    }
    __syncthreads();
}
}

namespace peer {
typedef __bf16 bf2 __attribute__((ext_vector_type(2)));
typedef unsigned u32x4 __attribute__((ext_vector_type(4)));
template <int CTRL, int RM> __device__ __forceinline__ float dpp_add(float v) {
    return v + __builtin_bit_cast(float, __builtin_amdgcn_update_dpp(0, __builtin_bit_cast(int, v), CTRL, RM, 0xF, false));
}
__device__ __forceinline__ float wave_total(float v) {
    v = dpp_add<0xB1, 0xF>(v); v = dpp_add<0x4E, 0xF>(v); v = dpp_add<0x141, 0xF>(v); v = dpp_add<0x140, 0xF>(v);
    v = dpp_add<0x142, 0xA>(v); v = dpp_add<0x143, 0xC>(v);
    return __builtin_bit_cast(float, __builtin_amdgcn_readlane(__builtin_bit_cast(int, v), 63));
}
__device__ __forceinline__ float dot2(unsigned a, unsigned b, float c) { return __builtin_amdgcn_fdot2_f32_bf16(__builtin_bit_cast(bf2, a), __builtin_bit_cast(bf2, b), c, false); }
__device__ __forceinline__ float dot8(const u32x4 a, const u32x4 b, float c) { c = dot2(a.x, b.x, c); c = dot2(a.y, b.y, c); c = dot2(a.z, b.z, c); return dot2(a.w, b.w, c); }

__device__ __forceinline__ int wave_isum(int v) {
    v += __builtin_amdgcn_update_dpp(0, v, 0xB1, 0xF, 0xF, false); v += __builtin_amdgcn_update_dpp(0, v, 0x4E, 0xF, 0xF, false);
    v += __builtin_amdgcn_update_dpp(0, v, 0x141, 0xF, 0xF, false); v += __builtin_amdgcn_update_dpp(0, v, 0x140, 0xF, 0xF, false);
    v += __builtin_amdgcn_update_dpp(0, v, 0x142, 0xA, 0xF, false); v += __builtin_amdgcn_update_dpp(0, v, 0x143, 0xC, 0xF, false);
    return __builtin_amdgcn_readlane(v, 63);
}
constexpr int TPW = 8, SLSH = 9;
constexpr int UGRP = 1;
constexpr int VGRP = 2;
constexpr int PW_BYTES = 17440, PW_LIST = 0, PW_XQ = 8192, PW_CNT = 16416;
static_assert(NWAVES * PW_BYTES <= MISC_OFF, "PEER LDS map");
template <int CTRL, int RM> __device__ __forceinline__ int dpp_iadd(int v) { return v + __builtin_amdgcn_update_dpp(0, v, CTRL, RM, 0xF, false); }
template <int CTRL, int RM> __device__ __forceinline__ unsigned dpp_umax(unsigned v) { const unsigned t = (unsigned)__builtin_amdgcn_update_dpp(0, (int)v, CTRL, RM, 0xF, false); return v > t ? v : t; }
__device__ __forceinline__ float wave_max_pos(float f) {
    unsigned v = __float_as_uint(f);
    v = dpp_umax<0xB1, 0xF>(v); v = dpp_umax<0x4E, 0xF>(v); v = dpp_umax<0x141, 0xF>(v); v = dpp_umax<0x140, 0xF>(v); v = dpp_umax<0x142, 0xA>(v); v = dpp_umax<0x143, 0xC>(v);
    return __uint_as_float((unsigned)__builtin_amdgcn_readlane((int)v, 63));
}
__device__ __forceinline__ unsigned long long read_entry(const LAS unsigned char* pw, int j, int p) {
    const int idx = p < 128 ? p : 127;
    return *(const LAS unsigned long long*)(pw + PW_LIST + (j * 128 + idx) * 8);
}
__device__ __forceinline__ int utok(int lane) { return ((lane >> 5) & 1) | (((lane >> 4) & 1) << 1) | (((lane >> 3) & 1) << 2); }
struct UGroup { u32x4 u[TPW]; unsigned long long ent; float us, vs; };
template <int EMASK> __device__ __forceinline__ void issue_ug(Frame& F, UGroup& G, const LAS unsigned char* pw, int p, int lane) {
    const int idx = p < 128 ? p : 127;
    G.ent = *(const LAS unsigned long long*)(pw + PW_LIST + (utok(lane) * 128 + idx) * 8);
    const unsigned ev = (unsigned)G.ent & (unsigned)EMASK;
    typedef float f32x2 __attribute__((ext_vector_type(2)));
    const f32x2 sc = *(const f32x2*)(F.US + 2 * (size_t)ev);
    G.us = sc.x; G.vs = sc.y;
#pragma unroll
    for (int j = 0; j < TPW; ++j) { const unsigned e = (unsigned)__builtin_amdgcn_readlane((int)ev, 32 * (j & 1) + 16 * ((j >> 1) & 1) + 8 * ((j >> 2) & 1)); G.u[j] = *(const u32x4*)(F.U8 + (size_t)e * D + 16 * lane); }
}
__device__ __forceinline__ void compute_ug(const UGroup& G, const u32x4 (&xq)[TPW], LAS unsigned char* pw, int p, int lane, float sxrv) {
    int d[TPW];
#pragma unroll
    for (int j = 0; j < TPW; ++j) {
        d[j] = __builtin_amdgcn_sdot4((int)G.u[j].x, (int)xq[j].x, 0, false); d[j] = __builtin_amdgcn_sdot4((int)G.u[j].y, (int)xq[j].y, d[j], false);
        d[j] = __builtin_amdgcn_sdot4((int)G.u[j].z, (int)xq[j].z, d[j], false); d[j] = __builtin_amdgcn_sdot4((int)G.u[j].w, (int)xq[j].w, d[j], false); }
    int m4[4], m2[2];
#pragma unroll
    for (int i = 0; i < 4; ++i) { auto rr = __builtin_amdgcn_permlane32_swap((unsigned)d[2 * i], (unsigned)d[2 * i + 1], false, false); m4[i] = (int)rr[0] + (int)rr[1]; }
#pragma unroll
    for (int i = 0; i < 2; ++i) { auto rr = __builtin_amdgcn_permlane16_swap((unsigned)m4[2 * i], (unsigned)m4[2 * i + 1], false, false); m2[i] = (int)rr[0] + (int)rr[1]; }
    const int ra = m2[0] + __builtin_amdgcn_update_dpp(0, m2[0], 0x128, 0xF, 0xF, false), rb = m2[1] + __builtin_amdgcn_update_dpp(0, m2[1], 0x128, 0xF, 0xF, false);
    int dv = (lane & 8) ? rb : ra;
    dv = dpp_iadd<0xB1, 0xF>(dv); dv = dpp_iadd<0x4E, 0xF>(dv); dv = dpp_iadd<0x141, 0xF>(dv);
    const float z = (float)dv * G.us * sxrv;
    const float y2 = -2.3022082f * (z + 0.044715f * z * z * z);
    const float cw = __uint_as_float((unsigned)(G.ent >> 32)) * G.vs * z * __builtin_amdgcn_rcpf(1.0f + __builtin_amdgcn_exp2f(y2));
    const int pp = p < 128 ? p : 127;
    if ((lane & 7) == 0) *(LAS float*)(pw + PW_LIST + (utok(lane) * 128 + pp) * 8 + 4) = cw;
}
#define PEER_ACC(A, cw, vv) do { \
    A[0] += cw * (float)(vv.x & 0xff); A[1] += cw * (float)((vv.x >> 8) & 0xff); A[2] += cw * (float)((vv.x >> 16) & 0xff); A[3] += cw * (float)(vv.x >> 24); \
    A[4] += cw * (float)(vv.y & 0xff); A[5] += cw * (float)((vv.y >> 8) & 0xff); A[6] += cw * (float)((vv.y >> 16) & 0xff); A[7] += cw * (float)(vv.y >> 24); \
    A[8] += cw * (float)(vv.z & 0xff); A[9] += cw * (float)((vv.z >> 8) & 0xff); A[10] += cw * (float)((vv.z >> 16) & 0xff); A[11] += cw * (float)(vv.z >> 24); \
    A[12] += cw * (float)(vv.w & 0xff); A[13] += cw * (float)((vv.w >> 8) & 0xff); A[14] += cw * (float)((vv.w >> 16) & 0xff); A[15] += cw * (float)(vv.w >> 24); } while (0)
template <int EMASK, int MODE> __device__ __forceinline__ void peer_phase_t(Frame& F, float* outp, const XcdBarrier& bar) {
    const int gw = F.bid * NWAVES + F.wave, NGW = F.G * NWAVES, lane = F.lane;
    LAS unsigned char* pw = (LAS unsigned char*)F.lds + F.wave * PW_BYTES;
    LAS unsigned* cnt = (LAS unsigned*)(pw + PW_CNT);
    const int rounds = (T / TPW + NGW - 1) / NGW;
    for (int rd = 0; rd < rounds; ++rd) {
        const int wt = gw + rd * NGW; const bool live = wt < T / TPW;
        if (rd) xcd_barrier_local(bar);
        const int t0 = (live ? wt : gw) * TPW;
        u32x4 xq[TPW]; float sxrv;
        {
            int lq = lane; asm volatile("" : "+v"(lq));
            uint4 hA[TPW], hB[TPW]; int id0[TPW], id1[TPW]; float g0[TPW], g1[TPW];
#pragma unroll
            for (int j = 0; j < TPW; ++j) { const size_t t = (size_t)(t0 + j);
                hA[j] = *(const uint4*)(F.HB + t * D + 16 * lq); hB[j] = *(const uint4*)(F.HB + t * D + 16 * lq + 8);
                id0[j] = F.IDX[t * 128 + lq]; id1[j] = F.IDX[t * 128 + 64 + lq]; g0[j] = F.GW[t * 128 + lq]; g1[j] = F.GW[t * 128 + 64 + lq]; }
            const float rstd = row_rstd(F.PSQ, t0 + utok(lq));
            *(LAS u32x4*)(pw + PW_CNT + 16 * lq) = u32x4{0u, 0u, 0u, 0u};
            float msel = 0.f;
#pragma unroll
            for (int j = 0; j < TPW; ++j) {
                float x[16];
                { float xa[8], xb[8]; unpack8(hA[j], xa); unpack8(hB[j], xb);
#pragma unroll
                  for (int i = 0; i < 8; ++i) { x[i] = xa[i]; x[8 + i] = xb[i]; } }
                float m = 0.f;
#pragma unroll
                for (int i = 0; i < 16; ++i) m = fmaxf(m, fabsf(x[i]));
                m = wave_max_pos(m);
                const float inv = m > 0.f ? 127.0f * __builtin_amdgcn_rcpf(m) : 0.f;
                int qi[16];
#pragma unroll
                for (int i = 0; i < 16; ++i) qi[i] = (int)rintf(x[i] * inv) & 0xff;
                xq[j].x = (unsigned)qi[0] | ((unsigned)qi[1] << 8) | ((unsigned)qi[2] << 16) | ((unsigned)qi[3] << 24); xq[j].y = (unsigned)qi[4] | ((unsigned)qi[5] << 8) | ((unsigned)qi[6] << 16) | ((unsigned)qi[7] << 24);
                xq[j].z = (unsigned)qi[8] | ((unsigned)qi[9] << 8) | ((unsigned)qi[10] << 16) | ((unsigned)qi[11] << 24); xq[j].w = (unsigned)qi[12] | ((unsigned)qi[13] << 8) | ((unsigned)qi[14] << 16) | ((unsigned)qi[15] << 24);
                msel = (utok(lq) == j) ? m : msel;
            }
            sxrv = msel * (1.0f / 127.0f) * rstd;
            asm volatile("s_waitcnt lgkmcnt(0)" ::: "memory");
            unsigned r0[TPW], r1[TPW];
#pragma unroll
            for (int j = 0; j < TPW; ++j) {
                r0[j] = __hip_atomic_fetch_add(cnt + j * 32 + (id0[j] >> SLSH), 1u, __ATOMIC_RELAXED, __HIP_MEMORY_SCOPE_WORKGROUP);
                r1[j] = __hip_atomic_fetch_add(cnt + j * 32 + (id1[j] >> SLSH), 1u, __ATOMIC_RELAXED, __HIP_MEMORY_SCOPE_WORKGROUP); }
            asm volatile("s_waitcnt lgkmcnt(0)" ::: "memory");
#pragma unroll
            for (int j = 0; j < TPW; ++j) {
                const int own = lq < 32 ? (int)cnt[j * 32 + lq] : 0; int c = own;
                c = dpp_iadd<0x111, 0xF>(c); c = dpp_iadd<0x112, 0xF>(c); c = dpp_iadd<0x114, 0xF>(c); c = dpp_iadd<0x118, 0xF>(c); c = dpp_iadd<0x142, 0xA>(c);
                if (lq < 32) cnt[j * 32 + lq] = (unsigned)(c - own); }
            asm volatile("s_waitcnt lgkmcnt(0)" ::: "memory");
#pragma unroll
            for (int j = 0; j < TPW; ++j) {
                const unsigned p0 = cnt[j * 32 + (id0[j] >> SLSH)] + r0[j], p1 = cnt[j * 32 + (id1[j] >> SLSH)] + r1[j];
                *(LAS unsigned long long*)(pw + PW_LIST + (j * 128 + p0) * 8) = (unsigned long long)(unsigned)id0[j] | ((unsigned long long)__float_as_uint(g0[j]) << 32);
                *(LAS unsigned long long*)(pw + PW_LIST + (j * 128 + p1) * 8) = (unsigned long long)(unsigned)id1[j] | ((unsigned long long)__float_as_uint(g1[j]) << 32); }
            asm volatile("s_waitcnt lgkmcnt(0)" ::: "memory");
        }
        {
            UGroup G[UGRP];
#pragma unroll
            for (int q = 0; q < UGRP; ++q) issue_ug<EMASK>(F, G[q], pw, q, lane);
            for (int p = 0; p < 128; p += UGRP) {
                if (p == 64) xcd_barrier_local(bar);
#pragma unroll
                for (int q = 0; q < UGRP; ++q) { compute_ug(G[q], xq, pw, p + q, lane, sxrv); issue_ug<EMASK>(F, G[q], pw, p + UGRP + q, lane); }
            }
        }
        asm volatile("s_waitcnt lgkmcnt(0)" ::: "memory");
        xcd_barrier_local(bar);
        float stok[TPW];
        int lc = lane; asm volatile("" : "+v"(lc));
#pragma unroll
        for (int j = 0; j < TPW; ++j) {
            const unsigned long long a0 = *(const LAS unsigned long long*)(pw + PW_LIST + (j * 128 + lc) * 8), a1 = *(const LAS unsigned long long*)(pw + PW_LIST + (j * 128 + 64 + lc) * 8);
            const float c0 = __uint_as_float((unsigned)(a0 >> 32)), c1 = __uint_as_float((unsigned)(a1 >> 32));
            const float m = wave_max_pos(fmaxf(fabsf(c0), fabsf(c1)));
            const float sc = m > 0.f ? 127.0f * __builtin_amdgcn_rcpf(m) : 0.f;
            stok[j] = m * (1.0f / 127.0f);
            *(LAS unsigned short*)(pw + PW_XQ + (j * 128 + lc) * 2) = (unsigned short)(unsigned)a0; *(LAS unsigned short*)(pw + PW_XQ + (j * 128 + 64 + lc) * 2) = (unsigned short)(unsigned)a1;
            *(LAS signed char*)(pw + PW_XQ + 2048 + j * 128 + lc) = (signed char)(int)rintf(c0 * sc); *(LAS signed char*)(pw + PW_XQ + 2048 + j * 128 + 64 + lc) = (signed char)(int)rintf(c1 * sc);
        }
        asm volatile("s_waitcnt lgkmcnt(0)" ::: "memory");
        int acc[TPW][16];
#pragma unroll
        for (int j = 0; j < TPW; ++j)
#pragma unroll
            for (int i = 0; i < 16; ++i) acc[j][i] = 0;
        {
            struct VG4 { u32x4 r[4]; int cw4; };
            VG4 S[VGRP];
#define PEER_VISSUE(S_, j_, gp_) do { const int g_ = (gp_) < 32 ? (gp_) : 31; \
                const unsigned long long ev_ = *(const LAS unsigned long long*)(pw + PW_XQ + ((j_) * 128 + 4 * g_) * 2); \
                const unsigned s0_ = (unsigned)__builtin_amdgcn_readfirstlane((int)(unsigned)ev_), s1_ = (unsigned)__builtin_amdgcn_readfirstlane((int)(unsigned)(ev_ >> 32)); \
                (S_).cw4 = __builtin_amdgcn_readfirstlane(*(const LAS int*)(pw + PW_XQ + 2048 + (j_) * 128 + 4 * g_)); \
                (S_).r[0] = *(const u32x4*)(F.V8 + (size_t)((s0_ & 0xffffu) & (unsigned)EMASK) * D + 16 * lane); (S_).r[1] = *(const u32x4*)(F.V8 + (size_t)((s0_ >> 16) & (unsigned)EMASK) * D + 16 * lane); \
                (S_).r[2] = *(const u32x4*)(F.V8 + (size_t)((s1_ & 0xffffu) & (unsigned)EMASK) * D + 16 * lane); (S_).r[3] = *(const u32x4*)(F.V8 + (size_t)((s1_ >> 16) & (unsigned)EMASK) * D + 16 * lane); } while (0)
#define PEER_VTR(A_, i_, a0_, a1_, a2_, a3_, cw_) do { \
                const unsigned x01l_ = __builtin_amdgcn_perm(a1_, a0_, 0x05010400u), x01h_ = __builtin_amdgcn_perm(a1_, a0_, 0x07030602u); \
                const unsigned x23l_ = __builtin_amdgcn_perm(a3_, a2_, 0x05010400u), x23h_ = __builtin_amdgcn_perm(a3_, a2_, 0x07030602u); \
                A_[4 * (i_) + 0] = __builtin_amdgcn_sdot4((int)__builtin_amdgcn_perm(x23l_, x01l_, 0x05040100u), cw_, A_[4 * (i_) + 0], false); \
                A_[4 * (i_) + 1] = __builtin_amdgcn_sdot4((int)__builtin_amdgcn_perm(x23l_, x01l_, 0x07060302u), cw_, A_[4 * (i_) + 1], false); \
                A_[4 * (i_) + 2] = __builtin_amdgcn_sdot4((int)__builtin_amdgcn_perm(x23h_, x01h_, 0x05040100u), cw_, A_[4 * (i_) + 2], false); \
                A_[4 * (i_) + 3] = __builtin_amdgcn_sdot4((int)__builtin_amdgcn_perm(x23h_, x01h_, 0x07060302u), cw_, A_[4 * (i_) + 3], false); } while (0)
#pragma unroll
            for (int n = 0; n < VGRP; ++n) PEER_VISSUE(S[n], n % TPW, n / TPW);
            for (int gp = 0; gp < 32; ++gp) {
                if (gp == 16) xcd_barrier_local(bar);
#pragma unroll
                for (int j = 0; j < TPW; ++j) {
                    VG4& G = S[j % VGRP];
                    PEER_VTR(acc[j], 0, G.r[0].x, G.r[1].x, G.r[2].x, G.r[3].x, G.cw4); PEER_VTR(acc[j], 1, G.r[0].y, G.r[1].y, G.r[2].y, G.r[3].y, G.cw4);
                    PEER_VTR(acc[j], 2, G.r[0].z, G.r[1].z, G.r[2].z, G.r[3].z, G.cw4); PEER_VTR(acc[j], 3, G.r[0].w, G.r[1].w, G.r[2].w, G.r[3].w, G.cw4);
                    PEER_VISSUE(G, (j + VGRP) % TPW, gp + (j + VGRP) / TPW);
                }
            }
#undef PEER_VISSUE
#undef PEER_VTR
        }
#pragma unroll
        for (int j = 0; j < TPW; ++j) {
            float* orow = outp + (size_t)(t0 + j) * D + 16 * lane;
            float y[16]; float ss = 0.f;
            { float ha[8], hb[8]; unpack8(*(const uint4*)(F.HB + (size_t)(t0 + j) * D + 16 * lane), ha); unpack8(*(const uint4*)(F.HB + (size_t)(t0 + j) * D + 16 * lane + 8), hb);
#pragma unroll
              for (int i = 0; i < 8; ++i) { y[i] = ha[i] + stok[j] * (float)acc[j][i]; y[8 + i] = hb[i] + stok[j] * (float)acc[j][8 + i]; } }
#pragma unroll
            for (int i = 0; i < 16; ++i) ss += y[i] * y[i];
            const float r = 1.0f / sqrtf(wave_total(ss) * (1.f / D) + RMS_EPS);
#pragma unroll
            for (int q = 0; q < 4; ++q) { const float4 wv = *(const float4*)(F.nfin + 16 * lane + 4 * q);
                *(float4*)(orow + 4 * q) = make_float4(y[4 * q] * r * wv.x, y[4 * q + 1] * r * wv.y, y[4 * q + 2] * r * wv.z, y[4 * q + 3] * r * wv.w); }
        }
        asm volatile("s_waitcnt lgkmcnt(0)" ::: "memory");
    }
}
}

constexpr int N_PHASES = 11;
__global__ void __launch_bounds__(NTHREADS, 2) mk_fwd(Args args) {
    extern __shared__ __attribute__((aligned(16))) unsigned char lds[];
    Frame F;
    F.lds = lds;
    F.tid = threadIdx.x; F.lane = F.tid & 63; F.wave = __builtin_amdgcn_readfirstlane(F.tid >> 6);
    F.G = gridDim.x; F.bid = blockIdx.x;
    F.x = args.in[0]; F.nmw = args.in[1]; F.w_in = args.in[2]; F.lbp = args.in[3]; F.hnw = args.in[4]; F.dlam = args.in[5]; F.dnw = args.in[6];
    F.w_out = args.in[7]; F.nfw = args.in[8]; F.wq = args.in[9]; F.sk = args.in[10]; F.u = args.in[11]; F.v = args.in[12]; F.nfin = args.in[13];
    F.out = args.out;
    unsigned char* ws = args.ws;
    F.WinT = (bf16*)(ws + WS_WIN); F.WoT = (bf16*)(ws + WS_WO); F.WqT = (bf16*)(ws + WS_WQ); F.SKb = (bf16*)(ws + WS_SK);
    F.XN = (bf16*)(ws + WS_XN); F.MIX = (bf16*)(ws + WS_MIX);
    F.PROJ = (bf16*)(ws + WS_PROJ); F.HB = (bf16*)(ws + WS_HB); F.QH = (bf16*)(ws + WS_QH);
    F.HA = (float*)(ws + WS_HA); F.HO = (float*)(ws + WS_HO); F.PSQ = (float*)(ws + WS_PSQ); F.GW = (float*)(ws + WS_G);
    F.IDX = (int*)(ws + WS_IDX); F.DECG = (float*)(ws + WS_DECG);
    F.U8 = ws + WS_U8; F.V8 = ws + WS_V8; F.US = (float*)(ws + WS_US);
    const int lo = args.ph_lo, hi = args.ph_hi;
    volatile LAS unsigned* MISC = (volatile LAS unsigned*)((LAS unsigned char*)lds + MISC_OFF);
    if (F.tid < 32) MISC[F.tid] = 0u;
    __syncthreads();
    XcdBarrier bar; bar.bar = (unsigned*)(ws + WS_CTL) + 4096; bar.x = 0; bar.st = nullptr;
    if (hi - lo > 1) bar = xcd_barrier_post((unsigned*)(ws + WS_CTL) + 4096, MISC + 8);
#define IN(k) (lo <= (k) && (k) < hi)
#define SEAM(k) do { if (IN(k) && IN((k) + 1)) xcd_barrier(bar); } while (0)
    if (IN(0)) { stage_prep(F);
    }
    SEAM(0);
    if (IN(1)) { pg8::Gemm g{F.XN, F.WinT, T, DIN, D}; pg8::StaticOrder S; S.init(T, DIN, F.G, F.bid); EpiIn E{F.PROJ, F.HA, F.lbp};
        pg8::gemm_phase<EpiIn, pg8::StaticOrder, true, true>((PG8_LAS unsigned char*)lds, g, S, E); }
    if (IN(1) && IN(3)) xcd_barrier(bar);
    if (IN(3)) for (int task = F.bid; task < BATCH * 4 * 64; task += F.G) hg::hgrn_pre(F, task);
    if (IN(3) && IN(4)) xcd_barrier(bar);
    if (IN(4)) { for (int unit = F.bid; unit < 32; unit += F.G) hg::hgrn_scan(F, unit >> 2, unit & 3);
        da::attn_phase(F, (unsigned*)(ws + WS_CTL), MISC);
    }
    SEAM(5);
    if (IN(6)) { pg8::Gemm g{F.MIX, F.WoT, T, D, D}; pg8::StaticOrder S; S.init(T, D, F.G, F.bid); EpiOut E{F.x, F.HB, F.PSQ};
        pg8::gemm_phase<EpiOut, pg8::StaticOrder, true, true>((PG8_LAS unsigned char*)lds, g, S, E); }
    if (IN(6) && IN(8)) xcd_barrier(bar);
    if (IN(8)) { pg8::Gemm g{F.HB, F.WqT, T, 2048, D}; pg8::StaticOrder S; S.init(T, 2048, F.G, F.bid); EpiQ E{F.QH};
        pg8::gemm_phase<EpiQ, pg8::StaticOrder, true, true>((PG8_LAS unsigned char*)lds, g, S, E); }
    SEAM(8);
    if (IN(9)) tk::topk_phase(F);
    SEAM(9);
    if (IN(10)) { peer::peer_phase_t<0xffff, 0>(F, F.out, bar);
    }
#undef IN
#undef SEAM
}

extern "C" void kernel_launch(void* const* d_in, const int* in_sizes, int n_in, void* d_out, int out_size, void* d_ws, size_t ws_size, hipStream_t stream) {
    static int grid = 0;
    if (grid == 0) {
        if (n_in != 14 || in_sizes[0] != T * D || out_size != T * D || ws_size < WS_END) {
            fprintf(stderr, "kernel_launch: unexpected shapes: n_in %d in0 %d out %d ws %zu (need %zu)\n", n_in, n_in > 0 ? in_sizes[0] : -1, out_size, ws_size, (size_t)WS_END);
            grid = -1; return; }
        int dev = 0, cus = 0;
        if (hipGetDevice(&dev) != hipSuccess || hipDeviceGetAttribute(&cus, hipDeviceAttributeMultiprocessorCount, dev) != hipSuccess) { grid = -1; return; }
        if (hipFuncSetAttribute((const void*)mk_fwd, hipFuncAttributeMaxDynamicSharedMemorySize, LDS_BYTES) != hipSuccess) { fprintf(stderr, "kernel_launch: hipFuncSetAttribute failed\n"); grid = -1; return; }
        int per_cu = 0;
        if (hipOccupancyMaxActiveBlocksPerMultiprocessor(&per_cu, (const void*)mk_fwd, NTHREADS, LDS_BYTES) != hipSuccess || per_cu < 1) {
            fprintf(stderr, "kernel_launch: the occupancy query reports %d workgroups per CU for %d threads / %d B of LDS; nothing launched\n", per_cu, NTHREADS, LDS_BYTES); grid = -1; return; }
        (void)hipGetLastError();
        grid = cus;
    }
    if (grid < 0) return;
    Args a{};
    for (int i = 0; i < 14; ++i) a.in[i] = (const float*)d_in[i];
    a.out = (float*)d_out; a.ws = (unsigned char*)d_ws;
    if (hipMemsetAsync((char*)d_ws + WS_CTL, 0, 64 * 1024, stream) != hipSuccess) { fprintf(stderr, "kernel_launch: memset failed\n"); return; }
    a.ph_lo = 0; a.ph_hi = N_PHASES;
    hipLaunchKernelGGL(mk_fwd, dim3(grid), dim3(NTHREADS), LDS_BYTES, stream, a);
}
```

```cpp
#include <hip/hip_runtime.h>
#include <cstdio>
#include <cstdint>

constexpr int BATCH = 8, SEQ = 4096, T = BATCH * SEQ, D = 1024, DIN = 3584;
constexpr int NEXP = 16384;
constexpr float RMS_EPS = 1e-6f;
constexpr int NWAVES = 8, NTHREADS = NWAVES * 64;

constexpr int C_HQ = 0, C_HF = 512, C_HI = 1024, C_HG = 1536, C_AQ = 2048, C_AK = 2560, C_AV = 3072;

constexpr size_t MiB = 1u << 20;
constexpr size_t WS_CTL = 0;
constexpr size_t WS_WIN = 2 * MiB;
constexpr size_t WS_WO = 9 * MiB;
constexpr size_t WS_WQ = 11 * MiB;
constexpr size_t WS_SK = 15 * MiB;
constexpr size_t WS_U8 = 16 * MiB;
constexpr size_t WS_V8 = 32 * MiB;
constexpr size_t WS_US = 48 * MiB;
constexpr size_t WS_XN = 80 * MiB;
constexpr size_t WS_MIX = 80 * MiB;
constexpr size_t WS_PROJ = 144 * MiB;
constexpr size_t WS_HA = 368 * MiB;
constexpr size_t WS_HO = 432 * MiB;
constexpr size_t WS_PSQ = 496 * MiB;
constexpr size_t WS_HB = 144 * MiB;
constexpr size_t WS_QH = 208 * MiB;
constexpr size_t WS_IDX = 336 * MiB;
constexpr size_t WS_G = 352 * MiB;
constexpr size_t WS_DECG = 498 * MiB;
constexpr size_t WS_END = 499 * MiB;

constexpr int LDS_BYTES = 147456;
constexpr int MISC_OFF = 139520 + 64;

typedef unsigned short bf16;
#define LAS __attribute__((address_space(3)))

__device__ __forceinline__ unsigned f2bf(float f) { unsigned u = __builtin_bit_cast(unsigned, f); return (u + 0x7fffu + ((u >> 16) & 1u)) >> 16; }
__device__ __forceinline__ unsigned pk2(float lo, float hi) { return f2bf(lo) | (f2bf(hi) << 16); }
__device__ __forceinline__ float bf2f(unsigned b) { return __builtin_bit_cast(float, b << 16); }
__device__ __forceinline__ float bflo(unsigned w) { return __builtin_bit_cast(float, w << 16); }
__device__ __forceinline__ float bfhi(unsigned w) { return __builtin_bit_cast(float, w & 0xffff0000u); }
__device__ __forceinline__ float wave_sum(float v) {
#pragma unroll
    for (int o = 1; o < 64; o <<= 1) v += __shfl_xor(v, o);
    return v;
}


#define GAS __attribute__((address_space(1)))
typedef GAS unsigned gu32;
#define RLX_AGENT __ATOMIC_RELAXED, __HIP_MEMORY_SCOPE_AGENT
#define XB_TMO      128
#define XB_XCNT(j)  (256  + 64 * (j))
#define XB_XSUB(j)  (1280 + 64 * (j))
#define XB_XGEN(j)  (2304 + 64 * (j))
#define XB_TOP      3328
#define XB_TOPGEN   3392
#define XCD_BAR_WORDS 3456
#define XB_SPIN_CAP (1u << 22)
__device__ __forceinline__ unsigned xb_ld(unsigned* p)              { return __hip_atomic_load(p, __ATOMIC_RELAXED, __HIP_MEMORY_SCOPE_AGENT); }
__device__ __forceinline__ unsigned xb_add(unsigned* p, unsigned v) { return __hip_atomic_fetch_add(p, v, __ATOMIC_RELAXED, __HIP_MEMORY_SCOPE_AGENT); }
__device__ __forceinline__ unsigned xb_xcc_id() { return (unsigned)__builtin_amdgcn_s_getreg((3 << 11) | 20) & 0xFu; }
#define XB_SPIN(cond, bar) do { unsigned _sp = 0; while (cond) { __builtin_amdgcn_s_sleep(1); \
    if ((++_sp & 255u) == 0u) { if (xb_ld(&(bar)[XB_TMO])) break; if (_sp > XB_SPIN_CAP) { atomicAdd(&(bar)[XB_TMO], 1u); break; } } } } while (0)
struct XcdBarrier { unsigned* bar; unsigned x; volatile LAS unsigned* st; };
__device__ __forceinline__ XcdBarrier xcd_barrier_post(unsigned* bar, volatile LAS unsigned* st) {
    XcdBarrier b; b.bar = bar; b.x = xb_xcc_id(); b.st = st;
    if (threadIdx.x == 0) (void)xb_add(&bar[XB_XCNT(b.x)], 1u);
    return b;
}
__device__ __forceinline__ void xcd_barrier_complete(unsigned* bar, unsigned x, unsigned& nloc, unsigned& nx) {
    const unsigned G = gridDim.x * gridDim.y * gridDim.z;
    unsigned sum, cnt, mine, sp = 0u;
    for (;;) {
        sum = 0u; cnt = 0u; mine = 0u;
#pragma unroll
        for (unsigned j = 0; j < 16; ++j) { const unsigned c = xb_ld(&bar[XB_XCNT(j)]); sum += c; cnt += (c > 0u) ? 1u : 0u; mine = (j == x) ? c : mine; }
        if (sum == G) break;
        __builtin_amdgcn_s_sleep(1);
        if ((++sp & 255u) == 0u) { if (xb_ld(&bar[XB_TMO])) break; if (sp > XB_SPIN_CAP) { atomicAdd(&bar[XB_TMO], 1u); break; } }
    }
    nloc = mine > 0u ? mine : 1u; nx = cnt > 0u ? cnt : 1u;
}
__device__ __forceinline__ void xcd_barrier(const XcdBarrier& b) {
    asm volatile("s_waitcnt vmcnt(0)" ::: "memory");
    __syncthreads();
    if (threadIdx.x == 0) {
        unsigned* bar = b.bar;
        __builtin_amdgcn_s_waitcnt(0);
        unsigned nloc = b.st[0], nx = b.st[1];
        if (nloc == 0u) { xcd_barrier_complete(bar, b.x, nloc, nx); b.st[0] = nloc; b.st[1] = nx; }
        const unsigned old = xb_add(&bar[XB_XSUB(b.x)], 1u);
        const unsigned gen = old / nloc;
        if (old + 1u == (gen + 1u) * nloc) {
            __builtin_amdgcn_fence(__ATOMIC_RELEASE, "agent");
            asm volatile("s_waitcnt vmcnt(0)" ::: "memory");
            const unsigned og = xb_add(&bar[XB_TOP], 1u);
            const unsigned tg = og / nx;
            if (og + 1u == (tg + 1u) * nx) xb_add(&bar[XB_TOPGEN], 1u);
            else XB_SPIN(xb_ld(&bar[XB_TOPGEN]) == tg, bar);
            __builtin_amdgcn_fence(__ATOMIC_ACQUIRE, "agent");
            xb_add(&bar[XB_XGEN(b.x)], 1u);
            asm volatile("s_waitcnt vmcnt(0)" ::: "memory");
        } else {
            XB_SPIN(xb_ld(&bar[XB_XGEN(b.x)]) == gen, bar);
            __builtin_amdgcn_fence(__ATOMIC_ACQUIRE, "agent");
            asm volatile("s_waitcnt vmcnt(0)" ::: "memory");
        }
    }
    __syncthreads();
}

__device__ __forceinline__ void xcd_barrier_light(const XcdBarrier& b) {
    __syncthreads();
    if (threadIdx.x == 0) {
        unsigned* bar = b.bar;
        unsigned nloc = b.st[0], nx = b.st[1];
        if (nloc == 0u) { xcd_barrier_complete(bar, b.x, nloc, nx); b.st[0] = nloc; b.st[1] = nx; }
        const unsigned old = xb_add(&bar[XB_XSUB(b.x)], 1u);
        const unsigned gen = old / nloc;
        if (old + 1u == (gen + 1u) * nloc) {
            const unsigned og = xb_add(&bar[XB_TOP], 1u);
            const unsigned tg = og / nx;
            if (og + 1u == (tg + 1u) * nx) xb_add(&bar[XB_TOPGEN], 1u);
            else XB_SPIN(xb_ld(&bar[XB_TOPGEN]) == tg, bar);
            xb_add(&bar[XB_XGEN(b.x)], 1u);
        } else {
            XB_SPIN(xb_ld(&bar[XB_XGEN(b.x)]) == gen, bar);
        }
    }
    __syncthreads();
}

__device__ __forceinline__ void xcd_barrier_local(const XcdBarrier& b) {
    __syncthreads();
    if (threadIdx.x == 0) {
        unsigned* bar = b.bar;
        unsigned nloc = b.st[0], nx = b.st[1];
        if (nloc == 0u) { xcd_barrier_complete(bar, b.x, nloc, nx); b.st[0] = nloc; b.st[1] = nx; }
        const unsigned old = xb_add(&bar[XB_XSUB(b.x)], 1u);
        const unsigned gen = old / nloc;
        if (old + 1u == (gen + 1u) * nloc) xb_add(&bar[XB_XGEN(b.x)], 1u);
        else XB_SPIN(xb_ld(&bar[XB_XGEN(b.x)]) == gen, bar);
    }
    __syncthreads();
}

struct Args { const float* in[14]; float* out; unsigned char* ws; int ph_lo, ph_hi; };

struct Frame {
    unsigned char* lds;
    int tid, lane, wave, G, bid;
    const float *x, *nmw, *w_in, *lbp, *hnw, *dlam, *dnw, *w_out, *nfw, *wq, *sk, *u, *v, *nfin;
    float* out;
    bf16 *WinT, *WoT, *WqT, *SKb, *XN, *MIX, *PROJ, *HB, *QH;
    float *HA, *HO, *PSQ, *GW, *US, *DECG;
    int* IDX;
    unsigned char *U8, *V8;
};

__device__ __forceinline__ void transpose_item(const float* W, const float* scale, int K, int N, bf16* WT, float* scr, int item, int lane) {
    const int nblk = N / 32, kb = item / nblk, nb = item % nblk, k0 = 64 * kb, n0 = 32 * nb;
#pragma unroll 8
    for (int i = 0; i < 32; ++i) { const int kk = 2 * i + (lane >> 5); float s = scale ? scale[k0 + kk] : 1.0f; scr[kk * 33 + (lane & 31)] = W[(size_t)(k0 + kk) * N + n0 + (lane & 31)] * s; }
    __builtin_amdgcn_s_waitcnt(0xc07f); asm volatile("" ::: "memory");
    const int c = lane & 7;
#pragma unroll
    for (int j = 0; j < 4; ++j) { const int n = (lane >> 3) + 8 * j; const float* s = scr + (8 * c) * 33 + n;
        uint4 o; o.x = pk2(s[0 * 33], s[1 * 33]); o.y = pk2(s[2 * 33], s[3 * 33]); o.z = pk2(s[4 * 33], s[5 * 33]); o.w = pk2(s[6 * 33], s[7 * 33]);
        *(uint4*)(WT + (size_t)(n0 + n) * K + k0 + 8 * c) = o; }
    __builtin_amdgcn_s_waitcnt(0xc07f); asm volatile("" ::: "memory");
}

__device__ __forceinline__ void stage_prep(Frame& F, const int parts = 7) {
    float* scr = (float*)(F.lds + F.wave * 16384);
    const int gw = F.bid * NWAVES + F.wave, NGW = F.G * NWAVES;
    constexpr int I_IN = (D / 64) * (DIN / 32), I_O = (D / 64) * (D / 32), I_Q = (D / 64) * (2048 / 32);
    if (parts & 1) for (int it = gw; it < I_IN + I_O + I_Q; it += NGW) {
        int r = it;
        if (r < I_IN) { transpose_item(F.w_in, nullptr, D, DIN, F.WinT, scr, r, F.lane); continue; } r -= I_IN;
        if (r < I_O) { transpose_item(F.w_out, nullptr, D, D, F.WoT, scr, r, F.lane); continue; } r -= I_O;
        transpose_item(F.wq, F.nfw, D, 2048, F.WqT, scr, r, F.lane);
    }
    const size_t gt = (size_t)F.bid * NTHREADS + F.tid, NGT = (size_t)F.G * NTHREADS;
    if (parts & 2) for (int e = gw; e < NEXP; e += NGW) {
        const float4* ur = (const float4*)(F.u + (size_t)e * D) + F.lane; const float4* vr = (const float4*)(F.v + (size_t)e * D) + F.lane; const float4* wr = (const float4*)F.nfw + F.lane;
        float4 a[4], b[4]; float mu = 0.f, mv = 0.f;
#pragma unroll
        for (int j = 0; j < 4; ++j) { const float4 w = wr[64 * j]; a[j] = ur[64 * j]; b[j] = vr[64 * j]; a[j].x *= w.x; a[j].y *= w.y; a[j].z *= w.z; a[j].w *= w.w;
            mu = fmaxf(mu, fmaxf(fmaxf(fabsf(a[j].x), fabsf(a[j].y)), fmaxf(fabsf(a[j].z), fabsf(a[j].w))));
            mv = fmaxf(mv, fmaxf(fmaxf(fabsf(b[j].x), fabsf(b[j].y)), fmaxf(fabsf(b[j].z), fabsf(b[j].w)))); }
#pragma unroll
        for (int o = 1; o < 64; o <<= 1) { mu = fmaxf(mu, __shfl_xor(mu, o)); mv = fmaxf(mv, __shfl_xor(mv, o)); }
        const float iu = mu > 0.f ? 127.0f / mu : 0.f, iv = mv > 0.f ? 127.0f / mv : 0.f;
        unsigned* u8 = (unsigned*)(F.U8 + (size_t)e * D) + F.lane; unsigned* v8 = (unsigned*)(F.V8 + (size_t)e * D) + F.lane;
#pragma unroll
        for (int j = 0; j < 4; ++j) {
            const int q0 = (int)rintf(a[j].x * iu), q1 = (int)rintf(a[j].y * iu), q2 = (int)rintf(a[j].z * iu), q3 = (int)rintf(a[j].w * iu);
            u8[64 * j] = (unsigned)(q0 & 0xff) | ((unsigned)(q1 & 0xff) << 8) | ((unsigned)(q2 & 0xff) << 16) | ((unsigned)(q3 & 0xff) << 24);
            const int p0 = (int)rintf(b[j].x * iv), p1 = (int)rintf(b[j].y * iv), p2 = (int)rintf(b[j].z * iv), p3 = (int)rintf(b[j].w * iv);
            v8[64 * j] = (unsigned)(p0 & 0xff) | ((unsigned)(p1 & 0xff) << 8) | ((unsigned)(p2 & 0xff) << 16) | ((unsigned)(p3 & 0xff) << 24); }
        if (F.lane == 0) { F.US[2 * e] = mu * (1.0f / 127.0f); F.US[2 * e + 1] = mv * (1.0f / 127.0f); }
    }
    if (parts & 2) for (size_t i = gt; i < (size_t)8 * 2 * 128 * 128 / 8; i += NGT) {
        const float4 c = *(const float4*)(F.sk + i * 8), d = *(const float4*)(F.sk + i * 8 + 4);
        uint4 p; p.x = pk2(c.x, c.y); p.y = pk2(c.z, c.w); p.z = pk2(d.x, d.y); p.w = pk2(d.z, d.w);
        *(uint4*)(F.SKb + i * 8) = p;
    }
    if (parts & 4) {
        float4 wv[4];
#pragma unroll
        for (int j = 0; j < 4; ++j) wv[j] = ((const float4*)F.nmw)[F.lane + 64 * j];
        for (int m = gw; m < T; m += 2 * NGW) {
            const int m1 = m + NGW; const bool has1 = m1 < T;
            const float4* xr0 = (const float4*)(F.x + (size_t)m * D) + F.lane; const float4* xr1 = (const float4*)(F.x + (size_t)(has1 ? m1 : m) * D) + F.lane;
            float4 v0[4], v1[4]; float s0 = 0.f, s1 = 0.f;
#pragma unroll
            for (int j = 0; j < 4; ++j) { v0[j] = xr0[64 * j]; v1[j] = xr1[64 * j]; }
#pragma unroll
            for (int j = 0; j < 4; ++j) { s0 += (v0[j].x * v0[j].x + v0[j].y * v0[j].y) + (v0[j].z * v0[j].z + v0[j].w * v0[j].w); s1 += (v1[j].x * v1[j].x + v1[j].y * v1[j].y) + (v1[j].z * v1[j].z + v1[j].w * v1[j].w); }
#pragma unroll
            for (int o = 1; o < 64; o <<= 1) { s0 += __shfl_xor(s0, o); s1 += __shfl_xor(s1, o); }
            const float r0 = 1.0f / sqrtf(s0 * (1.f / D) + RMS_EPS), r1 = 1.0f / sqrtf(s1 * (1.f / D) + RMS_EPS);
            unsigned long long* o0 = (unsigned long long*)(F.XN + (size_t)m * D) + F.lane; unsigned long long* o1 = (unsigned long long*)(F.XN + (size_t)m1 * D) + F.lane;
#pragma unroll
            for (int j = 0; j < 4; ++j) {
                o0[64 * j] = (unsigned long long)pk2(v0[j].x * r0 * wv[j].x, v0[j].y * r0 * wv[j].y) | ((unsigned long long)pk2(v0[j].z * r0 * wv[j].z, v0[j].w * r0 * wv[j].w) << 32);
                if (has1) o1[64 * j] = (unsigned long long)pk2(v1[j].x * r1 * wv[j].x, v1[j].y * r1 * wv[j].y) | ((unsigned long long)pk2(v1[j].z * r1 * wv[j].z, v1[j].w * r1 * wv[j].w) << 32); }
        }
    }
}

namespace pg8 {
#define PG8_LAS __attribute__((address_space(3)))
typedef unsigned short bf16_t;
typedef short bf16x8 __attribute__((ext_vector_type(8)));
typedef float f32x4 __attribute__((ext_vector_type(4)));
typedef unsigned u32x4 __attribute__((ext_vector_type(4)));
constexpr int BM = 256, BK = 64, HALF = 128, HTB = HALF * BK * 2  , STAGE_BYTES = 8 * HTB, NXCD = 8, WGM = 4;

__host__ __device__ __forceinline__ int lds_byte(int r, int c) { const int st = (r >> 4) * 2 + (c >> 5), rr = r & 15, cc = c & 31, ob = rr * 64 + cc * 2; return st * 1024 + (ob ^ (((ob >> 9) & 1) << 5)); }
__host__ __device__ __forceinline__ void stage_rc(int b, int& R, int& C) { const int st = b / 1024, sb = b % 1024, swz = sb ^ (((sb >> 9) & 1) << 5); R = (st >> 1) * 16 + swz / 64; C = (st & 1) * 32 + (swz % 64) / 2; }
__host__ __device__ __forceinline__ int perm32(int rho) { const int n = rho >> 4, i = rho & 15; return 8 * (i >> 2) + 4 * n + (i & 3); }

struct Unit { int pm, pn; };
struct Gemm { const bf16_t* A; const bf16_t* Bt; int M, N, K; };

struct StaticOrder {
    int nM, nN, nwg, G, c;
    __host__ __device__ void init(int M, int N, int G_, int c_) { nM = M / BM; nN = N / BM; nwg = nM * nN; G = G_; c = c_; }
    __host__ __device__ bool next(int i, Unit& u) const {
        const long L = (long)i * G + c; if (L >= nwg) return false;
        int wgid = (int)L; { const int q = nwg / NXCD, r = nwg % NXCD, xcd = wgid % NXCD, off = wgid / NXCD; wgid = (xcd < r ? xcd * (q + 1) : r * (q + 1) + (xcd - r) * q) + off; }
        const int nig = WGM * nN, gid = wgid / nig, fm = gid * WGM, gsz = (nM - fm) < WGM ? (nM - fm) : WGM;
        u.pm = fm + ((wgid % nig) % gsz); u.pn = (wgid % nig) / gsz; return true;
    }
    __device__ __forceinline__ void a_ready(const Unit&) const {}
    __device__ __forceinline__ void done(const Unit&) const {}
};

__device__ __forceinline__ unsigned cvt_pk_bf16(float lo, float hi) { unsigned r; asm volatile("v_cvt_pk_bf16_f32 %0, %1, %2" : "=v"(r) : "v"(lo), "v"(hi)); return r; }
template <class Epi, class Sched, bool ALIGN_EPI = false, bool SP2 = false>
__device__ __forceinline__ void gemm_phase(PG8_LAS unsigned char* lds, const Gemm g, const Sched& S, const Epi& E) {
    const int tid = threadIdx.x, wid = __builtin_amdgcn_readfirstlane(tid >> 6), lane = tid & 63, wr = wid >> 2, wc = wid & 3, fr = lane & 15, fq = lane >> 4;
    const int K = g.K, nt = K / BK;
    unsigned voffA[2], voffB[2];
#pragma unroll
    for (int i = 0; i < 2; ++i) { int R, C; stage_rc(tid * 16 + i * 8192, R, C); const int Rb = Epi::PERM ? ((R & ~31) + perm32(R & 31)) : R;
        voffA[i] = (unsigned)(R * K + C) * 2u; voffB[i] = (unsigned)(Rb * K + C) * 2u; }
    const size_t kstep = (size_t)(BK * 2);
    const size_t hstep = (size_t)HALF * K * 2;
    const size_t tstep = 2 * hstep;
    const unsigned ldsw = (unsigned)wid * 1024u;
    const int aoff = lds_byte(wr * 64 + fr, fq * 8), boff = lds_byte(wc * 32 + fr, fq * 8);
#define PG8_SA(b, h) (((b) * 2 + (h)) * HTB)
#define PG8_SB(b, h) ((4 + (b) * 2 + (h)) * HTB)
#define PG8_STAGE(bufoff, gbase, voff) do { _Pragma("unroll") for (int _i = 0; _i < 2; ++_i) \
        __builtin_amdgcn_global_load_lds((const unsigned*)((const char*)(gbase) + (voff)[_i]), (PG8_LAS unsigned*)(lds + (bufoff) + ldsw + _i * 8192), 16, 0, 0); } while (0)
#define PG8_LDA(dst, b, h) do { _Pragma("unroll") for (int m = 0; m < 4; ++m) _Pragma("unroll") for (int k = 0; k < 2; ++k) dst[m][k] = *(const PG8_LAS bf16x8*)(lds + PG8_SA(b, h) + aoff + m * 2048 + k * 1024); } while (0)
#define PG8_LDB(dst, b, h) do { _Pragma("unroll") for (int n = 0; n < 2; ++n) _Pragma("unroll") for (int k = 0; k < 2; ++k) dst[n][k] = *(const PG8_LAS bf16x8*)(lds + PG8_SB(b, h) + boff + n * 2048 + k * 1024); } while (0)
#define PG8_MMA(ai, bj, At, Bt) do { __builtin_amdgcn_s_setprio(1); _Pragma("unroll") for (int m = 0; m < 4; ++m) _Pragma("unroll") for (int n = 0; n < 2; ++n) _Pragma("unroll") for (int k = 0; k < 2; ++k) \
        acc[ai][bj][m][n] = __builtin_amdgcn_mfma_f32_16x16x32_bf16(Bt[n][k], At[m][k], acc[ai][bj][m][n], 0, 0, 0); __builtin_amdgcn_s_setprio(0); } while (0)
#define PG8_WAIT_V(n) asm volatile("s_waitcnt vmcnt(" #n ")" ::: "memory")
#define PG8_WAIT_L(n) asm volatile("s_waitcnt lgkmcnt(" #n ")" ::: "memory")
#define PG8_BAR __builtin_amdgcn_s_barrier()
#define PG8_SCHED __builtin_amdgcn_sched_barrier(0)
    Unit cur, nxt; int ui = 0;
    if (!S.next(0, cur)) return;
    f32x4 acc[2][2][4][2];
#pragma unroll
    for (int a = 0; a < 2; ++a)
#pragma unroll
        for (int b = 0; b < 2; ++b)
#pragma unroll
            for (int m = 0; m < 4; ++m)
#pragma unroll
                for (int n = 0; n < 2; ++n) acc[a][b][m][n] = (f32x4){0.f, 0.f, 0.f, 0.f};
    bf16x8 At[4][2], B0[2][2], B1[2][2];
    const char* cA = (const char*)g.A + (size_t)cur.pm * tstep; const char* cB = (const char*)g.Bt + (size_t)cur.pn * tstep;
    S.a_ready(cur);
    if constexpr (SP2) {
        PG8_STAGE(PG8_SB(0, 0), cB, voffB); PG8_STAGE(PG8_SB(0, 1), cB + hstep, voffB); PG8_STAGE(PG8_SA(0, 0), cA, voffA); PG8_STAGE(PG8_SA(0, 1), cA + hstep, voffA);
        if (wr == 1) PG8_BAR;
        PG8_WAIT_V(2); PG8_BAR;
        PG8_STAGE(PG8_SB(1, 0), cB + kstep, voffB); PG8_STAGE(PG8_SA(1, 0), cA + kstep, voffA); PG8_STAGE(PG8_SB(1, 1), cB + hstep + kstep, voffB);
        PG8_WAIT_V(6); PG8_BAR;
    } else {
        PG8_STAGE(PG8_SB(0, 0), cB, voffB); PG8_STAGE(PG8_SA(0, 0), cA, voffA); PG8_STAGE(PG8_SB(0, 1), cB + hstep, voffB); PG8_STAGE(PG8_SA(0, 1), cA + hstep, voffA);
        if (wr == 1) PG8_BAR;
        PG8_WAIT_V(4); PG8_BAR;
        PG8_STAGE(PG8_SB(1, 0), cB + kstep, voffB); PG8_STAGE(PG8_SA(1, 0), cA + kstep, voffA); PG8_STAGE(PG8_SB(1, 1), cB + hstep + kstep, voffB);
        PG8_WAIT_V(6); PG8_BAR;
    }
    for (;;) {
        const bool has_next = S.next(ui + 1, nxt);
        const char* nA = has_next ? (const char*)g.A + (size_t)nxt.pm * tstep : cA; const char* nB = has_next ? (const char*)g.Bt + (size_t)nxt.pn * tstep : cB;
        for (int t = 0; t < nt; t += 2) {
            const bool last = (t == nt - 2);
            const char* a1 = cA + (size_t)(t + 1) * kstep;
            const char* a2 = last ? nA : cA + (size_t)(t + 2) * kstep; const char* b2 = last ? nB : cB + (size_t)(t + 2) * kstep;
            const char* a3 = a2 + kstep; const char* b3 = b2 + kstep;
            if (last && has_next) S.a_ready(nxt);
            if constexpr (SP2) {
            PG8_LDB(B0, 0, 0); PG8_LDB(B1, 0, 1); PG8_SCHED; PG8_LDA(At, 0, 0); PG8_STAGE(PG8_SA(1, 1), a1 + hstep, voffA);
            PG8_WAIT_V(8); PG8_WAIT_L(0); PG8_BAR; PG8_MMA(0, 0, At, B0); PG8_MMA(0, 1, At, B1); PG8_BAR; PG8_SCHED;
            PG8_LDA(At, 0, 1); PG8_STAGE(PG8_SB(0, 0), b2, voffB); PG8_STAGE(PG8_SB(0, 1), b2 + hstep, voffB); PG8_STAGE(PG8_SA(0, 0), a2, voffA);
            PG8_WAIT_V(8); PG8_WAIT_L(0); PG8_BAR; PG8_MMA(1, 0, At, B0); PG8_MMA(1, 1, At, B1); PG8_BAR; PG8_SCHED;
            PG8_LDB(B0, 1, 0); PG8_LDB(B1, 1, 1); PG8_SCHED; PG8_LDA(At, 1, 0); PG8_STAGE(PG8_SA(0, 1), a2 + hstep, voffA);
            PG8_WAIT_V(8); PG8_WAIT_L(0); PG8_BAR; PG8_MMA(0, 0, At, B0); PG8_MMA(0, 1, At, B1); PG8_BAR; PG8_SCHED;
            PG8_LDA(At, 1, 1); PG8_STAGE(PG8_SB(1, 0), b3, voffB); PG8_STAGE(PG8_SB(1, 1), b3 + hstep, voffB); PG8_STAGE(PG8_SA(1, 0), a3, voffA);
            PG8_WAIT_V(8); PG8_WAIT_L(0); PG8_BAR; PG8_MMA(1, 0, At, B0); PG8_MMA(1, 1, At, B1); PG8_BAR; PG8_SCHED;
            } else {
            PG8_LDB(B0, 0, 0); PG8_SCHED; PG8_LDA(At, 0, 0); PG8_STAGE(PG8_SA(1, 1), a1 + hstep, voffA);
            PG8_WAIT_L(8); PG8_BAR; PG8_WAIT_L(0); PG8_MMA(0, 0, At, B0); PG8_BAR; PG8_SCHED;
            PG8_LDB(B1, 0, 1); PG8_STAGE(PG8_SB(0, 0), b2, voffB);
            PG8_BAR; PG8_WAIT_L(0); PG8_MMA(0, 1, At, B1); PG8_BAR;
            PG8_LDA(At, 0, 1); PG8_STAGE(PG8_SA(0, 0), a2, voffA);
            PG8_BAR; PG8_WAIT_L(0); PG8_MMA(1, 0, At, B0); PG8_BAR; PG8_SCHED;
            PG8_STAGE(PG8_SB(0, 1), b2 + hstep, voffB);
            PG8_WAIT_V(6); PG8_BAR; PG8_MMA(1, 1, At, B1); PG8_BAR;
            PG8_LDB(B0, 1, 0); PG8_SCHED; PG8_LDA(At, 1, 0); PG8_STAGE(PG8_SA(0, 1), a2 + hstep, voffA);
            PG8_WAIT_L(8); PG8_BAR; PG8_WAIT_L(0); PG8_MMA(0, 0, At, B0); PG8_BAR; PG8_SCHED;
            PG8_LDB(B1, 1, 1); PG8_STAGE(PG8_SB(1, 0), b3, voffB);
            PG8_BAR; PG8_WAIT_L(0); PG8_MMA(0, 1, At, B1); PG8_BAR;
            PG8_LDA(At, 1, 1); PG8_STAGE(PG8_SA(1, 0), a3, voffA);
            PG8_BAR; PG8_WAIT_L(0); PG8_MMA(1, 0, At, B0); PG8_BAR; PG8_SCHED;
            PG8_STAGE(PG8_SB(1, 1), b3 + hstep, voffB);
            PG8_WAIT_V(6); PG8_BAR; PG8_MMA(1, 1, At, B1); PG8_BAR;
            }
        }
        if constexpr (ALIGN_EPI) { if (wr == 0) PG8_BAR; }
        if constexpr (!Epi::AFTER_DRAIN) { E(acc, cur, wr, wc, fr, fq); S.done(cur); }
        if (!has_next) break;
#pragma unroll
        for (int a = 0; a < 2; ++a)
#pragma unroll
            for (int b = 0; b < 2; ++b)
#pragma unroll
                for (int m = 0; m < 4; ++m)
#pragma unroll
                    for (int n = 0; n < 2; ++n) acc[a][b][m][n] = (f32x4){0.f, 0.f, 0.f, 0.f};
        cur = nxt; cA = nA; cB = nB; ++ui;
        if constexpr (ALIGN_EPI) { if (wr == 1) PG8_BAR; }
    }
    PG8_WAIT_V(0);
    if constexpr (!ALIGN_EPI) { if (wr == 0) PG8_BAR; }
    PG8_BAR;
    if constexpr (Epi::AFTER_DRAIN) { E.fused(acc, cur, wr, wc, fr, fq, lds, wid, lane); S.done(cur); }
#undef PG8_SA
#undef PG8_SB
#undef PG8_STAGE
#undef PG8_LDA
#undef PG8_LDB
#undef PG8_MMA
#undef PG8_WAIT_V
#undef PG8_WAIT_L
#undef PG8_BAR
#undef PG8_SCHED
}
}

__device__ __forceinline__ uint4 pack8(const float (&v)[8]) { uint4 w; w.x = pk2(v[0], v[1]); w.y = pk2(v[2], v[3]); w.z = pk2(v[4], v[5]); w.w = pk2(v[6], v[7]); return w; }
struct EpiIn {
    static constexpr bool PERM = true, AFTER_DRAIN = false;
    bf16* PROJ; float* HA; const float* lbp;
    template <int GRP> __device__ __forceinline__ void run(const pg8::f32x4 (&acc)[2][2][4][2], int row0, int col0, float sc) const {
#pragma unroll
        for (int bj = 0; bj < 2; ++bj) {
            float lb[8];
            if (GRP == 1) {
#pragma unroll
                for (int i = 0; i < 8; ++i) { const int j = col0 - C_HF + bj * 128 + i; lb[i] = 1.0f / (1.0f + __expf(lbp[512 + j] - lbp[j])); }
            }
#pragma unroll
            for (int ai = 0; ai < 2; ++ai)
#pragma unroll
                for (int m = 0; m < 4; ++m) { const size_t row = (size_t)(row0 + ai * 128 + m * 16);
                    float v[8];
#pragma unroll
                    for (int i = 0; i < 4; ++i) { v[i] = acc[ai][bj][m][0][i]; v[4 + i] = acc[ai][bj][m][1][i]; }
                    if (GRP == 0) {
#pragma unroll
                        for (int i = 0; i < 8; ++i) v[i] *= sc;
                    } else if (GRP == 1) {
                        float a[8];
#pragma unroll
                        for (int i = 0; i < 8; ++i) { const float ex = __expf(-fminf(fmaxf(v[i], -30.f), 30.f)); const float sig = 1.0f / (1.0f + ex), omsig = ex * sig;
                            const float f = lb[i] + (1.0f - lb[i]) * sig; a[i] = __log2f(f); v[i] = (1.0f - lb[i]) * omsig; }
                        float4* hp = (float4*)(HA + row * 512 + (col0 - C_HF) + bj * 128);
                        hp[0] = make_float4(a[0], a[1], a[2], a[3]); hp[1] = make_float4(a[4], a[5], a[6], a[7]);
                    } else if (GRP == 3) {
#pragma unroll
                        for (int i = 0; i < 8; ++i) v[i] = v[i] * __builtin_amdgcn_rcpf(1.0f + __expf(-v[i]));
                    }
                    *(uint4*)(PROJ + row * DIN + col0 + bj * 128) = pack8(v);
                    asm volatile("" ::: "memory");
                }
        }
    }
    __device__ __forceinline__ void operator()(const pg8::f32x4 (&acc)[2][2][4][2], const pg8::Unit& u, int wr, int wc, int fr, int fq) const {
        const int row0 = u.pm * 256 + wr * 64 + fr, col0 = u.pn * 256 + wc * 32 + 8 * fq, grp = u.pn >> 1;
        const float sc = (grp == 0) ? 0.08838834764831845f : ((grp == 4) ? 0.18033688011112042f : 1.0f);
        if (grp == 1) run<1>(acc, row0, col0, sc); else if (grp == 3) run<3>(acc, row0, col0, sc); else run<0>(acc, row0, col0, sc);
    }
};
struct EpiOut {
    static constexpr bool PERM = true, AFTER_DRAIN = false;
    const float* x; bf16* HB; float* PSQ;
    __device__ __forceinline__ void operator()(const pg8::f32x4 (&acc)[2][2][4][2], const pg8::Unit& u, int wr, int wc, int fr, int fq) const {
        const int row0 = u.pm * 256 + wr * 64 + fr, col0 = u.pn * 256 + wc * 32 + 8 * fq;
#pragma unroll
        for (int ai = 0; ai < 2; ++ai) {
            float4 xv[4][2][2];
#pragma unroll
            for (int m = 0; m < 4; ++m)
#pragma unroll
                for (int bj = 0; bj < 2; ++bj) { const size_t off = (size_t)(row0 + ai * 128 + m * 16) * D + col0 + bj * 128;
                    xv[m][bj][0] = *(const float4*)(x + off); xv[m][bj][1] = *(const float4*)(x + off + 4); }
#pragma unroll
            for (int m = 0; m < 4; ++m) { const size_t row = (size_t)(row0 + ai * 128 + m * 16); float ss = 0.f;
#pragma unroll
                for (int bj = 0; bj < 2; ++bj) { const size_t off = row * D + col0 + bj * 128;
                    const float4 x0 = xv[m][bj][0], x1 = xv[m][bj][1];
                    float h[8] = {x0.x + acc[ai][bj][m][0][0], x0.y + acc[ai][bj][m][0][1], x0.z + acc[ai][bj][m][0][2], x0.w + acc[ai][bj][m][0][3],
                                  x1.x + acc[ai][bj][m][1][0], x1.y + acc[ai][bj][m][1][1], x1.z + acc[ai][bj][m][1][2], x1.w + acc[ai][bj][m][1][3]};
                    *(uint4*)(HB + off) = pack8(h);
#pragma unroll
                    for (int i = 0; i < 8; ++i) ss += h[i] * h[i]; }
                ss += __shfl_xor(ss, 16); ss += __shfl_xor(ss, 32);
                if (fq == 0) PSQ[row * 16 + u.pn * 4 + wc] = ss; }
            asm volatile("" ::: "memory");
        }
    }
};
struct EpiQ {
    static constexpr bool PERM = true, AFTER_DRAIN = false;
    bf16* QH;
    __device__ __forceinline__ void operator()(const pg8::f32x4 (&acc)[2][2][4][2], const pg8::Unit& u, int wr, int wc, int fr, int fq) const {
        const int row0 = u.pm * 256 + wr * 64 + fr, col0 = u.pn * 256 + wc * 32 + 8 * fq;
#pragma unroll
        for (int ai = 0; ai < 2; ++ai)
#pragma unroll
            for (int m = 0; m < 4; ++m) { const size_t row = (size_t)(row0 + ai * 128 + m * 16);
#pragma unroll
                for (int bj = 0; bj < 2; ++bj) { float v[8];
#pragma unroll
                    for (int i = 0; i < 4; ++i) { v[i] = acc[ai][bj][m][0][i]; v[4 + i] = acc[ai][bj][m][1][i]; }
                    *(uint4*)(QH + row * 2048 + col0 + bj * 128) = pack8(v); } }
    }
};

__device__ __forceinline__ float compute_lambda(const float* dl, int lane) {
    const float sa = wave_sum(dl[lane] * dl[64 + lane]), sb = wave_sum(dl[128 + lane] * dl[192 + lane]);
    return __expf(sa) - __expf(sb) + 0.2f;
}
namespace hg {
typedef short bf16x8 __attribute__((ext_vector_type(8)));
typedef short s16x4 __attribute__((ext_vector_type(4)));
typedef float f32x4 __attribute__((ext_vector_type(4)));
typedef unsigned u32x4 __attribute__((ext_vector_type(4)));
typedef unsigned u32x2 __attribute__((ext_vector_type(2)));
typedef float f32x2 __attribute__((ext_vector_type(2)));
constexpr int QT = 0, KT = 16384, VT = 32768, AT = 49152, PT = 81920, OT = 90112, SEG = 122880, DEC = 126976;
__device__ __forceinline__ int swzA(int row) { return row & 15; }
__device__ __forceinline__ int swzB(int row) { return ((row & 3) << 1) | (((row >> 3) & 1) << 3); }
__device__ __forceinline__ int swzP(int row) { return (((row >> 1) & 1) << 1) | (((row >> 3) & 1) << 2); }
__device__ __forceinline__ s16x4 vtr(const LAS unsigned char* p) { return __builtin_bit_cast(s16x4, __builtin_amdgcn_ds_read_tr16_b64_v4i16((LAS s16x4*)p)); }
__device__ __forceinline__ bf16x8 cat(s16x4 a, s16x4 b) { return (bf16x8){a[0], a[1], a[2], a[3], b[0], b[1], b[2], b[3]}; }
__device__ __forceinline__ unsigned cvtpk(float lo, float hi) { typedef float f2 __attribute__((ext_vector_type(2))); typedef __bf16 b2 __attribute__((ext_vector_type(2))); f2 v = {lo, hi}; b2 b = __builtin_convertvector(v, b2); return __builtin_bit_cast(unsigned, b); }

__device__ __forceinline__ void hgrn_pre(Frame& F, int task) {
    LAS unsigned char* lds = (LAS unsigned char*)F.lds;
    const int tid = F.tid, lane = F.lane, w = F.wave, c16 = lane & 15, g = lane >> 4, q4 = c16 >> 2, p4 = c16 & 3;
    const int c = task & 63, h = (task >> 6) & 3, b = task >> 8;
    const size_t row0 = (size_t)b * SEQ + (size_t)c * 64;
    const int srow = tid >> 4, sch = tid & 15;
#pragma unroll
    for (int i = 0; i < 2; ++i) { const int row = srow + 32 * i; const bf16* rp = F.PROJ + (row0 + row) * DIN + h * 128 + sch * 8;
        *(LAS u32x4*)(lds + QT + row * 256 + ((sch ^ swzA(row)) << 4)) = *(const u32x4*)(rp + C_HQ);
        *(LAS u32x4*)(lds + KT + row * 256 + ((sch ^ swzB(row)) << 4)) = *(const u32x4*)(rp + C_HF);
        *(LAS u32x4*)(lds + VT + row * 256 + ((sch ^ swzB(row)) << 4)) = *(const u32x4*)(rp + C_HI); }
#pragma unroll
    for (int i = 0; i < 4; ++i) { const int p = tid + 512 * i; *(LAS u32x4*)(lds + AT + (p >> 5) * 512 + (p & 31) * 16) = *(const u32x4*)(F.HA + (row0 + (p >> 5)) * 512 + h * 128 + (p & 31) * 4); }
    __syncthreads();
    {
        const int dp = tid & 63, ts = tid >> 6, d = 2 * dp;
        const LAS float* at = (const LAS float*)(lds + AT);
        LAS float* seg = (LAS float*)(lds + SEG);
        float cs0[8], cs1[8]; float r0 = 0.f, r1 = 0.f;
#pragma unroll
        for (int tt = 0; tt < 8; ++tt) { const f32x2 a = *(const LAS f32x2*)(at + (8 * ts + tt) * 128 + d); r0 += a.x; r1 += a.y; cs0[tt] = r0; cs1[tt] = r1; }
        *(LAS f32x2*)(seg + ts * 128 + d) = (f32x2){r0, r1};
        __syncthreads();
        float off0 = 0.f, off1 = 0.f, bl0 = 0.f, bl1 = 0.f;
#pragma unroll
        for (int k = 0; k < 8; ++k) { const f32x2 s = *(const LAS f32x2*)(seg + k * 128 + d); if (k < ts) { off0 += s.x; off1 += s.y; } bl0 += s.x; bl1 += s.y; }
        if (ts == 0) *(f32x2*)(F.DECG + ((size_t)(b * 64 + c) * 4 + h) * 128 + d) = (f32x2){__builtin_amdgcn_exp2f(fmaxf(bl0, -120.f)), __builtin_amdgcn_exp2f(fmaxf(bl1, -120.f))};
#pragma unroll
        for (int tt = 0; tt < 8; ++tt) { const int t = 8 * ts + tt;
            const float x0 = (off0 + cs0[tt]) - bl0, x1 = (off1 + cs1[tt]) - bl1;
            const float eq0 = __builtin_amdgcn_exp2f(fminf(x0, 120.f)), eq1 = __builtin_amdgcn_exp2f(fminf(x1, 120.f));
            const float ek0 = __builtin_amdgcn_exp2f(fmaxf(-x0, -120.f)), ek1 = __builtin_amdgcn_exp2f(fmaxf(-x1, -120.f));
            LAS unsigned* pq = (LAS unsigned*)(lds + QT + t * 256 + (((d >> 3) ^ swzA(t)) << 4) + (d & 7) * 2);
            LAS unsigned* pk = (LAS unsigned*)(lds + KT + t * 256 + (((d >> 3) ^ swzB(t)) << 4) + (d & 7) * 2);
            const unsigned qv = *pq, kv = *pk;
            *pq = cvtpk(bflo(qv) * eq0, bfhi(qv) * eq1); *pk = cvtpk(bflo(kv) * ek0, bfhi(kv) * ek1); }
    }
    __syncthreads();
#pragma unroll
    for (int i = 0; i < 2; ++i) { const int row = srow + 32 * i; bf16* rp = F.PROJ + (row0 + row) * DIN + h * 128 + sch * 8;
        *(u32x4*)(rp + C_HQ) = *(const LAS u32x4*)(lds + QT + row * 256 + ((sch ^ swzA(row)) << 4));
        *(u32x4*)(rp + C_HF) = *(const LAS u32x4*)(lds + KT + row * 256 + ((sch ^ swzB(row)) << 4)); }
#pragma unroll
    for (int rep = 0; rep < 2; ++rep) {
        const int idx = w + 8 * rep;
        if (idx < 12) {
            int tb, sb; bool zero = false;
            if (idx == 10) { tb = 0; sb = 1; zero = true; } else if (idx == 11) { tb = 2; sb = 3; zero = true; }
            else { tb = (idx >= 6) ? 3 : (idx >= 3) ? 2 : (idx >= 1) ? 1 : 0; sb = idx - (tb * (tb + 1)) / 2; }
            f32x4 acc = (f32x4){0.f, 0.f, 0.f, 0.f};
            if (!zero) {
                const int tr = 16 * tb + c16, sr = 16 * sb + c16;
#pragma unroll
                for (int ks = 0; ks < 4; ++ks) {
                    const bf16x8 a = *(const LAS bf16x8*)(lds + QT + tr * 256 + (((4 * ks + g) ^ swzA(tr)) << 4));
                    const bf16x8 bb = *(const LAS bf16x8*)(lds + KT + sr * 256 + (((4 * ks + g) ^ swzB(sr)) << 4));
                    acc = __builtin_amdgcn_mfma_f32_16x16x32_bf16(a, bb, acc, 0, 0, 0);
                }
                if (tb == sb) {
#pragma unroll
                    for (int r = 0; r < 4; ++r) if (c16 > 4 * g + r) acc[r] = 0.f;
                }
            }
            const int s = 16 * sb + c16;
            u32x2 pk; pk.x = cvtpk(acc[0], acc[1]); pk.y = cvtpk(acc[2], acc[3]);
            *(LAS u32x2*)(lds + PT + s * 128 + (((2 * tb + (g >> 1)) ^ swzP(s)) << 4) + (g & 1) * 8) = pk;
        }
    }
    __syncthreads();
    bf16x8 Vf[2];
#pragma unroll
    for (int ks2 = 0; ks2 < 2; ++ks2) {
        const int r0 = 32 * ks2 + 8 * g + q4, r1 = r0 + 4;
        Vf[ks2] = cat(vtr(lds + VT + r0 * 256 + (((2 * w + (p4 >> 1)) ^ swzB(r0)) << 4) + (p4 & 1) * 8), vtr(lds + VT + r1 * 256 + (((2 * w + (p4 >> 1)) ^ swzB(r1)) << 4) + (p4 & 1) * 8));
    }
    LAS float* ot = (LAS float*)(lds + OT);
#pragma unroll
    for (int tb = 0; tb < 4; ++tb) {
        f32x4 O = (f32x4){0.f, 0.f, 0.f, 0.f};
#pragma unroll
        for (int ks2 = 0; ks2 < 2; ++ks2) {
            if (ks2 <= (tb >> 1)) {
                const int r0 = 32 * ks2 + 8 * g + q4, r1 = r0 + 4;
                const s16x4 lo = vtr(lds + PT + r0 * 128 + (((2 * tb + (p4 >> 1)) ^ swzP(r0)) << 4) + (p4 & 1) * 8);
                const s16x4 hh = vtr(lds + PT + r1 * 128 + (((2 * tb + (p4 >> 1)) ^ swzP(r1)) << 4) + (p4 & 1) * 8);
                O = __builtin_amdgcn_mfma_f32_16x16x32_bf16(cat(lo, hh), Vf[ks2], O, 0, 0, 0);
            }
        }
#pragma unroll
        for (int r = 0; r < 4; ++r) ot[(16 * tb + 4 * g + r) * 128 + 16 * w + c16] = O[r];
    }
    __syncthreads();
#pragma unroll
    for (int i = 0; i < 4; ++i) { const int p = tid + 512 * i; *(u32x4*)(F.HO + (row0 + (p >> 5)) * 512 + h * 128 + (p & 31) * 4) = *(const LAS u32x4*)(lds + OT + (p >> 5) * 512 + (p & 31) * 16); }
    __syncthreads();
}

__device__ __forceinline__ void hgrn_scan(Frame& F, int b, int h) {
    LAS unsigned char* lds = (LAS unsigned char*)F.lds;
    const int tid = F.tid, lane = F.lane, w = F.wave;
    const size_t row0 = (size_t)b * SEQ;
    f32x4 S[8];
#pragma unroll
    for (int i = 0; i < 8; ++i) S[i] = (f32x4){0.f, 0.f, 0.f, 0.f};
    u32x4 sq[2], sk[2], sv[2], so[4], sgn[2]; float sdec = 0.f;
    const int srow = tid >> 4, sch = tid & 15;
    float hw[8];
    { const float4 a = *(const float4*)(F.hnw + sch * 8), bq = *(const float4*)(F.hnw + sch * 8 + 4); hw[0] = a.x; hw[1] = a.y; hw[2] = a.z; hw[3] = a.w; hw[4] = bq.x; hw[5] = bq.y; hw[6] = bq.z; hw[7] = bq.w; }
#define HG_LOAD(c) do { _Pragma("unroll") for (int i = 0; i < 2; ++i) { const bf16* rp = F.PROJ + (row0 + (size_t)(c) * 64 + srow + 32 * i) * DIN + h * 128 + sch * 8; \
        sq[i] = *(const u32x4*)(rp + C_HQ); sk[i] = *(const u32x4*)(rp + C_HF); sv[i] = *(const u32x4*)(rp + C_HI); sgn[i] = *(const u32x4*)(rp + C_HG); } \
    _Pragma("unroll") for (int i = 0; i < 4; ++i) { const int p = tid + 512 * i; so[i] = *(const u32x4*)(F.HO + (row0 + (size_t)(c) * 64 + (p >> 5)) * 512 + h * 128 + (p & 31) * 4); } \
    if (tid < 128) sdec = F.DECG[((size_t)(b * 64 + (c)) * 4 + h) * 128 + tid]; } while (0)
    HG_LOAD(0);
    for (int c = 0; c < SEQ / 64; ++c) {
        int lz = lane; asm volatile("" : "+v"(lz));
        const int c16 = lz & 15, g = lz >> 4, q4 = c16 >> 2, p4 = c16 & 3;
        u32x4 sgt[2]; sgt[0] = sgn[0]; sgt[1] = sgn[1];
#pragma unroll
        for (int i = 0; i < 2; ++i) { const int row = srow + 32 * i;
            *(LAS u32x4*)(lds + QT + row * 256 + ((sch ^ swzA(row)) << 4)) = sq[i];
            *(LAS u32x4*)(lds + KT + row * 256 + ((sch ^ swzB(row)) << 4)) = sk[i];
            *(LAS u32x4*)(lds + VT + row * 256 + ((sch ^ swzB(row)) << 4)) = sv[i]; }
#pragma unroll
        for (int i = 0; i < 4; ++i) { const int p = tid + 512 * i; *(LAS u32x4*)(lds + OT + (p >> 5) * 512 + (p & 31) * 16) = so[i]; }
        if (tid < 128) ((LAS float*)(lds + DEC))[tid] = sdec;
        __syncthreads();
        if (c + 1 < SEQ / 64) HG_LOAD(c + 1);
        bf16x8 Bf[4];
        {
            const LAS float* dec = (const LAS float*)(lds + DEC);
#pragma unroll
            for (int db = 0; db < 8; ++db) { const f32x4 dv = *(const LAS f32x4*)(dec + 16 * db + 4 * g); S[db] = S[db] * dv; }
#pragma unroll
            for (int ks = 0; ks < 4; ++ks) { u32x4 t; t.x = cvtpk(S[2 * ks][0], S[2 * ks][1]); t.y = cvtpk(S[2 * ks][2], S[2 * ks][3]); t.z = cvtpk(S[2 * ks + 1][0], S[2 * ks + 1][1]); t.w = cvtpk(S[2 * ks + 1][2], S[2 * ks + 1][3]);
                Bf[ks] = __builtin_bit_cast(bf16x8, t); }
        }
        LAS float* ot = (LAS float*)(lds + OT);
#pragma unroll
        for (int tb = 0; tb < 4; ++tb) {
            f32x4 O;
#pragma unroll
            for (int r = 0; r < 4; ++r) O[r] = ot[(16 * tb + 4 * g + r) * 128 + 16 * w + c16];
            const int tr = 16 * tb + c16;
#pragma unroll
            for (int ks = 0; ks < 4; ++ks) {
                const s16x4 lo = *(const LAS s16x4*)(lds + QT + tr * 256 + (((4 * ks + (g >> 1)) ^ swzA(tr)) << 4) + (g & 1) * 8);
                const s16x4 hh = *(const LAS s16x4*)(lds + QT + tr * 256 + (((4 * ks + 2 + (g >> 1)) ^ swzA(tr)) << 4) + (g & 1) * 8);
                O = __builtin_amdgcn_mfma_f32_16x16x32_bf16(cat(lo, hh), Bf[ks], O, 0, 0, 0);
            }
#pragma unroll
            for (int r = 0; r < 4; ++r) ot[(16 * tb + 4 * g + r) * 128 + 16 * w + c16] = O[r];
        }
        bf16x8 Vf[2];
#pragma unroll
        for (int ks2 = 0; ks2 < 2; ++ks2) {
            const int r0 = 32 * ks2 + 8 * g + q4, r1 = r0 + 4;
            Vf[ks2] = cat(vtr(lds + VT + r0 * 256 + (((2 * w + (p4 >> 1)) ^ swzB(r0)) << 4) + (p4 & 1) * 8), vtr(lds + VT + r1 * 256 + (((2 * w + (p4 >> 1)) ^ swzB(r1)) << 4) + (p4 & 1) * 8));
        }
#pragma unroll
        for (int db = 0; db < 8; ++db)
#pragma unroll
            for (int ks2 = 0; ks2 < 2; ++ks2) {
                const int r0 = 32 * ks2 + 8 * g + q4, r1 = r0 + 4;
                const s16x4 lo = vtr(lds + KT + r0 * 256 + (((2 * db + (p4 >> 1)) ^ swzB(r0)) << 4) + (p4 & 1) * 8);
                const s16x4 hh = vtr(lds + KT + r1 * 256 + (((2 * db + (p4 >> 1)) ^ swzB(r1)) << 4) + (p4 & 1) * 8);
                S[db] = __builtin_amdgcn_mfma_f32_16x16x32_bf16(cat(lo, hh), Vf[ks2], S[db], 0, 0, 0);
            }
        __syncthreads();
#pragma unroll
        for (int i = 0; i < 2; ++i) { const int t = srow + 32 * i; const size_t row = row0 + (size_t)c * 64 + t;
            const f32x4 xa = *(const LAS f32x4*)(ot + t * 128 + sch * 8), xb = *(const LAS f32x4*)(ot + t * 128 + sch * 8 + 4);
            float ss = (xa[0] * xa[0] + xa[1] * xa[1]) + (xa[2] * xa[2] + xa[3] * xa[3]) + (xb[0] * xb[0] + xb[1] * xb[1]) + (xb[2] * xb[2] + xb[3] * xb[3]);
            ss += __builtin_bit_cast(float, __builtin_amdgcn_update_dpp(0, __builtin_bit_cast(int, ss), 0xB1, 0xF, 0xF, false));
            ss += __builtin_bit_cast(float, __builtin_amdgcn_update_dpp(0, __builtin_bit_cast(int, ss), 0x4E, 0xF, 0xF, false));
            ss += __builtin_bit_cast(float, __builtin_amdgcn_update_dpp(0, __builtin_bit_cast(int, ss), 0x141, 0xF, 0xF, false));
            ss += __builtin_bit_cast(float, __builtin_amdgcn_update_dpp(0, __builtin_bit_cast(int, ss), 0x140, 0xF, 0xF, false));
            const float r = 1.0f / sqrtf(ss * (1.f / 128.f) + RMS_EPS);
            const u32x4 gt = sgt[i];
            u32x4 o;
            o.x = cvtpk(xa[0] * r * hw[0] * bflo(gt.x), xa[1] * r * hw[1] * bfhi(gt.x)); o.y = cvtpk(xa[2] * r * hw[2] * bflo(gt.y), xa[3] * r * hw[3] * bfhi(gt.y));
            o.z = cvtpk(xb[0] * r * hw[4] * bflo(gt.z), xb[1] * r * hw[5] * bfhi(gt.z)); o.w = cvtpk(xb[2] * r * hw[6] * bflo(gt.w), xb[3] * r * hw[7] * bfhi(gt.w));
            *(u32x4*)(F.MIX + row * D + h * 128 + sch * 8) = o; }
        __syncthreads();
    }
#undef HG_LOAD
}
}

namespace da {
typedef short bf16x8 __attribute__((ext_vector_type(8)));
typedef short s16x4 __attribute__((ext_vector_type(4)));
typedef float f32x16 __attribute__((ext_vector_type(16)));
constexpr int V_OFF = 16384, BUF_BYTES = 32768;
__device__ __forceinline__ s16x4 vtr(const LAS unsigned char* p) { return __builtin_bit_cast(s16x4, __builtin_amdgcn_ds_read_tr16_b64_v4i16((LAS s16x4*)p)); }
__device__ __forceinline__ unsigned cvtpk(float lo, float hi) { typedef float f2 __attribute__((ext_vector_type(2))); typedef __bf16 b2 __attribute__((ext_vector_type(2))); f2 v = {lo, hi}; b2 b = __builtin_convertvector(v, b2); return __builtin_bit_cast(unsigned, b); }

__device__ __forceinline__ float max3f(float a, float b, float c) { float r; asm("v_max3_f32 %0, %1, %2, %3" : "=v"(r) : "v"(a), "v"(b), "v"(c)); return r; }
__device__ __forceinline__ float exp2_pin(float x) { float y; asm volatile("v_exp_f32_e32 %0, %1" : "=v"(y) : "v"(x)); return y; }
__device__ __forceinline__ float max2f(float a, float b) { float r; asm("v_max_f32_e32 %0, %1, %2" : "=v"(r) : "v"(a), "v"(b)); return r; }
constexpr float RESC_THR = 8.0f;
__device__ __forceinline__ void attn_unit(Frame& F, int b, int h, int qblk, float lam) {
    LAS unsigned char* lds = (LAS unsigned char*)F.lds;
    const int lane = F.lane, r32 = lane & 31, hi = lane >> 5, w = F.wave, rg = w >> 1, map = w & 1;
    const int t0 = qblk * 128 + rg * 32;
    const int ntile_blk = 2 * qblk + 2, ntile_w = 2 * qblk + (rg >> 1) + 1;
    const bf16* base = F.PROJ + (size_t)b * SEQ * DIN;
    const bf16* gk = base + (size_t)(8 * w + (lane >> 3)) * DIN + C_AK + h * 128 + (((lane & 7) ^ ((4 * w + (lane >> 4)) & 7)) * 8);
    const bf16* gv = base + (size_t)(4 * w + (lane >> 4)) * DIN + C_AV + h * 128 + (((lane & 15) ^ ((lane >> 4) << 2)) * 8);
#define DA_DMA(tile, buf) do { const size_t to_ = (size_t)(tile) * 64 * DIN; LAS unsigned char* lb_ = lds + (buf) * BUF_BYTES + w * 1024; \
        __builtin_amdgcn_global_load_lds((const unsigned*)(gk + to_), (LAS unsigned*)(lb_), 16, 0, 0); \
        __builtin_amdgcn_global_load_lds((const unsigned*)(gk + to_ + 64), (LAS unsigned*)(lb_ + 8192), 16, 0, 0); \
        __builtin_amdgcn_global_load_lds((const unsigned*)(gv + to_), (LAS unsigned*)(lb_ + V_OFF), 16, 0, 0); \
        __builtin_amdgcn_global_load_lds((const unsigned*)(gv + to_ + (size_t)32 * DIN), (LAS unsigned*)(lb_ + V_OFF + 8192), 16, 0, 0); } while (0)
    DA_DMA(0, 0); DA_DMA(1, 1);
    if (ntile_blk > 2) DA_DMA(2, 2);
    bf16x8 qr[4];
#pragma unroll
    for (int d0 = 0; d0 < 4; ++d0) qr[d0] = *(const bf16x8*)(base + (size_t)(t0 + r32) * DIN + C_AQ + h * 128 + map * 64 + 16 * d0 + 8 * hi);
    asm volatile("s_waitcnt vmcnt(0)" : "+v"(qr[0]), "+v"(qr[1]), "+v"(qr[2]), "+v"(qr[3]) :: "memory");
    f32x16 o[4], negm;
#pragma unroll
    for (int eb = 0; eb < 4; ++eb)
#pragma unroll
        for (int r = 0; r < 16; ++r) o[eb][r] = 0.f;
#pragma unroll
    for (int r = 0; r < 16; ++r) negm[r] = 0.f;
    float mref = 0.f, l = 0.f;
    const int koff = map * 8192 + r32 * 128;
    const int q4 = (lane & 15) >> 2, p4 = lane & 3, eh = (lane >> 4) & 1;
    int voff[4];
#pragma unroll
    for (int eb = 0; eb < 4; ++eb) voff[eb] = V_OFF + (4 * hi + q4) * 256 + (p4 & 1) * 8 + (((((eb ^ q4) << 2) + 2 * eh + (p4 >> 1))) << 4);
#define DA_KFRAG(slot_, d0_, half_) (*(const LAS bf16x8*)(lds + (slot_) * BUF_BYTES + koff + (half_) * (32 * 128) + ((((2 * (d0_) + hi) ^ ((r32 >> 1) & 7))) << 4)))
#define DA_ROWMAX(c0_, c1_) ({ float a_ = fmaxf(fmaxf(c0_[0], c0_[1]), c1_[0]), b_ = fmaxf(fmaxf(c0_[2], c0_[3]), c1_[1]); a_ = fmaxf(fmaxf(a_, c1_[2]), c1_[3]); \
        _Pragma("unroll") for (int r = 4; r < 16; r += 4) { a_ = fmaxf(fmaxf(a_, c0_[r]), c0_[r + 1]); b_ = fmaxf(fmaxf(b_, c0_[r + 2]), c0_[r + 3]); a_ = fmaxf(fmaxf(a_, c1_[r]), c1_[r + 1]); b_ = fmaxf(fmaxf(b_, c1_[r + 2]), c1_[r + 3]); } \
        float m_ = fmaxf(a_, b_); auto rr_ = __builtin_amdgcn_permlane32_swap(__float_as_uint(m_), __float_as_uint(m_), false, false); fmaxf(__uint_as_float(rr_[0]), __uint_as_float(rr_[1])); })
    __builtin_amdgcn_s_barrier(); asm volatile("" ::: "memory");
    f32x16 pp0 = negm, pp1 = negm;
#pragma unroll
    for (int d0 = 0; d0 < 4; ++d0) { pp0 = __builtin_amdgcn_mfma_f32_32x32x16_bf16(DA_KFRAG(0, d0, 0), qr[d0], pp0, 0, 0, 0); pp1 = __builtin_amdgcn_mfma_f32_32x32x16_bf16(DA_KFRAG(0, d0, 1), qr[d0], pp1, 0, 0, 0); }
    { const float mx = DA_ROWMAX(pp0, pp1); mref = mx;
#pragma unroll
      for (int r = 0; r < 16; ++r) { negm[r] = -mref; pp0[r] = __builtin_amdgcn_exp2f(pp0[r] - mx); pp1[r] = __builtin_amdgcn_exp2f(pp1[r] - mx); } }
    asm volatile("s_waitcnt lgkmcnt(0)" ::: "memory");
    __builtin_amdgcn_s_barrier(); asm volatile("" ::: "memory");
    for (int t = 1; t <= ntile_blk; ++t) {
        if (t + 2 < ntile_blk) DA_DMA(t + 2, (t + 2) & 3);
        const int sc = t & 3, sp = (t - 1) & 3;
        if (t <= ntile_w) {
            const bool cur = t < ntile_w;
            f32x16 c0 = negm, c1 = negm;
            bf16x8 kf[8];
#pragma unroll
            for (int d0 = 0; d0 < 4; ++d0) { kf[2 * d0] = DA_KFRAG(sc, d0, 0); kf[2 * d0 + 1] = DA_KFRAG(sc, d0, 1); }
            unsigned pw[2][2][4]; float rs = 0.f;
#pragma unroll
            for (int r = 0; r < 16; ++r) rs += pp0[r] + pp1[r];
#pragma unroll
            for (int s = 0; s < 2; ++s)
#pragma unroll
                for (int j = 0; j < 4; ++j) { pw[0][s][j] = cvtpk(pp0[8 * s + 2 * j], pp0[8 * s + 2 * j + 1]); pw[1][s][j] = cvtpk(pp1[8 * s + 2 * j], pp1[8 * s + 2 * j + 1]); }
#pragma unroll
            for (int d0 = 0; d0 < 4; ++d0) { c0 = __builtin_amdgcn_mfma_f32_32x32x16_bf16(kf[2 * d0], qr[d0], c0, 0, 0, 0); c1 = __builtin_amdgcn_mfma_f32_32x32x16_bf16(kf[2 * d0 + 1], qr[d0], c1, 0, 0, 0); }
            __builtin_amdgcn_sched_group_barrier(0x100, 8, 0); __builtin_amdgcn_sched_group_barrier(0x2, 10, 0);
#pragma unroll
            for (int i = 0; i < 8; ++i) { __builtin_amdgcn_sched_group_barrier(0x8, 1, 0); __builtin_amdgcn_sched_group_barrier(0x2, 4, 0); }
            l += rs;
            bool resc = false; float f = 1.0f;
            if (cur) {
                const float mx = DA_ROWMAX(c0, c1);
                if (__any(mx > RESC_THR)) {
                    const float dl = fmaxf(mx, 0.f); f = __builtin_amdgcn_exp2f(-dl); mref += dl; l *= f; resc = true;
#pragma unroll
                    for (int r = 0; r < 16; ++r) { c0[r] -= dl; c1[r] -= dl; negm[r] = -mref; }
                }
            }
            {
                typedef unsigned u4 __attribute__((ext_vector_type(4)));
                const LAS unsigned char* vb_ = lds + sp * BUF_BYTES;
#define DA_VA(k_) (vb_ + voff[(k_) >> 2] + (16 * ((k_) & 3)) * 256)
                s16x4 lo_a = vtr(DA_VA(0)), hh_a = vtr(DA_VA(0) + 8 * 256), lo_b = vtr(DA_VA(1)), hh_b = vtr(DA_VA(1) + 8 * 256);
#pragma unroll
                for (int k = 0; k < 16; ++k) {
                    const s16x4 lo = lo_a, hh = hh_a;
                    lo_a = lo_b; hh_a = hh_b;
                    if (k < 14) { lo_b = vtr(DA_VA(k + 2)); hh_b = vtr(DA_VA(k + 2) + 8 * 256); }
                    const bf16x8 av = {lo[0], lo[1], lo[2], lo[3], hh[0], hh[1], hh[2], hh[3]};
                    const u4 pv = {pw[(k >> 1) & 1][k & 1][0], pw[(k >> 1) & 1][k & 1][1], pw[(k >> 1) & 1][k & 1][2], pw[(k >> 1) & 1][k & 1][3]};
                    o[k >> 2] = __builtin_amdgcn_mfma_f32_32x32x16_bf16(av, __builtin_bit_cast(bf16x8, pv), o[k >> 2], 0, 0, 0);
                    if (k < 8) { c0[2 * k] = exp2_pin(c0[2 * k]); c0[2 * k + 1] = exp2_pin(c0[2 * k + 1]); }
                    else { c1[2 * (k - 8)] = exp2_pin(c1[2 * (k - 8)]); c1[2 * (k - 8) + 1] = exp2_pin(c1[2 * (k - 8) + 1]); }
                }
#undef DA_VA
            }
            if (resc) {
#pragma unroll
                for (int eb = 0; eb < 4; ++eb)
#pragma unroll
                    for (int r = 0; r < 16; ++r) o[eb][r] *= f;
            }
            pp0 = c0; pp1 = c1;
        }
        if (t + 2 < ntile_blk) asm volatile("s_waitcnt vmcnt(4)" ::: "memory"); else asm volatile("s_waitcnt vmcnt(0)" ::: "memory");
        asm volatile("s_waitcnt lgkmcnt(0)" ::: "memory");
        __builtin_amdgcn_s_barrier(); asm volatile("" ::: "memory");
    }
#undef DA_KFRAG
#undef DA_ROWMAX
#undef DA_DMA
    l += __shfl_xor(l, 32);
    const float inv = 1.0f / l;
    LAS float* X = (LAS float*)lds + rg * 4096;
    if (map == 1) {
#pragma unroll
        for (int eb = 0; eb < 4; ++eb)
#pragma unroll
            for (int r = 0; r < 16; ++r) X[(eb * 16 + r) * 64 + lane] = o[eb][r] * inv;
    }
    __syncthreads();
    if (map == 0) {
        float ss = 0.f;
#pragma unroll
        for (int eb = 0; eb < 4; ++eb)
#pragma unroll
            for (int r = 0; r < 16; ++r) { const float d = o[eb][r] * inv - lam * X[(eb * 16 + r) * 64 + lane]; o[eb][r] = d; ss += d * d; }
        ss += __shfl_xor(ss, 32);
        const float rstd = 0.8f / sqrtf(ss * (1.f / 128.f) + RMS_EPS);
        bf16* orow = F.MIX + (size_t)(b * SEQ + t0 + r32) * D + 512 + h * 128;
#pragma unroll
        for (int eb = 0; eb < 4; ++eb)
#pragma unroll
            for (int r4 = 0; r4 < 4; ++r4) { const int e0 = 32 * eb + 8 * r4 + 4 * hi; const float4 wv = *(const float4*)(F.dnw + e0);
                uint2 pk; pk.x = pk2(o[eb][4 * r4 + 0] * rstd * wv.x, o[eb][4 * r4 + 1] * rstd * wv.y); pk.y = pk2(o[eb][4 * r4 + 2] * rstd * wv.z, o[eb][4 * r4 + 3] * rstd * wv.w);
                *(uint2*)(orow + e0) = pk; }
    }
    __syncthreads();
}
__device__ __forceinline__ void attn_phase(Frame& F, unsigned* ctl, volatile LAS unsigned* MISC, int cbase = 1024) {
    const float lam = compute_lambda(F.dlam, F.lane);
    const int x = F.bid & 7;
    if (F.tid == 0) MISC[16] = atomicAdd(&ctl[cbase + 64 * x], 1u);
    __syncthreads();
    for (;;) {
        const unsigned u = MISC[16];
        __syncthreads();
        if (u >= 128u) break;
        unsigned nxt = 0u;
        if (F.tid == 0) nxt = atomicAdd(&ctl[cbase + 64 * x], 1u);
        attn_unit(F, (4 * x + (int)(u & 3)) >> 2, (int)(u & 3), 31 - (int)(u >> 2), lam);
        if (F.tid == 0) MISC[16] = nxt;
        __syncthreads();
    }
}
}

__device__ __forceinline__ float row_rstd(const float* PSQ, int t) {
    const float4* p = (const float4*)(PSQ + (size_t)t * 16);
    const float4 a = p[0], b = p[1], c = p[2], d = p[3];
    const float s = ((a.x + a.y) + (a.z + a.w)) + ((b.x + b.y) + (b.z + b.w)) + ((c.x + c.y) + (c.z + c.w)) + ((d.x + d.y) + (d.z + d.w));
    return 1.0f / sqrtf(s * (1.f / D) + RMS_EPS);
}

__device__ __forceinline__ float gelu_tanh(float z) {
    const float y = 0.7978845608028654f * (z + 0.044715f * z * z * z);
    const float th = 1.0f - 2.0f / (1.0f + __expf(2.0f * y));
    return 0.5f * z * (1.0f + th);
}
__device__ __forceinline__ void unpack8(const uint4 v, float (&f)[8]) {
    f[0] = bflo(v.x); f[1] = bfhi(v.x); f[2] = bflo(v.y); f[3] = bfhi(v.y); f[4] = bflo(v.z); f[5] = bfhi(v.z); f[6] = bflo(v.w); f[7] = bfhi(v.w);
}
namespace tk {
typedef short bf16x8 __attribute__((ext_vector_type(8)));
typedef float f32x16 __attribute__((ext_vector_type(16)));
typedef unsigned u32x4 __attribute__((ext_vector_type(4)));
constexpr int NC = 50;
constexpr int CI[NC] = {0, 0, 0, 0, 0, 0, 0, 0, 0, 0, 0, 0, 0, 0, 0, 0, 1, 1, 1, 1, 1, 1, 1, 1, 2, 2, 2, 2, 2, 3, 3, 3, 3, 4, 4, 4, 5, 5, 6, 6, 7, 7, 8, 9, 10, 11, 12, 13, 14, 15};
constexpr int CJ[NC] = {0, 1, 2, 3, 4, 5, 6, 7, 8, 9, 10, 11, 12, 13, 14, 15, 0, 1, 2, 3, 4, 5, 6, 7, 0, 1, 2, 3, 4, 0, 1, 2, 3, 0, 1, 2, 0, 1, 0, 1, 0, 1, 0, 0, 0, 0, 0, 0, 0, 0};
constexpr int SLOT_OFF = 65536;
#define TK_SORT16(A) do { int h_, l_; \
    h_ = max(A[0], A[1]); l_ = min(A[0], A[1]); A[0] = h_; A[1] = l_; \
    h_ = max(A[3], A[2]); l_ = min(A[3], A[2]); A[3] = h_; A[2] = l_; \
    h_ = max(A[4], A[5]); l_ = min(A[4], A[5]); A[4] = h_; A[5] = l_; \
    h_ = max(A[7], A[6]); l_ = min(A[7], A[6]); A[7] = h_; A[6] = l_; \
    h_ = max(A[8], A[9]); l_ = min(A[8], A[9]); A[8] = h_; A[9] = l_; \
    h_ = max(A[11], A[10]); l_ = min(A[11], A[10]); A[11] = h_; A[10] = l_; \
    h_ = max(A[12], A[13]); l_ = min(A[12], A[13]); A[12] = h_; A[13] = l_; \
    h_ = max(A[15], A[14]); l_ = min(A[15], A[14]); A[15] = h_; A[14] = l_; \
    h_ = max(A[0], A[2]); l_ = min(A[0], A[2]); A[0] = h_; A[2] = l_; \
    h_ = max(A[1], A[3]); l_ = min(A[1], A[3]); A[1] = h_; A[3] = l_; \
    h_ = max(A[6], A[4]); l_ = min(A[6], A[4]); A[6] = h_; A[4] = l_; \
    h_ = max(A[7], A[5]); l_ = min(A[7], A[5]); A[7] = h_; A[5] = l_; \
    h_ = max(A[8], A[10]); l_ = min(A[8], A[10]); A[8] = h_; A[10] = l_; \
    h_ = max(A[9], A[11]); l_ = min(A[9], A[11]); A[9] = h_; A[11] = l_; \
    h_ = max(A[14], A[12]); l_ = min(A[14], A[12]); A[14] = h_; A[12] = l_; \
    h_ = max(A[15], A[13]); l_ = min(A[15], A[13]); A[15] = h_; A[13] = l_; \
    h_ = max(A[0], A[1]); l_ = min(A[0], A[1]); A[0] = h_; A[1] = l_; \
    h_ = max(A[2], A[3]); l_ = min(A[2], A[3]); A[2] = h_; A[3] = l_; \
    h_ = max(A[5], A[4]); l_ = min(A[5], A[4]); A[5] = h_; A[4] = l_; \
    h_ = max(A[7], A[6]); l_ = min(A[7], A[6]); A[7] = h_; A[6] = l_; \
    h_ = max(A[8], A[9]); l_ = min(A[8], A[9]); A[8] = h_; A[9] = l_; \
    h_ = max(A[10], A[11]); l_ = min(A[10], A[11]); A[10] = h_; A[11] = l_; \
    h_ = max(A[13], A[12]); l_ = min(A[13], A[12]); A[13] = h_; A[12] = l_; \
    h_ = max(A[15], A[14]); l_ = min(A[15], A[14]); A[15] = h_; A[14] = l_; \
    h_ = max(A[0], A[4]); l_ = min(A[0], A[4]); A[0] = h_; A[4] = l_; \
    h_ = max(A[1], A[5]); l_ = min(A[1], A[5]); A[1] = h_; A[5] = l_; \
    h_ = max(A[2], A[6]); l_ = min(A[2], A[6]); A[2] = h_; A[6] = l_; \
    h_ = max(A[3], A[7]); l_ = min(A[3], A[7]); A[3] = h_; A[7] = l_; \
    h_ = max(A[12], A[8]); l_ = min(A[12], A[8]); A[12] = h_; A[8] = l_; \
    h_ = max(A[13], A[9]); l_ = min(A[13], A[9]); A[13] = h_; A[9] = l_; \
    h_ = max(A[14], A[10]); l_ = min(A[14], A[10]); A[14] = h_; A[10] = l_; \
    h_ = max(A[15], A[11]); l_ = min(A[15], A[11]); A[15] = h_; A[11] = l_; \
    h_ = max(A[0], A[2]); l_ = min(A[0], A[2]); A[0] = h_; A[2] = l_; \
    h_ = max(A[1], A[3]); l_ = min(A[1], A[3]); A[1] = h_; A[3] = l_; \
    h_ = max(A[4], A[6]); l_ = min(A[4], A[6]); A[4] = h_; A[6] = l_; \
    h_ = max(A[5], A[7]); l_ = min(A[5], A[7]); A[5] = h_; A[7] = l_; \
    h_ = max(A[10], A[8]); l_ = min(A[10], A[8]); A[10] = h_; A[8] = l_; \
    h_ = max(A[11], A[9]); l_ = min(A[11], A[9]); A[11] = h_; A[9] = l_; \
    h_ = max(A[14], A[12]); l_ = min(A[14], A[12]); A[14] = h_; A[12] = l_; \
    h_ = max(A[15], A[13]); l_ = min(A[15], A[13]); A[15] = h_; A[13] = l_; \
    h_ = max(A[0], A[1]); l_ = min(A[0], A[1]); A[0] = h_; A[1] = l_; \
    h_ = max(A[2], A[3]); l_ = min(A[2], A[3]); A[2] = h_; A[3] = l_; \
    h_ = max(A[4], A[5]); l_ = min(A[4], A[5]); A[4] = h_; A[5] = l_; \
    h_ = max(A[6], A[7]); l_ = min(A[6], A[7]); A[6] = h_; A[7] = l_; \
    h_ = max(A[9], A[8]); l_ = min(A[9], A[8]); A[9] = h_; A[8] = l_; \
    h_ = max(A[11], A[10]); l_ = min(A[11], A[10]); A[11] = h_; A[10] = l_; \
    h_ = max(A[13], A[12]); l_ = min(A[13], A[12]); A[13] = h_; A[12] = l_; \
    h_ = max(A[15], A[14]); l_ = min(A[15], A[14]); A[15] = h_; A[14] = l_; \
    h_ = max(A[0], A[8]); l_ = min(A[0], A[8]); A[0] = h_; A[8] = l_; \
    h_ = max(A[1], A[9]); l_ = min(A[1], A[9]); A[1] = h_; A[9] = l_; \
    h_ = max(A[2], A[10]); l_ = min(A[2], A[10]); A[2] = h_; A[10] = l_; \
    h_ = max(A[3], A[11]); l_ = min(A[3], A[11]); A[3] = h_; A[11] = l_; \
    h_ = max(A[4], A[12]); l_ = min(A[4], A[12]); A[4] = h_; A[12] = l_; \
    h_ = max(A[5], A[13]); l_ = min(A[5], A[13]); A[5] = h_; A[13] = l_; \
    h_ = max(A[6], A[14]); l_ = min(A[6], A[14]); A[6] = h_; A[14] = l_; \
    h_ = max(A[7], A[15]); l_ = min(A[7], A[15]); A[7] = h_; A[15] = l_; \
    h_ = max(A[0], A[4]); l_ = min(A[0], A[4]); A[0] = h_; A[4] = l_; \
    h_ = max(A[1], A[5]); l_ = min(A[1], A[5]); A[1] = h_; A[5] = l_; \
    h_ = max(A[2], A[6]); l_ = min(A[2], A[6]); A[2] = h_; A[6] = l_; \
    h_ = max(A[3], A[7]); l_ = min(A[3], A[7]); A[3] = h_; A[7] = l_; \
    h_ = max(A[8], A[12]); l_ = min(A[8], A[12]); A[8] = h_; A[12] = l_; \
    h_ = max(A[9], A[13]); l_ = min(A[9], A[13]); A[9] = h_; A[13] = l_; \
    h_ = max(A[10], A[14]); l_ = min(A[10], A[14]); A[10] = h_; A[14] = l_; \
    h_ = max(A[11], A[15]); l_ = min(A[11], A[15]); A[11] = h_; A[15] = l_; \
    h_ = max(A[0], A[2]); l_ = min(A[0], A[2]); A[0] = h_; A[2] = l_; \
    h_ = max(A[1], A[3]); l_ = min(A[1], A[3]); A[1] = h_; A[3] = l_; \
    h_ = max(A[4], A[6]); l_ = min(A[4], A[6]); A[4] = h_; A[6] = l_; \
    h_ = max(A[5], A[7]); l_ = min(A[5], A[7]); A[5] = h_; A[7] = l_; \
    h_ = max(A[8], A[10]); l_ = min(A[8], A[10]); A[8] = h_; A[10] = l_; \
    h_ = max(A[9], A[11]); l_ = min(A[9], A[11]); A[9] = h_; A[11] = l_; \
    h_ = max(A[12], A[14]); l_ = min(A[12], A[14]); A[12] = h_; A[14] = l_; \
    h_ = max(A[13], A[15]); l_ = min(A[13], A[15]); A[13] = h_; A[15] = l_; \
    h_ = max(A[0], A[1]); l_ = min(A[0], A[1]); A[0] = h_; A[1] = l_; \
    h_ = max(A[2], A[3]); l_ = min(A[2], A[3]); A[2] = h_; A[3] = l_; \
    h_ = max(A[4], A[5]); l_ = min(A[4], A[5]); A[4] = h_; A[5] = l_; \
    h_ = max(A[6], A[7]); l_ = min(A[6], A[7]); A[6] = h_; A[7] = l_; \
    h_ = max(A[8], A[9]); l_ = min(A[8], A[9]); A[8] = h_; A[9] = l_; \
    h_ = max(A[10], A[11]); l_ = min(A[10], A[11]); A[10] = h_; A[11] = l_; \
    h_ = max(A[12], A[13]); l_ = min(A[12], A[13]); A[12] = h_; A[13] = l_; \
    h_ = max(A[14], A[15]); l_ = min(A[14], A[15]); A[14] = h_; A[15] = l_; \
} while (0)
#define TK_MERGE16(A) do { int h_, l_; \
    h_ = max(A[0], A[8]); l_ = min(A[0], A[8]); A[0] = h_; A[8] = l_; \
    h_ = max(A[1], A[9]); l_ = min(A[1], A[9]); A[1] = h_; A[9] = l_; \
    h_ = max(A[2], A[10]); l_ = min(A[2], A[10]); A[2] = h_; A[10] = l_; \
    h_ = max(A[3], A[11]); l_ = min(A[3], A[11]); A[3] = h_; A[11] = l_; \
    h_ = max(A[4], A[12]); l_ = min(A[4], A[12]); A[4] = h_; A[12] = l_; \
    h_ = max(A[5], A[13]); l_ = min(A[5], A[13]); A[5] = h_; A[13] = l_; \
    h_ = max(A[6], A[14]); l_ = min(A[6], A[14]); A[6] = h_; A[14] = l_; \
    h_ = max(A[7], A[15]); l_ = min(A[7], A[15]); A[7] = h_; A[15] = l_; \
    h_ = max(A[0], A[4]); l_ = min(A[0], A[4]); A[0] = h_; A[4] = l_; \
    h_ = max(A[1], A[5]); l_ = min(A[1], A[5]); A[1] = h_; A[5] = l_; \
    h_ = max(A[2], A[6]); l_ = min(A[2], A[6]); A[2] = h_; A[6] = l_; \
    h_ = max(A[3], A[7]); l_ = min(A[3], A[7]); A[3] = h_; A[7] = l_; \
    h_ = max(A[8], A[12]); l_ = min(A[8], A[12]); A[8] = h_; A[12] = l_; \
    h_ = max(A[9], A[13]); l_ = min(A[9], A[13]); A[9] = h_; A[13] = l_; \
    h_ = max(A[10], A[14]); l_ = min(A[10], A[14]); A[10] = h_; A[14] = l_; \
    h_ = max(A[11], A[15]); l_ = min(A[11], A[15]); A[11] = h_; A[15] = l_; \
    h_ = max(A[0], A[2]); l_ = min(A[0], A[2]); A[0] = h_; A[2] = l_; \
    h_ = max(A[1], A[3]); l_ = min(A[1], A[3]); A[1] = h_; A[3] = l_; \
    h_ = max(A[4], A[6]); l_ = min(A[4], A[6]); A[4] = h_; A[6] = l_; \
    h_ = max(A[5], A[7]); l_ = min(A[5], A[7]); A[5] = h_; A[7] = l_; \
    h_ = max(A[8], A[10]); l_ = min(A[8], A[10]); A[8] = h_; A[10] = l_; \
    h_ = max(A[9], A[11]); l_ = min(A[9], A[11]); A[9] = h_; A[11] = l_; \
    h_ = max(A[12], A[14]); l_ = min(A[12], A[14]); A[12] = h_; A[14] = l_; \
    h_ = max(A[13], A[15]); l_ = min(A[13], A[15]); A[13] = h_; A[15] = l_; \
    h_ = max(A[0], A[1]); l_ = min(A[0], A[1]); A[0] = h_; A[1] = l_; \
    h_ = max(A[2], A[3]); l_ = min(A[2], A[3]); A[2] = h_; A[3] = l_; \
    h_ = max(A[4], A[5]); l_ = min(A[4], A[5]); A[4] = h_; A[5] = l_; \
    h_ = max(A[6], A[7]); l_ = min(A[6], A[7]); A[6] = h_; A[7] = l_; \
    h_ = max(A[8], A[9]); l_ = min(A[8], A[9]); A[8] = h_; A[9] = l_; \
    h_ = max(A[10], A[11]); l_ = min(A[10], A[11]); A[10] = h_; A[11] = l_; \
    h_ = max(A[12], A[13]); l_ = min(A[12], A[13]); A[12] = h_; A[13] = l_; \
    h_ = max(A[14], A[15]); l_ = min(A[14], A[15]); A[14] = h_; A[15] = l_; \
} while (0)

__device__ __forceinline__ int f2ord(float f) { const int b = (int)__float_as_uint(f); return b ^ (int)((unsigned)(b >> 31) >> 1); }
__device__ __forceinline__ float ord2f(int k) { return __uint_as_float((unsigned)(k ^ (int)((unsigned)(k >> 31) >> 1))); }
__device__ __forceinline__ void topk_phase(Frame& F) {
    LAS unsigned char* lds = (LAS unsigned char*)F.lds;
    const int tid = F.tid, lane = F.lane, r32 = lane & 31, hi = lane >> 5, w = F.wave;
    LAS unsigned* slots = (LAS unsigned*)(lds + SLOT_OFF + w * 8192);
    for (int u = F.bid; u < 256; u += F.G) {
        const int tile = u >> 1, hgp = u & 1;
        const int t = tile * 256 + w * 32 + r32;
        const float rl2 = row_rstd(F.PSQ, t) * 1.4426950408889634f;
        for (int hh = 0; hh < 4; ++hh) {
            const int h = hgp * 4 + hh;
            __syncthreads();
#pragma unroll
            for (int i = 0; i < 8; ++i) { const int p = tid + 512 * i, half = p >> 11, row = (p >> 4) & 127, ch = p & 15;
                const u32x4 v = *(const u32x4*)(F.SKb + ((size_t)(h * 2 + half) * 128 + row) * 128 + ch * 8);
                *(LAS u32x4*)(lds + half * 32768 + row * 256 + ((ch ^ (row & 15)) << 4)) = v; }
            __syncthreads();
            int topk[2][16];
#pragma unroll
            for (int half = 0; half < 2; ++half) {
                bf16x8 bq[8];
#pragma unroll
                for (int ks = 0; ks < 8; ++ks) bq[ks] = *(const bf16x8*)(F.QH + (size_t)t * 2048 + h * 256 + half * 128 + 16 * ks + 8 * hi);
                f32x16 s[4];
#pragma unroll
                for (int nb = 0; nb < 4; ++nb) {
#pragma unroll
                    for (int r = 0; r < 16; ++r) s[nb][r] = 0.f;
#pragma unroll
                    for (int ks = 0; ks < 8; ++ks) {
                        const bf16x8 a = *(const LAS bf16x8*)(lds + half * 32768 + (32 * nb + r32) * 256 + (((2 * ks + hi) ^ (r32 & 15)) << 4));
                        s[nb] = __builtin_amdgcn_mfma_f32_32x32x16_bf16(a, bq[ks], s[nb], 0, 0, 0);
                    }
                }
                int kk[4][16];
#pragma unroll
                for (int nb = 0; nb < 4; ++nb)
#pragma unroll
                    for (int r = 0; r < 16; ++r) { const float sv = s[nb][r]; kk[nb][r] = (f2ord(sv) & ~127) | (32 * nb + (r & 3) + 8 * (r >> 2) + 4 * hi); }
                TK_SORT16(kk[0]); TK_SORT16(kk[1]); TK_SORT16(kk[2]); TK_SORT16(kk[3]);
#pragma unroll
                for (int i = 0; i < 16; ++i) { kk[0][i] = max(kk[0][i], kk[1][15 - i]); kk[2][i] = max(kk[2][i], kk[3][15 - i]); }
                TK_MERGE16(kk[0]); TK_MERGE16(kk[2]);
#pragma unroll
                for (int i = 0; i < 16; ++i) kk[0][i] = max(kk[0][i], kk[2][15 - i]);
                TK_MERGE16(kk[0]);
#pragma unroll
                for (int i = 0; i < 16; ++i) { auto rr = __builtin_amdgcn_permlane32_swap((unsigned)kk[0][i], (unsigned)kk[0][i], false, false); kk[1][i] = (int)(hi ? rr[0] : rr[1]); }
#pragma unroll
                for (int i = 0; i < 16; ++i) kk[0][i] = max(kk[0][i], kk[1][15 - i]);
                TK_MERGE16(kk[0]);
#pragma unroll
                for (int i = 0; i < 16; ++i) topk[half][i] = kk[0][i];
            }
            float v1[16], v2[16]; unsigned i1[16], i2[16];
#pragma unroll
            for (int r = 0; r < 16; ++r) { v1[r] = ord2f(topk[0][r] & ~127); i1[r] = (unsigned)topk[0][r] & 127u; v2[r] = ord2f(topk[1][r] & ~127); i2[r] = (unsigned)topk[1][r] & 127u; }
            float cv[NC / 2]; unsigned cp[NC / 2];
#pragma unroll
            for (int c = 0; c < NC / 2; ++c) {
                const float va = v1[CI[2 * c]] + v2[CJ[2 * c]], vb = v1[CI[2 * c + 1]] + v2[CJ[2 * c + 1]];
                const unsigned pa = (i1[CI[2 * c]] << 7) | i2[CJ[2 * c]], pb = (i1[CI[2 * c + 1]] << 7) | i2[CJ[2 * c + 1]];
                cv[c] = hi ? vb : va; cp[c] = hi ? pb : pa;
            }
            float rv[16]; unsigned rp[16];
            {
                int kc[2][16];
#pragma unroll
                for (int c = 0; c < NC / 2; ++c) { kc[c >> 4][c & 15] = (f2ord(cv[c]) & ~63) | (hi << 5) | c; slots[((hi << 5) | c) * 32 + r32] = cp[c]; }
#pragma unroll
                for (int c = NC / 2; c < 32; ++c) kc[c >> 4][c & 15] = (int)0x80000000;
                TK_SORT16(kc[0]); TK_SORT16(kc[1]);
#pragma unroll
                for (int i = 0; i < 16; ++i) kc[0][i] = max(kc[0][i], kc[1][15 - i]);
                TK_MERGE16(kc[0]);
#pragma unroll
                for (int i = 0; i < 16; ++i) { auto rr = __builtin_amdgcn_permlane32_swap((unsigned)kc[0][i], (unsigned)kc[0][i], false, false); kc[1][i] = (int)(hi ? rr[0] : rr[1]); }
#pragma unroll
                for (int i = 0; i < 16; ++i) kc[0][i] = max(kc[0][i], kc[1][15 - i]);
                TK_MERGE16(kc[0]);
#pragma unroll
                for (int r = 0; r < 16; ++r) { rv[r] = ord2f(kc[0][r] & ~63); rp[r] = slots[(kc[0][r] & 63) * 32 + r32]; }
            }
            float sum = 0.f; const float mx0 = rv[0];
#pragma unroll
            for (int r = 0; r < 16; ++r) rv[r] = __builtin_amdgcn_exp2f((rv[r] - mx0) * rl2);
#pragma unroll
            for (int r = 0; r < 16; ++r) sum += rv[r];
            const float inv = 1.0f / sum;
            if (hi == 0) {
                int4* ip = (int4*)(F.IDX + (size_t)t * 128 + h * 16); float4* gp = (float4*)(F.GW + (size_t)t * 128 + h * 16);
#pragma unroll
                for (int q = 0; q < 4; ++q) { ip[q] = make_int4((int)rp[4 * q], (int)rp[4 * q + 1], (int)rp[4 * q + 2], (int)rp[4 * q + 3]);
                    gp[q] = make_float4(rv[4 * q] * inv, rv[4 * q + 1] * inv, rv[4 * q + 2] * inv, rv[4 * q + 3] * inv); }
            }
        }
    }
    __syncthreads();
}
}

namespace peer {
typedef float f32x4_t __attribute__((ext_vector_type(4)));
typedef __bf16 bf2 __attribute__((ext_vector_type(2)));
typedef unsigned u32x4 __attribute__((ext_vector_type(4)));
template <int CTRL, int RM> __device__ __forceinline__ float dpp_add(float v) {
    return v + __builtin_bit_cast(float, __builtin_amdgcn_update_dpp(0, __builtin_bit_cast(int, v), CTRL, RM, 0xF, false));
}
__device__ __forceinline__ float wave_total(float v) {
    v = dpp_add<0xB1, 0xF>(v); v = dpp_add<0x4E, 0xF>(v); v = dpp_add<0x141, 0xF>(v); v = dpp_add<0x140, 0xF>(v);
    v = dpp_add<0x142, 0xA>(v); v = dpp_add<0x143, 0xC>(v);
    return __builtin_bit_cast(float, __builtin_amdgcn_readlane(__builtin_bit_cast(int, v), 63));
}
__device__ __forceinline__ float dot2(unsigned a, unsigned b, float c) { return __builtin_amdgcn_fdot2_f32_bf16(__builtin_bit_cast(bf2, a), __builtin_bit_cast(bf2, b), c, false); }
__device__ __forceinline__ float dot8(const u32x4 a, const u32x4 b, float c) { c = dot2(a.x, b.x, c); c = dot2(a.y, b.y, c); c = dot2(a.z, b.z, c); return dot2(a.w, b.w, c); }

__device__ __forceinline__ int wave_isum(int v) {
    v += __builtin_amdgcn_update_dpp(0, v, 0xB1, 0xF, 0xF, false); v += __builtin_amdgcn_update_dpp(0, v, 0x4E, 0xF, 0xF, false);
    v += __builtin_amdgcn_update_dpp(0, v, 0x141, 0xF, 0xF, false); v += __builtin_amdgcn_update_dpp(0, v, 0x140, 0xF, 0xF, false);
    v += __builtin_amdgcn_update_dpp(0, v, 0x142, 0xA, 0xF, false); v += __builtin_amdgcn_update_dpp(0, v, 0x143, 0xC, 0xF, false);
    return __builtin_amdgcn_readlane(v, 63);
}
constexpr int TPW = 8, SLSH = 9;
constexpr int UGRP = 1;
constexpr int VGRP = 2;
constexpr int PW_BYTES = 17440, PW_LIST = 0, PW_XQ = 8192, PW_CNT = 16416;
static_assert(NWAVES * PW_BYTES <= MISC_OFF, "PEER LDS map");
template <int CTRL, int RM> __device__ __forceinline__ int dpp_iadd(int v) { return v + __builtin_amdgcn_update_dpp(0, v, CTRL, RM, 0xF, false); }
template <int CTRL, int RM> __device__ __forceinline__ unsigned dpp_umax(unsigned v) { const unsigned t = (unsigned)__builtin_amdgcn_update_dpp(0, (int)v, CTRL, RM, 0xF, false); return v > t ? v : t; }
__device__ __forceinline__ float wave_max_pos(float f) {
    unsigned v = __float_as_uint(f);
    v = dpp_umax<0xB1, 0xF>(v); v = dpp_umax<0x4E, 0xF>(v); v = dpp_umax<0x141, 0xF>(v); v = dpp_umax<0x140, 0xF>(v); v = dpp_umax<0x142, 0xA>(v); v = dpp_umax<0x143, 0xC>(v);
    return __uint_as_float((unsigned)__builtin_amdgcn_readlane((int)v, 63));
}
__device__ __forceinline__ unsigned long long read_entry(const LAS unsigned char* pw, int j, int p) {
    const int idx = p < 128 ? p : 127;
    return *(const LAS unsigned long long*)(pw + PW_LIST + (j * 128 + idx) * 8);
}
__device__ __forceinline__ int utok(int lane) { return ((lane >> 5) & 1) | (((lane >> 4) & 1) << 1) | (((lane >> 3) & 1) << 2); }
struct UGroup { u32x4 u[TPW]; unsigned long long ent; float us, vs; };
template <int EMASK> __device__ __forceinline__ void issue_ug(Frame& F, UGroup& G, const LAS unsigned char* pw, int p, int lane) {
    const int idx = p < 128 ? p : 127;
    G.ent = *(const LAS unsigned long long*)(pw + PW_LIST + (utok(lane) * 128 + idx) * 8);
    const unsigned ev = (unsigned)G.ent & (unsigned)EMASK;
    typedef float f32x2 __attribute__((ext_vector_type(2)));
    const f32x2 sc = *(const f32x2*)(F.US + 2 * (size_t)ev);
    G.us = sc.x; G.vs = sc.y;
#pragma unroll
    for (int j = 0; j < TPW; ++j) { const unsigned e = (unsigned)__builtin_amdgcn_readlane((int)ev, 32 * (j & 1) + 16 * ((j >> 1) & 1) + 8 * ((j >> 2) & 1)); G.u[j] = *(const u32x4*)(F.U8 + (size_t)e * D + 16 * lane); }
}
__device__ __forceinline__ void compute_ug(const UGroup& G, const u32x4 (&xq)[TPW], LAS unsigned char* pw, int p, int lane, float sxrv) {
    int d[TPW];
#pragma unroll
    for (int j = 0; j < TPW; ++j) {
        d[j] = __builtin_amdgcn_sdot4((int)G.u[j].x, (int)xq[j].x, 0, false); d[j] = __builtin_amdgcn_sdot4((int)G.u[j].y, (int)xq[j].y, d[j], false);
        d[j] = __builtin_amdgcn_sdot4((int)G.u[j].z, (int)xq[j].z, d[j], false); d[j] = __builtin_amdgcn_sdot4((int)G.u[j].w, (int)xq[j].w, d[j], false); }
    int m4[4], m2[2];
#pragma unroll
    for (int i = 0; i < 4; ++i) { auto rr = __builtin_amdgcn_permlane32_swap((unsigned)d[2 * i], (unsigned)d[2 * i + 1], false, false); m4[i] = (int)rr[0] + (int)rr[1]; }
#pragma unroll
    for (int i = 0; i < 2; ++i) { auto rr = __builtin_amdgcn_permlane16_swap((unsigned)m4[2 * i], (unsigned)m4[2 * i + 1], false, false); m2[i] = (int)rr[0] + (int)rr[1]; }
    const int ra = m2[0] + __builtin_amdgcn_update_dpp(0, m2[0], 0x128, 0xF, 0xF, false), rb = m2[1] + __builtin_amdgcn_update_dpp(0, m2[1], 0x128, 0xF, 0xF, false);
    int dv = (lane & 8) ? rb : ra;
    dv = dpp_iadd<0xB1, 0xF>(dv); dv = dpp_iadd<0x4E, 0xF>(dv); dv = dpp_iadd<0x141, 0xF>(dv);
    const float z = (float)dv * G.us * sxrv;
    const float y2 = -2.3022082f * (z + 0.044715f * z * z * z);
    const float cw = __uint_as_float((unsigned)(G.ent >> 32)) * G.vs * z * __builtin_amdgcn_rcpf(1.0f + __builtin_amdgcn_exp2f(y2));
    const int pp = p < 128 ? p : 127;
    if ((lane & 7) == 0) *(LAS float*)(pw + PW_LIST + (utok(lane) * 128 + pp) * 8 + 4) = cw;
}
#define PEER_ACC(A, cw, vv) do { \
    A[0] += cw * (float)(vv.x & 0xff); A[1] += cw * (float)((vv.x >> 8) & 0xff); A[2] += cw * (float)((vv.x >> 16) & 0xff); A[3] += cw * (float)(vv.x >> 24); \
    A[4] += cw * (float)(vv.y & 0xff); A[5] += cw * (float)((vv.y >> 8) & 0xff); A[6] += cw * (float)((vv.y >> 16) & 0xff); A[7] += cw * (float)(vv.y >> 24); \
    A[8] += cw * (float)(vv.z & 0xff); A[9] += cw * (float)((vv.z >> 8) & 0xff); A[10] += cw * (float)((vv.z >> 16) & 0xff); A[11] += cw * (float)(vv.z >> 24); \
    A[12] += cw * (float)(vv.w & 0xff); A[13] += cw * (float)((vv.w >> 8) & 0xff); A[14] += cw * (float)((vv.w >> 16) & 0xff); A[15] += cw * (float)(vv.w >> 24); } while (0)
template <int EMASK, int MODE> __device__ __forceinline__ void peer_phase_t(Frame& F, float* outp, const XcdBarrier& bar) {
    const int gw = F.bid * NWAVES + F.wave, NGW = F.G * NWAVES, lane = F.lane;
    LAS unsigned char* pw = (LAS unsigned char*)F.lds + F.wave * PW_BYTES;
    LAS unsigned* cnt = (LAS unsigned*)(pw + PW_CNT);
    const int rounds = (T / TPW + NGW - 1) / NGW;
    for (int rd = 0; rd < rounds; ++rd) {
        const int wt = gw + rd * NGW; const bool live = wt < T / TPW;
        if (rd) xcd_barrier_local(bar);
        const int t0 = (live ? wt : gw) * TPW;
        u32x4 xq[TPW]; float sxrv;
        {
            int lq = lane; asm volatile("" : "+v"(lq));
            uint4 hA[TPW], hB[TPW]; int id0[TPW], id1[TPW]; float g0[TPW], g1[TPW];
#pragma unroll
            for (int j = 0; j < TPW; ++j) { const size_t t = (size_t)(t0 + j);
                hA[j] = *(const uint4*)(F.HB + t * D + 16 * lq); hB[j] = *(const uint4*)(F.HB + t * D + 16 * lq + 8);
                id0[j] = F.IDX[t * 128 + lq]; id1[j] = F.IDX[t * 128 + 64 + lq]; g0[j] = F.GW[t * 128 + lq]; g1[j] = F.GW[t * 128 + 64 + lq]; }
            const float rstd = row_rstd(F.PSQ, t0 + utok(lq));
            *(LAS u32x4*)(pw + PW_CNT + 16 * lq) = u32x4{0u, 0u, 0u, 0u};
            float msel = 0.f;
#pragma unroll
            for (int j = 0; j < TPW; ++j) {
                float x[16];
                { float xa[8], xb[8]; unpack8(hA[j], xa); unpack8(hB[j], xb);
#pragma unroll
                  for (int i = 0; i < 8; ++i) { x[i] = xa[i]; x[8 + i] = xb[i]; } }
                float m = 0.f;
#pragma unroll
                for (int i = 0; i < 16; ++i) m = fmaxf(m, fabsf(x[i]));
                m = wave_max_pos(m);
                const float inv = m > 0.f ? 127.0f * __builtin_amdgcn_rcpf(m) : 0.f;
                int qi[16];
#pragma unroll
                for (int i = 0; i < 16; ++i) qi[i] = (int)rintf(x[i] * inv) & 0xff;
                xq[j].x = (unsigned)qi[0] | ((unsigned)qi[1] << 8) | ((unsigned)qi[2] << 16) | ((unsigned)qi[3] << 24); xq[j].y = (unsigned)qi[4] | ((unsigned)qi[5] << 8) | ((unsigned)qi[6] << 16) | ((unsigned)qi[7] << 24);
                xq[j].z = (unsigned)qi[8] | ((unsigned)qi[9] << 8) | ((unsigned)qi[10] << 16) | ((unsigned)qi[11] << 24); xq[j].w = (unsigned)qi[12] | ((unsigned)qi[13] << 8) | ((unsigned)qi[14] << 16) | ((unsigned)qi[15] << 24);
                msel = (utok(lq) == j) ? m : msel;
            }
            sxrv = msel * (1.0f / 127.0f) * rstd;
            asm volatile("s_waitcnt lgkmcnt(0)" ::: "memory");
            unsigned r0[TPW], r1[TPW];
#pragma unroll
            for (int j = 0; j < TPW; ++j) {
                r0[j] = __hip_atomic_fetch_add(cnt + j * 32 + (id0[j] >> SLSH), 1u, __ATOMIC_RELAXED, __HIP_MEMORY_SCOPE_WORKGROUP);
                r1[j] = __hip_atomic_fetch_add(cnt + j * 32 + (id1[j] >> SLSH), 1u, __ATOMIC_RELAXED, __HIP_MEMORY_SCOPE_WORKGROUP); }
            asm volatile("s_waitcnt lgkmcnt(0)" ::: "memory");
#pragma unroll
            for (int j = 0; j < TPW; ++j) {
                const int own = lq < 32 ? (int)cnt[j * 32 + lq] : 0; int c = own;
                c = dpp_iadd<0x111, 0xF>(c); c = dpp_iadd<0x112, 0xF>(c); c = dpp_iadd<0x114, 0xF>(c); c = dpp_iadd<0x118, 0xF>(c); c = dpp_iadd<0x142, 0xA>(c);
                if (lq < 32) cnt[j * 32 + lq] = (unsigned)(c - own); }
            asm volatile("s_waitcnt lgkmcnt(0)" ::: "memory");
#pragma unroll
            for (int j = 0; j < TPW; ++j) {
                const unsigned p0 = cnt[j * 32 + (id0[j] >> SLSH)] + r0[j], p1 = cnt[j * 32 + (id1[j] >> SLSH)] + r1[j];
                *(LAS unsigned long long*)(pw + PW_LIST + (j * 128 + p0) * 8) = (unsigned long long)(unsigned)id0[j] | ((unsigned long long)__float_as_uint(g0[j]) << 32);
                *(LAS unsigned long long*)(pw + PW_LIST + (j * 128 + p1) * 8) = (unsigned long long)(unsigned)id1[j] | ((unsigned long long)__float_as_uint(g1[j]) << 32); }
            asm volatile("s_waitcnt lgkmcnt(0)" ::: "memory");
        }
        {
            UGroup G[UGRP];
#pragma unroll
            for (int q = 0; q < UGRP; ++q) issue_ug<EMASK>(F, G[q], pw, q, lane);
            for (int p = 0; p < 128; p += UGRP) {
                if (p == 64) xcd_barrier_local(bar);
#pragma unroll
                for (int q = 0; q < UGRP; ++q) { compute_ug(G[q], xq, pw, p + q, lane, sxrv); issue_ug<EMASK>(F, G[q], pw, p + UGRP + q, lane); }
            }
        }
        asm volatile("s_waitcnt lgkmcnt(0)" ::: "memory");
        xcd_barrier_local(bar);
        float stok[TPW];
        int lc = lane; asm volatile("" : "+v"(lc));
#pragma unroll
        for (int j = 0; j < TPW; ++j) {
            const unsigned long long a0 = *(const LAS unsigned long long*)(pw + PW_LIST + (j * 128 + lc) * 8), a1 = *(const LAS unsigned long long*)(pw + PW_LIST + (j * 128 + 64 + lc) * 8);
            const float c0 = __uint_as_float((unsigned)(a0 >> 32)), c1 = __uint_as_float((unsigned)(a1 >> 32));
            const float m = wave_max_pos(fmaxf(fabsf(c0), fabsf(c1)));
            const float sc = m > 0.f ? 127.0f * __builtin_amdgcn_rcpf(m) : 0.f;
            stok[j] = m * (1.0f / 127.0f);
            *(LAS unsigned short*)(pw + PW_XQ + (j * 128 + lc) * 2) = (unsigned short)(unsigned)a0; *(LAS unsigned short*)(pw + PW_XQ + (j * 128 + 64 + lc) * 2) = (unsigned short)(unsigned)a1;
            *(LAS signed char*)(pw + PW_XQ + 2048 + j * 128 + lc) = (signed char)(int)rintf(c0 * sc); *(LAS signed char*)(pw + PW_XQ + 2048 + j * 128 + 64 + lc) = (signed char)(int)rintf(c1 * sc);
        }
        asm volatile("s_waitcnt lgkmcnt(0)" ::: "memory");
        int acc[TPW][16];
#pragma unroll
        for (int j = 0; j < TPW; ++j)
#pragma unroll
            for (int i = 0; i < 16; ++i) acc[j][i] = 0;
        {
            struct VG4 { u32x4 r[4]; int cw4; };
            VG4 S[VGRP];
#define PEER_VISSUE(S_, j_, gp_) do { const int g_ = (gp_) < 32 ? (gp_) : 31; \
                const unsigned long long ev_ = *(const LAS unsigned long long*)(pw + PW_XQ + ((j_) * 128 + 4 * g_) * 2); \
                const unsigned s0_ = (unsigned)__builtin_amdgcn_readfirstlane((int)(unsigned)ev_), s1_ = (unsigned)__builtin_amdgcn_readfirstlane((int)(unsigned)(ev_ >> 32)); \
                (S_).cw4 = __builtin_amdgcn_readfirstlane(*(const LAS int*)(pw + PW_XQ + 2048 + (j_) * 128 + 4 * g_)); \
                (S_).r[0] = *(const u32x4*)(F.V8 + (size_t)((s0_ & 0xffffu) & (unsigned)EMASK) * D + 16 * lane); (S_).r[1] = *(const u32x4*)(F.V8 + (size_t)((s0_ >> 16) & (unsigned)EMASK) * D + 16 * lane); \
                (S_).r[2] = *(const u32x4*)(F.V8 + (size_t)((s1_ & 0xffffu) & (unsigned)EMASK) * D + 16 * lane); (S_).r[3] = *(const u32x4*)(F.V8 + (size_t)((s1_ >> 16) & (unsigned)EMASK) * D + 16 * lane); } while (0)
#define PEER_VTR(A_, i_, a0_, a1_, a2_, a3_, cw_) do { \
                const unsigned x01l_ = __builtin_amdgcn_perm(a1_, a0_, 0x05010400u), x01h_ = __builtin_amdgcn_perm(a1_, a0_, 0x07030602u); \
                const unsigned x23l_ = __builtin_amdgcn_perm(a3_, a2_, 0x05010400u), x23h_ = __builtin_amdgcn_perm(a3_, a2_, 0x07030602u); \
                A_[4 * (i_) + 0] = __builtin_amdgcn_sdot4((int)__builtin_amdgcn_perm(x23l_, x01l_, 0x05040100u), cw_, A_[4 * (i_) + 0], false); \
                A_[4 * (i_) + 1] = __builtin_amdgcn_sdot4((int)__builtin_amdgcn_perm(x23l_, x01l_, 0x07060302u), cw_, A_[4 * (i_) + 1], false); \
                A_[4 * (i_) + 2] = __builtin_amdgcn_sdot4((int)__builtin_amdgcn_perm(x23h_, x01h_, 0x05040100u), cw_, A_[4 * (i_) + 2], false); \
                A_[4 * (i_) + 3] = __builtin_amdgcn_sdot4((int)__builtin_amdgcn_perm(x23h_, x01h_, 0x07060302u), cw_, A_[4 * (i_) + 3], false); } while (0)
#pragma unroll
            for (int n = 0; n < VGRP; ++n) PEER_VISSUE(S[n], n % TPW, n / TPW);
            for (int gp = 0; gp < 32; ++gp) {
                if (gp == 16) xcd_barrier_local(bar);
#pragma unroll
                for (int j = 0; j < TPW; ++j) {
                    VG4& G = S[j % VGRP];
                    PEER_VTR(acc[j], 0, G.r[0].x, G.r[1].x, G.r[2].x, G.r[3].x, G.cw4); PEER_VTR(acc[j], 1, G.r[0].y, G.r[1].y, G.r[2].y, G.r[3].y, G.cw4);
                    PEER_VTR(acc[j], 2, G.r[0].z, G.r[1].z, G.r[2].z, G.r[3].z, G.cw4); PEER_VTR(acc[j], 3, G.r[0].w, G.r[1].w, G.r[2].w, G.r[3].w, G.cw4);
                    PEER_VISSUE(G, (j + VGRP) % TPW, gp + (j + VGRP) / TPW);
                }
            }
#undef PEER_VISSUE
#undef PEER_VTR
        }
#pragma unroll
        for (int j = 0; j < TPW; ++j) {
            float y[16]; float ss = 0.f;
            { float ha[8], hb[8]; unpack8(*(const uint4*)(F.HB + (size_t)(t0 + j) * D + 16 * lane), ha); unpack8(*(const uint4*)(F.HB + (size_t)(t0 + j) * D + 16 * lane + 8), hb);
#pragma unroll
              for (int i = 0; i < 8; ++i) { y[i] = ha[i] + stok[j] * (float)acc[j][i]; y[8 + i] = hb[i] + stok[j] * (float)acc[j][8 + i]; } }
#pragma unroll
            for (int i = 0; i < 16; ++i) ss += y[i] * y[i];
            const float r = 1.0f / sqrtf(wave_total(ss) * (1.f / D) + RMS_EPS);
            LAS float* stg = (LAS float*)(pw + PW_LIST) + (j & 1) * 1024;
#pragma unroll
            for (int q = 0; q < 4; ++q) { const float4 wv = *(const float4*)(F.nfin + 16 * lane + 4 * q);
                *(LAS f32x4_t*)(stg + 16 * lane + 4 * q) = (f32x4_t){y[4 * q] * r * wv.x, y[4 * q + 1] * r * wv.y, y[4 * q + 2] * r * wv.z, y[4 * q + 3] * r * wv.w}; }
            asm volatile("s_waitcnt lgkmcnt(0)" ::: "memory");
#pragma unroll
            for (int q = 0; q < 4; ++q) { const f32x4_t ov = *(const LAS f32x4_t*)(stg + 256 * q + 4 * lane);
                *(f32x4_t*)(outp + (size_t)(t0 + j) * D + 256 * q + 4 * lane) = ov; }
        }
        asm volatile("s_waitcnt lgkmcnt(0)" ::: "memory");
    }
}
}

constexpr int N_PHASES = 11;
__global__ void __launch_bounds__(NTHREADS, 2) mk_fwd(Args args) {
    extern __shared__ __attribute__((aligned(16))) unsigned char lds[];
    Frame F;
    F.lds = lds;
    F.tid = threadIdx.x; F.lane = F.tid & 63; F.wave = __builtin_amdgcn_readfirstlane(F.tid >> 6);
    F.G = gridDim.x; F.bid = blockIdx.x;
    F.x = args.in[0]; F.nmw = args.in[1]; F.w_in = args.in[2]; F.lbp = args.in[3]; F.hnw = args.in[4]; F.dlam = args.in[5]; F.dnw = args.in[6];
    F.w_out = args.in[7]; F.nfw = args.in[8]; F.wq = args.in[9]; F.sk = args.in[10]; F.u = args.in[11]; F.v = args.in[12]; F.nfin = args.in[13];
    F.out = args.out;
    unsigned char* ws = args.ws;
    F.WinT = (bf16*)(ws + WS_WIN); F.WoT = (bf16*)(ws + WS_WO); F.WqT = (bf16*)(ws + WS_WQ); F.SKb = (bf16*)(ws + WS_SK);
    F.XN = (bf16*)(ws + WS_XN); F.MIX = (bf16*)(ws + WS_MIX);
    F.PROJ = (bf16*)(ws + WS_PROJ); F.HB = (bf16*)(ws + WS_HB); F.QH = (bf16*)(ws + WS_QH);
    F.HA = (float*)(ws + WS_HA); F.HO = (float*)(ws + WS_HO); F.PSQ = (float*)(ws + WS_PSQ); F.GW = (float*)(ws + WS_G);
    F.IDX = (int*)(ws + WS_IDX); F.DECG = (float*)(ws + WS_DECG);
    F.U8 = ws + WS_U8; F.V8 = ws + WS_V8; F.US = (float*)(ws + WS_US);
    const int lo = args.ph_lo, hi = args.ph_hi;
    volatile LAS unsigned* MISC = (volatile LAS unsigned*)((LAS unsigned char*)lds + MISC_OFF);
    if (F.tid < 32) MISC[F.tid] = 0u;
    __syncthreads();
    XcdBarrier bar; bar.bar = (unsigned*)(ws + WS_CTL) + 4096; bar.x = 0; bar.st = nullptr;
    if (hi - lo > 1) bar = xcd_barrier_post((unsigned*)(ws + WS_CTL) + 4096, MISC + 8);
#define IN(k) (lo <= (k) && (k) < hi)
#define SEAM(k) do { if (IN(k) && IN((k) + 1)) xcd_barrier(bar); } while (0)
    if (IN(0)) { stage_prep(F);
    }
    SEAM(0);
    if (IN(1)) { pg8::Gemm g{F.XN, F.WinT, T, DIN, D}; pg8::StaticOrder S; S.init(T, DIN, F.G, F.bid); EpiIn E{F.PROJ, F.HA, F.lbp};
        pg8::gemm_phase<EpiIn, pg8::StaticOrder, true, true>((PG8_LAS unsigned char*)lds, g, S, E); }
    if (IN(1) && IN(3)) xcd_barrier(bar);
    if (IN(3)) for (int task = F.bid; task < BATCH * 4 * 64; task += F.G) hg::hgrn_pre(F, task);
    if (IN(3) && IN(4)) xcd_barrier(bar);
    if (IN(4)) { for (int unit = F.bid; unit < 32; unit += F.G) hg::hgrn_scan(F, unit >> 2, unit & 3);
        da::attn_phase(F, (unsigned*)(ws + WS_CTL), MISC);
    }
    SEAM(5);
    if (IN(6)) { pg8::Gemm g{F.MIX, F.WoT, T, D, D}; pg8::StaticOrder S; S.init(T, D, F.G, F.bid); EpiOut E{F.x, F.HB, F.PSQ};
        pg8::gemm_phase<EpiOut, pg8::StaticOrder, true, true>((PG8_LAS unsigned char*)lds, g, S, E); }
    if (IN(6) && IN(8)) xcd_barrier(bar);
    if (IN(8)) { pg8::Gemm g{F.HB, F.WqT, T, 2048, D}; pg8::StaticOrder S; S.init(T, 2048, F.G, F.bid); EpiQ E{F.QH};
        pg8::gemm_phase<EpiQ, pg8::StaticOrder, true, true>((PG8_LAS unsigned char*)lds, g, S, E); }
    SEAM(8);
    if (IN(9)) tk::topk_phase(F);
    SEAM(9);
    if (IN(10)) { peer::peer_phase_t<0xffff, 0>(F, F.out, bar);
    }
#undef IN
#undef SEAM
}

extern "C" void kernel_launch(void* const* d_in, const int* in_sizes, int n_in, void* d_out, int out_size, void* d_ws, size_t ws_size, hipStream_t stream) {
    static int grid = 0;
    if (grid == 0) {
        if (n_in != 14 || in_sizes[0] != T * D || out_size != T * D || ws_size < WS_END) {
            fprintf(stderr, "kernel_launch: unexpected shapes: n_in %d in0 %d out %d ws %zu (need %zu)\n", n_in, n_in > 0 ? in_sizes[0] : -1, out_size, ws_size, (size_t)WS_END);
            grid = -1; return; }
        int dev = 0, cus = 0;
        if (hipGetDevice(&dev) != hipSuccess || hipDeviceGetAttribute(&cus, hipDeviceAttributeMultiprocessorCount, dev) != hipSuccess) { grid = -1; return; }
        if (hipFuncSetAttribute((const void*)mk_fwd, hipFuncAttributeMaxDynamicSharedMemorySize, LDS_BYTES) != hipSuccess) { fprintf(stderr, "kernel_launch: hipFuncSetAttribute failed\n"); grid = -1; return; }
        int per_cu = 0;
        if (hipOccupancyMaxActiveBlocksPerMultiprocessor(&per_cu, (const void*)mk_fwd, NTHREADS, LDS_BYTES) != hipSuccess || per_cu < 1) {
            fprintf(stderr, "kernel_launch: the occupancy query reports %d workgroups per CU for %d threads / %d B of LDS; nothing launched\n", per_cu, NTHREADS, LDS_BYTES); grid = -1; return; }
        (void)hipGetLastError();
        grid = cus;
    }
    if (grid < 0) return;
    Args a{};
    for (int i = 0; i < 14; ++i) a.in[i] = (const float*)d_in[i];
    a.out = (float*)d_out; a.ws = (unsigned char*)d_ws;
    if (hipMemsetAsync((char*)d_ws + WS_CTL, 0, 64 * 1024, stream) != hipSuccess) { fprintf(stderr, "kernel_launch: memset failed\n"); return; }
    a.ph_lo = 0; a.ph_hi = N_PHASES;
    hipLaunchKernelGGL(mk_fwd, dim3(grid), dim3(NTHREADS), LDS_BYTES, stream, a);
}
```
